# Optimizing an MI355X kernel written in HIP

```python
import jax, jax.numpy as jnp
from jax import lax
import numpy as np

D_MODEL = 1024
BATCH = 4
SEQ = 8192
DEPTH = 2

N_MIXERS = 2
N_A_LAYERS = (DEPTH + 1) // 2
N_B_LAYERS = DEPTH // 2
NORM_EPS = 1e-6

A_WIDTH = 2 * D_MODEL
A_GROUPS = 8
A_CHUNK = 128
A_GROUP_DIM = A_WIDTH // A_GROUPS

B_HEADS = 4
B_KEY_DIM = D_MODEL // 2
B_VAL_DIM = D_MODEL
B_HEAD_K = B_KEY_DIM // B_HEADS
B_HEAD_V = B_VAL_DIM // B_HEADS
B_GATE_RANK = 16
B_GATE_NORM = 16.0
B_CHUNK = 64
B_PROJ = 2 * B_KEY_DIM + 2 * B_VAL_DIM + B_GATE_RANK

P_HEADS = 8
P_NKEYS = 128
P_EXPERTS = P_NKEYS * P_NKEYS
P_QDIM = 256
P_HALF = P_QDIM // 2
P_TOPK = 16
P_BLOCK = 128

kernel_name = "hybrid_gmlp_gla_peer_trunk"


def rmsnorm(x, g):
    xf = x.astype(jnp.float32)
    y = xf * lax.rsqrt(jnp.mean(xf * xf, axis=-1, keepdims=True) + NORM_EPS)
    return (y * g.astype(jnp.float32)).astype(x.dtype)


def layernorm(x, g, b):
    xf = x.astype(jnp.float32)
    mu = jnp.mean(xf, axis=-1, keepdims=True)
    xc = xf - mu
    y = xc * lax.rsqrt(jnp.mean(xc * xc, axis=-1, keepdims=True) + NORM_EPS)
    return (y * g.astype(jnp.float32) + b.astype(jnp.float32)).astype(x.dtype)


def mixer_a(h, w_in, b_in, ln_g, ln_b, w_s, b_s, w_out):
    B, L, _ = h.shape
    z = jax.nn.gelu(h @ w_in + b_in, approximate=False)
    u, v = jnp.split(z, 2, axis=-1)
    v = layernorm(v, ln_g, ln_b)
    v = v.reshape(B, L // A_CHUNK, A_CHUNK, A_GROUPS, A_GROUP_DIM)
    causal = jnp.tril(jnp.ones((A_CHUNK, A_CHUNK), dtype=bool))
    w = jnp.where(causal[None], w_s, 0.0)
    sv = jnp.einsum('gts,bnsgc->bntgc', w, v) + b_s.T[:, :, None]
    y = u * sv.reshape(B, L, A_WIDTH)
    return y @ w_out


def mixer_b(h, w_in, w_g2, b_g, norm_g, w_out):
    B, L, _ = h.shape
    f32 = jnp.float32
    proj = h @ w_in
    q, k, v, r, g_lr = jnp.split(
        proj, [B_KEY_DIM, 2 * B_KEY_DIM, 2 * B_KEY_DIM + B_VAL_DIM, 2 * B_KEY_DIM + 2 * B_VAL_DIM], axis=-1)
    log_a = jax.nn.log_sigmoid((g_lr @ w_g2 + b_g).astype(f32)) / B_GATE_NORM
    nc = L // B_CHUNK

    def to_chunks(t, d):
        return t.astype(f32).reshape(B, nc, B_CHUNK, B_HEADS, d).transpose(1, 0, 3, 2, 4)

    qc = to_chunks(q, B_HEAD_K) * (B_HEAD_K ** -0.5)
    kc = to_chunks(k, B_HEAD_K)
    vc = to_chunks(v, B_HEAD_V)
    gc = jnp.cumsum(to_chunks(log_a, B_HEAD_K), axis=3)
    causal = jnp.tril(jnp.ones((B_CHUNK, B_CHUNK), dtype=bool))[:, :, None]

    def step(S, inp):
        qb, kb, vb, gb = inp
        diff = gb[:, :, :, None, :] - gb[:, :, None, :, :]
        decay = jnp.where(causal, jnp.exp(jnp.where(causal, diff, 0.0)), 0.0)
        scores = jnp.einsum('bhtsk,bhsk->bhts', qb[:, :, :, None, :] * decay, kb)
        o = scores @ vb + jnp.einsum('bhtk,bhkv->bhtv', qb * jnp.exp(gb), S)
        g_last = gb[:, :, -1:, :]
        S = jnp.exp(g_last[:, :, 0, :, None]) * S + jnp.einsum(
            'bhsk,bhsv->bhkv', kb * jnp.exp(g_last - gb), vb)
        return S, o

    S0 = jnp.zeros((B, B_HEADS, B_HEAD_K, B_HEAD_V), f32)
    _, o = lax.scan(step, S0, (qc, kc, vc, gc))
    o = o.transpose(1, 0, 3, 2, 4).reshape(B, L, B_HEADS, B_HEAD_V)
    o = rmsnorm(o, norm_g).reshape(B, L, B_VAL_DIM).astype(h.dtype)
    o = o * jax.nn.silu(r)
    return o @ w_out


def peer(h, w_q, k1, k2, u_tab, v_tab):
    B, L, D = h.shape
    f32 = jnp.float32
    xs = h.reshape(-1, P_BLOCK, D)

    def block(xb):
        q = (xb @ w_q).reshape(P_BLOCK, P_HEADS, P_QDIM).astype(f32)
        s1 = jnp.einsum('thd,nd->thn', q[..., :P_HALF], k1.astype(f32))
        s2 = jnp.einsum('thd,nd->thn', q[..., P_HALF:], k2.astype(f32))
        v1, i1 = lax.top_k(s1, P_TOPK)
        v2, i2 = lax.top_k(s2, P_TOPK)
        cand = (v1[..., :, None] + v2[..., None, :]).reshape(P_BLOCK, P_HEADS, P_TOPK * P_TOPK)
        cand_id = (i1[..., :, None] * P_NKEYS + i2[..., None, :]).reshape(P_BLOCK, P_HEADS, P_TOPK * P_TOPK)
        top_s, pos = lax.top_k(cand, P_TOPK)
        eid = jnp.take_along_axis(cand_id, pos, axis=-1)
        gate = jax.nn.softmax(top_s, axis=-1)
        u_e = jnp.take(u_tab, eid, axis=0)
        act = jax.nn.gelu(jnp.einsum('thkd,td->thk', u_e, xb), approximate=False)
        v_e = jnp.take(v_tab, eid, axis=0)
        return jnp.einsum('thk,thkd->td', (gate * act).astype(xb.dtype), v_e)

    return lax.map(block, xs).reshape(B, L, D)


def setup_inputs(seed: int = 0) -> dict:
    key = jax.random.key(seed)
    ks = jax.random.split(key, 24)
    f32 = jnp.float32

    def nrm(k, shape, scale):
        return jax.random.normal(k, shape, f32) * scale

    return {
        "x": nrm(ks[0], (BATCH, SEQ, D_MODEL), 1.0),
        "norm_mix": 1.0 + nrm(ks[1], (DEPTH, D_MODEL), 0.02),
        "norm_ffn": 1.0 + nrm(ks[2], (DEPTH, D_MODEL), 0.02),
        "final_norm": 1.0 + nrm(ks[3], (D_MODEL,), 0.02),
        "a_w_in": nrm(ks[4], (N_A_LAYERS, D_MODEL, 2 * A_WIDTH), D_MODEL ** -0.5),
        "a_b_in": nrm(ks[5], (N_A_LAYERS, 2 * A_WIDTH), 0.02),
        "a_ln_g": 1.0 + nrm(ks[6], (N_A_LAYERS, A_WIDTH), 0.02),
        "a_ln_b": nrm(ks[7], (N_A_LAYERS, A_WIDTH), 0.02),
        "a_w_s": nrm(ks[8], (N_A_LAYERS, A_GROUPS, A_CHUNK, A_CHUNK), A_CHUNK ** -0.5),
        "a_b_s": 1.0 + nrm(ks[9], (N_A_LAYERS, A_GROUPS, A_CHUNK), 0.02),
        "a_w_out": nrm(ks[10], (N_A_LAYERS, A_WIDTH, D_MODEL), A_WIDTH ** -0.5),
        "b_w_in": nrm(ks[11], (N_B_LAYERS, D_MODEL, B_PROJ), D_MODEL ** -0.5),
        "b_w_g2": nrm(ks[12], (N_B_LAYERS, B_GATE_RANK, B_KEY_DIM), B_GATE_RANK ** -0.5),
        "b_b_g": nrm(ks[13], (N_B_LAYERS, B_KEY_DIM), 0.02),
        "b_norm": 1.0 + nrm(ks[14], (N_B_LAYERS, B_HEAD_V), 0.02),
        "b_w_out": nrm(ks[15], (N_B_LAYERS, B_VAL_DIM, D_MODEL), B_VAL_DIM ** -0.5),
        "p_w_q": nrm(ks[16], (DEPTH, D_MODEL, P_HEADS * P_QDIM), D_MODEL ** -0.5),
        "p_k1": nrm(ks[17], (DEPTH, P_NKEYS, P_HALF), P_HALF ** -0.5),
        "p_k2": nrm(ks[18], (DEPTH, P_NKEYS, P_HALF), P_HALF ** -0.5),
        "p_u": nrm(ks[19], (DEPTH, P_EXPERTS, D_MODEL), D_MODEL ** -0.5),
        "p_v": nrm(ks[20], (DEPTH, P_EXPERTS, D_MODEL), P_HEADS ** -0.5),
    }


def reference(x, norm_mix, norm_ffn, final_norm,
              a_w_in, a_b_in, a_ln_g, a_ln_b, a_w_s, a_b_s, a_w_out,
              b_w_in, b_w_g2, b_b_g, b_norm, b_w_out,
              p_w_q, p_k1, p_k2, p_u, p_v):
    for i in range(DEPTH):
        h = rmsnorm(x, norm_mix[i])
        j = i // N_MIXERS
        if i % N_MIXERS == 0:
            x = x + mixer_a(h, a_w_in[j], a_b_in[j], a_ln_g[j], a_ln_b[j], a_w_s[j], a_b_s[j], a_w_out[j])
        else:
            x = x + mixer_b(h, b_w_in[j], b_w_g2[j], b_b_g[j], b_norm[j], b_w_out[j])
        h = rmsnorm(x, norm_ffn[i])
        x = x + peer(h, p_w_q[i], p_k1[i], p_k2[i], p_u[i], p_v[i])
    return rmsnorm(x, final_norm)
```

```cpp
#include <hip/hip_runtime.h>
#include <cstdio>
#include <cstdint>
#include <hip/hip_cooperative_groups.h>
namespace cg = cooperative_groups;
#define PROBE 0
namespace pg8 {
#define PG8_LAS __attribute__((address_space(3)))
typedef unsigned short bf16_t;
typedef short bf16x8 __attribute__((ext_vector_type(8)));
typedef float f32x4 __attribute__((ext_vector_type(4)));
typedef unsigned u32x4 __attribute__((ext_vector_type(4)));
constexpr int BM = 256, BK = 64, HALF = 128, HTB = HALF * BK * 2  , STAGE_BYTES = 8 * HTB, NXCD = 8, WGM = 8;

__host__ __device__ __forceinline__ int lds_byte(int r, int c) { const int st = (r >> 4) * 2 + (c >> 5), rr = r & 15, cc = c & 31, ob = rr * 64 + cc * 2; return st * 1024 + (ob ^ (((ob >> 9) & 1) << 5)); }
__host__ __device__ __forceinline__ void stage_rc(int b, int& R, int& C) { const int st = b / 1024, sb = b % 1024, swz = sb ^ (((sb >> 9) & 1) << 5); R = (st >> 1) * 16 + swz / 64; C = (st & 1) * 32 + (swz % 64) / 2; }
__host__ __device__ __forceinline__ int perm32(int rho) { const int n = rho >> 4, i = rho & 15; return 8 * (i >> 2) + 4 * n + (i & 3); }

struct Unit { int pm, pn; };
struct Gemm { const bf16_t* A; const bf16_t* Bt; int M, N, K; };

struct StaticOrder {
    int nM, nN, nwg, G, c;
    __host__ __device__ void init(int M, int N, int G_, int c_) { nM = M / BM; nN = N / BM; nwg = nM * nN; G = G_; c = c_; }
    __host__ __device__ bool next(int i, Unit& u) const {
        const long L = (long)i * G + c; if (L >= nwg) return false;
        int wgid = (int)L; { const int q = nwg / NXCD, r = nwg % NXCD, xcd = wgid % NXCD, off = wgid / NXCD; wgid = (xcd < r ? xcd * (q + 1) : r * (q + 1) + (xcd - r) * q) + off; }
        const int nig = WGM * nN, gid = wgid / nig, fm = gid * WGM, gsz = (nM - fm) < WGM ? (nM - fm) : WGM;
        u.pm = fm + ((wgid % nig) % gsz); u.pn = (wgid % nig) / gsz; return true;
    }
    __device__ __forceinline__ void a_ready(const Unit&) const {}
    __device__ __forceinline__ void done(const Unit&) const {}
};

__device__ __forceinline__ unsigned cvt_pk_bf16(float lo, float hi) { unsigned r; asm volatile("v_cvt_pk_bf16_f32 %0, %1, %2" : "=v"(r) : "v"(lo), "v"(hi)); return r; }
typedef float f32x2 __attribute__((ext_vector_type(2)));
__device__ __forceinline__ f32x2 gelu_pk(f32x2 v) {
    const f32x2 av = __builtin_elementwise_abs(v), d = av * 0.2316418882f + 1.0f;
    f32x2 t; t.x = __builtin_amdgcn_rcpf(d.x); t.y = __builtin_amdgcn_rcpf(d.y);
    f32x2 q = t * 0.5307027145f + (-0.7265760135f); q = q * t + 0.7107068705f; q = q * t + (-0.142248368f); q = q * t + 0.127414796f; q = q * t;
    const f32x2 s = (v * v) * (-0.72134752044f);
    f32x2 e; e.x = __builtin_amdgcn_exp2f(s.x); e.y = __builtin_amdgcn_exp2f(s.y);
    const f32x2 m = v * (q * e), r = v - m;
    f32x2 o; o.x = v.x < 0.f ? m.x : r.x; o.y = v.y < 0.f ? m.y : r.y; return o;
}

template <int ACT  > struct EpiBf16 {
    static constexpr bool PERM = true, AFTER_DRAIN = false; static_assert(ACT == 0 || ACT == 1, "EpiBf16: ACT is 0 (none) or 1 (gelu_pk)");
    bf16_t* O; int ldc; const float* bias; int split_cols; size_t split_stride; float scale0;
    __device__ __forceinline__ void operator()(const f32x4 (&acc)[2][2][4][2], const Unit& u, int wr, int wc, int fr, int fq) const {
        const int row0 = u.pm * BM + wr * 64 + fr; int colt = u.pn * BM; bf16_t* base = O;
        float sc = 1.f; if (split_cols) { const int t = colt / split_cols; base += (size_t)t * split_stride; colt -= t * split_cols; if (t == 0) sc = scale0; }
        const int col0 = colt + wc * 32 + 8 * fq, bcol0 = u.pn * BM + wc * 32 + 8 * fq;
        f32x4 bv[2][2];
#pragma unroll
        for (int bj = 0; bj < 2; ++bj)
#pragma unroll
            for (int n = 0; n < 2; ++n) bv[bj][n] = bias ? *(const f32x4*)(bias + bcol0 + bj * HALF + 4 * n) : (f32x4){0.f, 0.f, 0.f, 0.f};
#pragma unroll
        for (int ai = 0; ai < 2; ++ai)
#pragma unroll
            for (int m = 0; m < 4; ++m) { bf16_t* rowp = base + (size_t)(row0 + ai * HALF + m * 16) * ldc + col0;
#pragma unroll
                for (int bj = 0; bj < 2; ++bj) { f32x4 v0 = acc[ai][bj][m][0] + bv[bj][0], v1 = acc[ai][bj][m][1] + bv[bj][1];
                    if (ACT == 1) { f32x2 a = gelu_pk((f32x2){v0[0], v0[1]}), b = gelu_pk((f32x2){v0[2], v0[3]}), c = gelu_pk((f32x2){v1[0], v1[1]}), d = gelu_pk((f32x2){v1[2], v1[3]});
                        v0 = (f32x4){a.x, a.y, b.x, b.y}; v1 = (f32x4){c.x, c.y, d.x, d.y}; }
                    v0 = v0 * sc; v1 = v1 * sc; u32x4 w; w.x = cvt_pk_bf16(v0[0], v0[1]); w.y = cvt_pk_bf16(v0[2], v0[3]); w.z = cvt_pk_bf16(v1[0], v1[1]); w.w = cvt_pk_bf16(v1[2], v1[3]);
                    *(u32x4*)(rowp + bj * HALF) = w; } }
    }
};

struct EpiResF32 {
    static constexpr bool PERM = false, AFTER_DRAIN = false;
    float* C; const float* R; int ldc;
    __device__ __forceinline__ void operator()(const f32x4 (&acc)[2][2][4][2], const Unit& u, int wr, int wc, int fr, int fq) const {
        const int row0 = u.pm * BM + wr * 64 + fr, col0 = u.pn * BM + wc * 32 + 4 * fq;
#pragma unroll
        for (int ai = 0; ai < 2; ++ai)
#pragma unroll
            for (int m = 0; m < 4; ++m) { const size_t off = (size_t)(row0 + ai * HALF + m * 16) * ldc + col0;
#pragma unroll
                for (int bj = 0; bj < 2; ++bj)
#pragma unroll
                    for (int n = 0; n < 2; ++n) { f32x4 v = acc[ai][bj][m][n]; if (R) v = v + *(const f32x4*)(R + off + bj * HALF + n * 16); *(f32x4*)(C + off + bj * HALF + n * 16) = v; } }
    }
};
typedef int i32x4 __attribute__((ext_vector_type(4)));
template <bool INT8> __device__ __forceinline__ f32x4 pg8_mma(bf16x8 a, bf16x8 b, f32x4 c) {
    if constexpr (INT8) return __builtin_bit_cast(f32x4, __builtin_amdgcn_mfma_i32_16x16x64_i8(__builtin_bit_cast(i32x4, a), __builtin_bit_cast(i32x4, b), __builtin_bit_cast(i32x4, c), 0, 0, 0));
    else return __builtin_amdgcn_mfma_f32_16x16x32_bf16(a, b, c, 0, 0, 0);
}
template <int ACT> struct EpiBf16I8 {
    static constexpr bool PERM = true, AFTER_DRAIN = false;
    bf16_t* O; int ldc; const float* bias; int split_cols; size_t split_stride; const float* sa; const float* sb;
    __device__ __forceinline__ void operator()(const f32x4 (&acc)[2][2][4][2], const Unit& u, int wr, int wc, int fr, int fq) const {
        const int row0 = u.pm * BM + wr * 64 + fr; int colt = u.pn * BM; bf16_t* base = O;
        if (split_cols) { const int t = colt / split_cols; base += (size_t)t * split_stride; colt -= t * split_cols; }
        const int col0 = colt + wc * 32 + 8 * fq, bcol0 = u.pn * BM + wc * 32 + 8 * fq;
        f32x4 bv[2][2], cs[2][2];
#pragma unroll
        for (int bj = 0; bj < 2; ++bj)
#pragma unroll
            for (int n = 0; n < 2; ++n) { bv[bj][n] = bias ? *(const f32x4*)(bias + bcol0 + bj * HALF + 4 * n) : (f32x4){0.f, 0.f, 0.f, 0.f}; cs[bj][n] = *(const f32x4*)(sb + bcol0 + bj * HALF + 4 * n); }
#pragma unroll
        for (int ai = 0; ai < 2; ++ai)
#pragma unroll
            for (int m = 0; m < 4; ++m) { const int row = row0 + ai * HALF + m * 16; const float ra = sa[row]; bf16_t* rowp = base + (size_t)row * ldc + col0;
#pragma unroll
                for (int bj = 0; bj < 2; ++bj) { const i32x4 i0 = __builtin_bit_cast(i32x4, acc[ai][bj][m][0]), i1 = __builtin_bit_cast(i32x4, acc[ai][bj][m][1]);
                    f32x4 v0, v1;
#pragma unroll
                    for (int j = 0; j < 4; ++j) { v0[j] = (float)i0[j] * (ra * cs[bj][0][j]) + bv[bj][0][j]; v1[j] = (float)i1[j] * (ra * cs[bj][1][j]) + bv[bj][1][j]; }
                    if (ACT == 1) { f32x2 a = gelu_pk((f32x2){v0[0], v0[1]}), b = gelu_pk((f32x2){v0[2], v0[3]}), c = gelu_pk((f32x2){v1[0], v1[1]}), d = gelu_pk((f32x2){v1[2], v1[3]});
                        v0 = (f32x4){a.x, a.y, b.x, b.y}; v1 = (f32x4){c.x, c.y, d.x, d.y}; }
                    u32x4 w; w.x = cvt_pk_bf16(v0[0], v0[1]); w.y = cvt_pk_bf16(v0[2], v0[3]); w.z = cvt_pk_bf16(v1[0], v1[1]); w.w = cvt_pk_bf16(v1[2], v1[3]);
                    *(u32x4*)(rowp + bj * HALF) = w; } }
    }
};
struct EpiResF32I8 {
    static constexpr bool PERM = false, AFTER_DRAIN = false;
    float* C; const float* R; const float* sa; const float* sb; int ldc;
    __device__ __forceinline__ void operator()(const f32x4 (&acc)[2][2][4][2], const Unit& u, int wr, int wc, int fr, int fq) const {
        const int row0 = u.pm * BM + wr * 64 + fr, col0 = u.pn * BM + wc * 32 + 4 * fq;
        f32x4 cs[2][2];
#pragma unroll
        for (int bj = 0; bj < 2; ++bj)
#pragma unroll
            for (int n = 0; n < 2; ++n) cs[bj][n] = *(const f32x4*)(sb + col0 + bj * HALF + n * 16);
#pragma unroll
        for (int ai = 0; ai < 2; ++ai)
#pragma unroll
            for (int m = 0; m < 4; ++m) { const int row = row0 + ai * HALF + m * 16; const float ra = sa[row]; const size_t off = (size_t)row * ldc + col0;
#pragma unroll
                for (int bj = 0; bj < 2; ++bj)
#pragma unroll
                    for (int n = 0; n < 2; ++n) { const i32x4 iv = __builtin_bit_cast(i32x4, acc[ai][bj][m][n]); f32x4 v = *(const f32x4*)(R + off + bj * HALF + n * 16);
#pragma unroll
                        for (int j = 0; j < 4; ++j) v[j] += (float)iv[j] * (ra * cs[bj][n][j]);
                        *(f32x4*)(C + off + bj * HALF + n * 16) = v; } }
    }
};
struct EpiF16 {
    static constexpr bool PERM = true, AFTER_DRAIN = false;
    _Float16* O; int ldc;
    __device__ __forceinline__ void operator()(const f32x4 (&acc)[2][2][4][2], const Unit& u, int wr, int wc, int fr, int fq) const {
        typedef _Float16 h2 __attribute__((ext_vector_type(2)));
        const int row0 = u.pm * BM + wr * 64 + fr, col0 = u.pn * BM + wc * 32 + 8 * fq;
#pragma unroll
        for (int ai = 0; ai < 2; ++ai)
#pragma unroll
            for (int m = 0; m < 4; ++m) { _Float16* rowp = O + (size_t)(row0 + ai * HALF + m * 16) * ldc + col0;
#pragma unroll
                for (int bj = 0; bj < 2; ++bj) { const f32x4 v0 = acc[ai][bj][m][0], v1 = acc[ai][bj][m][1];
                    u32x4 w;
                    w.x = __builtin_bit_cast(unsigned, (h2){(_Float16)v0[0], (_Float16)v0[1]}); w.y = __builtin_bit_cast(unsigned, (h2){(_Float16)v0[2], (_Float16)v0[3]});
                    w.z = __builtin_bit_cast(unsigned, (h2){(_Float16)v1[0], (_Float16)v1[1]}); w.w = __builtin_bit_cast(unsigned, (h2){(_Float16)v1[2], (_Float16)v1[3]});
                    *(u32x4*)(rowp + bj * HALF) = w; } }
    }
};
template <class Epi, class Sched, bool ALIGN_EPI = false, bool SP2 = false, bool INT8 = false>
__device__ __forceinline__ void gemm_phase(PG8_LAS unsigned char* lds, const Gemm g, const Sched& S, const Epi& E) {
    int tid = threadIdx.x; asm volatile("" : "+v"(tid));
    const int wid = __builtin_amdgcn_readfirstlane(tid >> 6), lane = tid & 63, wr = wid >> 2, wc = wid & 3, fr = lane & 15, fq = lane >> 4;
    const int K = g.K, nt = K / BK;
    unsigned voffA[2], voffB[2];
#pragma unroll
    for (int i = 0; i < 2; ++i) { int R, C; stage_rc(tid * 16 + i * 8192, R, C); const int Rb = Epi::PERM ? ((R & ~31) + perm32(R & 31)) : R;
        voffA[i] = (unsigned)(R * K + C) * 2u; voffB[i] = (unsigned)(Rb * K + C) * 2u; }
    const size_t kstep = (size_t)(BK * 2);
    const size_t hstep = (size_t)HALF * K * 2;
    const size_t tstep = 2 * hstep;
    const unsigned ldsw = (unsigned)wid * 1024u;
    const int aoff = lds_byte(wr * 64 + fr, fq * 8), boff = lds_byte(wc * 32 + fr, fq * 8);
#define PG8_SA(b, h) (((b) * 2 + (h)) * HTB)
#define PG8_SB(b, h) ((4 + (b) * 2 + (h)) * HTB)
#define PG8_STAGE(bufoff, gbase, voff) do { _Pragma("unroll") for (int _i = 0; _i < 2; ++_i) \
        __builtin_amdgcn_global_load_lds((const unsigned*)((const char*)(gbase) + (voff)[_i]), (PG8_LAS unsigned*)(lds + (bufoff) + ldsw + _i * 8192), 16, 0, 0); } while (0)
#define PG8_LDA(dst, b, h) do { _Pragma("unroll") for (int m = 0; m < 4; ++m) _Pragma("unroll") for (int k = 0; k < 2; ++k) dst[m][k] = *(const PG8_LAS bf16x8*)(lds + PG8_SA(b, h) + aoff + m * 2048 + k * 1024); } while (0)
#define PG8_LDB(dst, b, h) do { _Pragma("unroll") for (int n = 0; n < 2; ++n) _Pragma("unroll") for (int k = 0; k < 2; ++k) dst[n][k] = *(const PG8_LAS bf16x8*)(lds + PG8_SB(b, h) + boff + n * 2048 + k * 1024); } while (0)
#define PG8_MMA(ai, bj, At, Bt) do { __builtin_amdgcn_s_setprio(1); _Pragma("unroll") for (int m = 0; m < 4; ++m) _Pragma("unroll") for (int n = 0; n < 2; ++n) _Pragma("unroll") for (int k = 0; k < 2; ++k) \
        acc[ai][bj][m][n] = pg8_mma<INT8>(Bt[n][k], At[m][k], acc[ai][bj][m][n]); __builtin_amdgcn_s_setprio(0); } while (0)
#define PG8_WAIT_V(n) asm volatile("s_waitcnt vmcnt(" #n ")" ::: "memory")
#define PG8_WAIT_L(n) asm volatile("s_waitcnt lgkmcnt(" #n ")" ::: "memory")
#define PG8_BAR __builtin_amdgcn_s_barrier()
#define PG8_SCHED __builtin_amdgcn_sched_barrier(0)
    Unit cur, nxt; int ui = 0;
    if (!S.next(0, cur)) return;
    f32x4 acc[2][2][4][2];
#pragma unroll
    for (int a = 0; a < 2; ++a)
#pragma unroll
        for (int b = 0; b < 2; ++b)
#pragma unroll
            for (int m = 0; m < 4; ++m)
#pragma unroll
                for (int n = 0; n < 2; ++n) acc[a][b][m][n] = (f32x4){0.f, 0.f, 0.f, 0.f};
    bf16x8 At[4][2], B0[2][2], B1[2][2];
    const char* cA = (const char*)g.A + (size_t)cur.pm * tstep; const char* cB = (const char*)g.Bt + (size_t)cur.pn * tstep;
    S.a_ready(cur);
    if constexpr (SP2) {
        PG8_STAGE(PG8_SB(0, 0), cB, voffB); PG8_STAGE(PG8_SB(0, 1), cB + hstep, voffB); PG8_STAGE(PG8_SA(0, 0), cA, voffA); PG8_STAGE(PG8_SA(0, 1), cA + hstep, voffA);
        if (wr == 1) PG8_BAR;
        PG8_WAIT_V(2); PG8_BAR;
        PG8_STAGE(PG8_SB(1, 0), cB + kstep, voffB); PG8_STAGE(PG8_SA(1, 0), cA + kstep, voffA); PG8_STAGE(PG8_SB(1, 1), cB + hstep + kstep, voffB);
        PG8_WAIT_V(6); PG8_BAR;
    } else {
        PG8_STAGE(PG8_SB(0, 0), cB, voffB); PG8_STAGE(PG8_SA(0, 0), cA, voffA); PG8_STAGE(PG8_SB(0, 1), cB + hstep, voffB); PG8_STAGE(PG8_SA(0, 1), cA + hstep, voffA);
        if (wr == 1) PG8_BAR;
        PG8_WAIT_V(4); PG8_BAR;
        PG8_STAGE(PG8_SB(1, 0), cB + kstep, voffB); PG8_STAGE(PG8_SA(1, 0), cA + kstep, voffA); PG8_STAGE(PG8_SB(1, 1), cB + hstep + kstep, voffB);
        PG8_WAIT_V(6); PG8_BAR;
    }
    for (;;) {
        const bool has_next = S.next(ui + 1, nxt);
        const char* nA = has_next ? (const char*)g.A + (size_t)nxt.pm * tstep : cA; const char* nB = has_next ? (const char*)g.Bt + (size_t)nxt.pn * tstep : cB;
        for (int t = 0; t < nt; t += 2) {
            const bool last = (t == nt - 2);
            const char* a1 = cA + (size_t)(t + 1) * kstep;
            const char* a2 = last ? nA : cA + (size_t)(t + 2) * kstep; const char* b2 = last ? nB : cB + (size_t)(t + 2) * kstep;
            const char* a3 = a2 + kstep; const char* b3 = b2 + kstep;
            if (last && has_next) S.a_ready(nxt);
            if constexpr (SP2) {
            PG8_LDB(B0, 0, 0); PG8_LDB(B1, 0, 1); PG8_SCHED; PG8_LDA(At, 0, 0); PG8_STAGE(PG8_SA(1, 1), a1 + hstep, voffA);
            PG8_WAIT_V(8); PG8_WAIT_L(0); PG8_BAR; PG8_MMA(0, 0, At, B0); PG8_MMA(0, 1, At, B1); PG8_BAR; PG8_SCHED;
            PG8_LDA(At, 0, 1); PG8_STAGE(PG8_SB(0, 0), b2, voffB); PG8_STAGE(PG8_SB(0, 1), b2 + hstep, voffB); PG8_STAGE(PG8_SA(0, 0), a2, voffA);
            PG8_WAIT_V(8); PG8_WAIT_L(0); PG8_BAR; PG8_MMA(1, 0, At, B0); PG8_MMA(1, 1, At, B1); PG8_BAR; PG8_SCHED;
            PG8_LDB(B0, 1, 0); PG8_LDB(B1, 1, 1); PG8_SCHED; PG8_LDA(At, 1, 0); PG8_STAGE(PG8_SA(0, 1), a2 + hstep, voffA);
            PG8_WAIT_V(8); PG8_WAIT_L(0); PG8_BAR; PG8_MMA(0, 0, At, B0); PG8_MMA(0, 1, At, B1); PG8_BAR; PG8_SCHED;
            PG8_LDA(At, 1, 1); PG8_STAGE(PG8_SB(1, 0), b3, voffB); PG8_STAGE(PG8_SB(1, 1), b3 + hstep, voffB); PG8_STAGE(PG8_SA(1, 0), a3, voffA);
            PG8_WAIT_V(8); PG8_WAIT_L(0); PG8_BAR; PG8_MMA(1, 0, At, B0); PG8_MMA(1, 1, At, B1); PG8_BAR; PG8_SCHED;
            } else {
            PG8_LDB(B0, 0, 0); PG8_SCHED; PG8_LDA(At, 0, 0); PG8_STAGE(PG8_SA(1, 1), a1 + hstep, voffA);
            PG8_WAIT_L(8); PG8_BAR; PG8_WAIT_L(0); PG8_MMA(0, 0, At, B0); PG8_BAR; PG8_SCHED;
            PG8_LDB(B1, 0, 1); PG8_STAGE(PG8_SB(0, 0), b2, voffB);
            PG8_BAR; PG8_WAIT_L(0); PG8_MMA(0, 1, At, B1); PG8_BAR;
            PG8_LDA(At, 0, 1); PG8_STAGE(PG8_SA(0, 0), a2, voffA);
            PG8_BAR; PG8_WAIT_L(0); PG8_MMA(1, 0, At, B0); PG8_BAR; PG8_SCHED;
            PG8_STAGE(PG8_SB(0, 1), b2 + hstep, voffB);
            PG8_WAIT_V(6); PG8_BAR; PG8_MMA(1, 1, At, B1); PG8_BAR;
            PG8_LDB(B0, 1, 0); PG8_SCHED; PG8_LDA(At, 1, 0); PG8_STAGE(PG8_SA(0, 1), a2 + hstep, voffA);
            PG8_WAIT_L(8); PG8_BAR; PG8_WAIT_L(0); PG8_MMA(0, 0, At, B0); PG8_BAR; PG8_SCHED;
            PG8_LDB(B1, 1, 1); PG8_STAGE(PG8_SB(1, 0), b3, voffB);
            PG8_BAR; PG8_WAIT_L(0); PG8_MMA(0, 1, At, B1); PG8_BAR;
            PG8_LDA(At, 1, 1); PG8_STAGE(PG8_SA(1, 0), a3, voffA);
            PG8_BAR; PG8_WAIT_L(0); PG8_MMA(1, 0, At, B0); PG8_BAR; PG8_SCHED;
            PG8_STAGE(PG8_SB(1, 1), b3 + hstep, voffB);
            PG8_WAIT_V(6); PG8_BAR; PG8_MMA(1, 1, At, B1); PG8_BAR;
            }
        }
        if constexpr (ALIGN_EPI) { if (wr == 0) PG8_BAR; }
        if constexpr (!Epi::AFTER_DRAIN) { E(acc, cur, wr, wc, fr, fq); S.done(cur); }
        if (!has_next) break;
#pragma unroll
        for (int a = 0; a < 2; ++a)
#pragma unroll
            for (int b = 0; b < 2; ++b)
#pragma unroll
                for (int m = 0; m < 4; ++m)
#pragma unroll
                    for (int n = 0; n < 2; ++n) acc[a][b][m][n] = (f32x4){0.f, 0.f, 0.f, 0.f};
        cur = nxt; cA = nA; cB = nB; ++ui;
        if constexpr (ALIGN_EPI) { if (wr == 1) PG8_BAR; }
    }
    PG8_WAIT_V(0);
    if constexpr (!ALIGN_EPI) { if (wr == 0) PG8_BAR; }
    PG8_BAR;
    if constexpr (Epi::AFTER_DRAIN) { E.fused(acc, cur, wr, wc, fr, fq, lds, wid, lane); S.done(cur); }
#undef PG8_SA
#undef PG8_SB
#undef PG8_STAGE
#undef PG8_LDA
#undef PG8_LDB
#undef PG8_MMA
#undef PG8_WAIT_V
#undef PG8_WAIT_L
#undef PG8_BAR
#undef PG8_SCHED
}
}
#define LAS __attribute__((address_space(3)))
typedef unsigned short bf16_t;
typedef unsigned v4u __attribute__((ext_vector_type(4)));
typedef unsigned v2u __attribute__((ext_vector_type(2)));
typedef short bf16x8_t __attribute__((ext_vector_type(8)));
typedef float f32x4 __attribute__((ext_vector_type(4)));

constexpr int TOK = 32768, DM = 1024, SEQ = 8192;
constexpr int BPROJ = 3328;
constexpr size_t MiB = 1ull << 20;
constexpr size_t WS_CTL = 0;
constexpr size_t WS_BAR = 512 * 1024;
constexpr size_t WS_SCALE = 0;
constexpr size_t WS_WA_IN = 1 * MiB;
constexpr size_t WS_WA_OUT = 9 * MiB;
constexpr size_t WS_WB_IN = 13 * MiB;
constexpr size_t WS_WB_OUT = 20 * MiB;
constexpr size_t WS_WP = 22 * MiB;
constexpr size_t WS_H = 32 * MiB;
constexpr size_t WS_EID = 96 * MiB;
constexpr size_t WS_GATE = 112 * MiB;
constexpr size_t WS_TAB = 128 * MiB;
constexpr size_t WS_BIG = 192 * MiB;
constexpr size_t WS_GLR = WS_BIG + 305 * MiB;
constexpr size_t WS_WA_IN8 = WS_BIG + 309 * MiB;
constexpr size_t WS_WB_IN8 = WS_BIG + 313 * MiB;
constexpr size_t WS_WB_OUT8 = WS_BIG + 317 * MiB;
constexpr size_t WS_SB_OUT = 352 * 1024;
constexpr size_t WS_SA_IN = 288 * 1024;
constexpr size_t WS_SB_IN = 320 * 1024;
constexpr int LDS_BYTES = 147456;

struct Params { const float* in[21]; float* out; unsigned char* ws; };

__device__ __forceinline__ bf16_t f2bf(float f) { unsigned u = __float_as_uint(f); u += 0x7FFFu + ((u >> 16) & 1u); return (bf16_t)(u >> 16); }
__device__ __forceinline__ unsigned pk2(float lo, float hi) { return (unsigned)f2bf(lo) | ((unsigned)f2bf(hi) << 16); }
__device__ __forceinline__ float bf2f(bf16_t b) { return __uint_as_float(((unsigned)b) << 16); }
__device__ __forceinline__ float gelu_exact(float x) { return 0.5f * x * (1.0f + erff(x * 0.70710678118654752f)); }
__device__ __forceinline__ float wave_sum(float v) {
#pragma unroll
  for (int o = 32; o > 0; o >>= 1) v += __shfl_xor(v, o);
  return v;
}

typedef __bf16 bf16x2_t __attribute__((ext_vector_type(2)));
__device__ __forceinline__ float dot2bf(unsigned a, unsigned b, float c) { return __builtin_amdgcn_fdot2_f32_bf16(__builtin_bit_cast(bf16x2_t, a), __builtin_bit_cast(bf16x2_t, b), c, false); }
__device__ __forceinline__ float wave_sum_dpp(float v) {
  int x;
  x = __builtin_amdgcn_mov_dpp(__float_as_int(v), 0xB1, 0xF, 0xF, true); v += __int_as_float(x);
  x = __builtin_amdgcn_mov_dpp(__float_as_int(v), 0x4E, 0xF, 0xF, true); v += __int_as_float(x);
  x = __builtin_amdgcn_mov_dpp(__float_as_int(v), 0x141, 0xF, 0xF, true); v += __int_as_float(x);
  x = __builtin_amdgcn_mov_dpp(__float_as_int(v), 0x140, 0xF, 0xF, true); v += __int_as_float(x);
  const int vi = __float_as_int(v);
  return (__int_as_float(__builtin_amdgcn_readlane(vi, 0)) + __int_as_float(__builtin_amdgcn_readlane(vi, 16))) +
         (__int_as_float(__builtin_amdgcn_readlane(vi, 32)) + __int_as_float(__builtin_amdgcn_readlane(vi, 48)));
}
__device__ __forceinline__ float gelu_as(float v) {
  const float av = fabsf(v), t = __builtin_amdgcn_rcpf(av * 0.2316418882f + 1.0f);
  float q = t * 0.5307027145f + (-0.7265760135f); q = q * t + 0.7107068705f; q = q * t + (-0.142248368f); q = q * t + 0.127414796f; q = q * t;
  const float e = __builtin_amdgcn_exp2f((v * v) * (-0.72134752044f));
  const float m = v * (q * e);
  return v < 0.f ? m : v - m;
}

__device__ __forceinline__ void fold_item(const Params& P, int it, int lane, LAS float* scr) {
  const int kk0 = (it & 63) * 16, half = (it >> 6) & 1, head = (it >> 7) & 7, layer = it >> 10;
  const float* kx = (half ? P.in[18] : P.in[17]) + (size_t)layer * 16384;
  const float* wq = P.in[16] + (size_t)layer * 1024 * 2048 + head * 256 + half * 128;
#pragma unroll
  for (int i = 0; i < 8; ++i) { const int e = i * 64 + lane, r = e >> 5, c4 = e & 31;
    const float4 v = *(const float4*)(wq + (size_t)(kk0 + r) * 2048 + c4 * 4);
    *(LAS f32x4*)(scr + r * 128 + c4 * 4) = (f32x4){v.x, v.y, v.z, v.w}; }
  asm volatile("s_waitcnt lgkmcnt(0)" ::: "memory");
  float a0[16], a1[16];
#pragma unroll
  for (int i = 0; i < 16; ++i) { a0[i] = 0.f; a1[i] = 0.f; }
#pragma unroll 2
  for (int d4 = 0; d4 < 32; ++d4) {
    const float4 x0 = *(const float4*)(kx + (size_t)lane * 128 + d4 * 4), x1 = *(const float4*)(kx + (size_t)(lane + 64) * 128 + d4 * 4);
#pragma unroll
    for (int kk = 0; kk < 16; ++kk) {
      const f32x4 b = *(const LAS f32x4*)(scr + kk * 128 + d4 * 4);
      a0[kk] += x0.x * b[0] + x0.y * b[1] + x0.z * b[2] + x0.w * b[3];
      a1[kk] += x1.x * b[0] + x1.y * b[1] + x1.z * b[2] + x1.w * b[3];
    }
  }
  asm volatile("s_waitcnt lgkmcnt(0)" ::: "memory");
  bf16_t* wt = (bf16_t*)(P.ws + WS_WP) + (size_t)layer * 2048 * 1024;
  bf16_t* r0 = wt + (size_t)(head * 256 + half * 128 + lane) * 1024 + kk0;
  bf16_t* r1 = r0 + (size_t)64 * 1024;
  v4u o;
  o.x = pk2(a0[0], a0[1]); o.y = pk2(a0[2], a0[3]); o.z = pk2(a0[4], a0[5]); o.w = pk2(a0[6], a0[7]); *(v4u*)r0 = o;
  o.x = pk2(a0[8], a0[9]); o.y = pk2(a0[10], a0[11]); o.z = pk2(a0[12], a0[13]); o.w = pk2(a0[14], a0[15]); *(v4u*)(r0 + 8) = o;
  o.x = pk2(a1[0], a1[1]); o.y = pk2(a1[2], a1[3]); o.z = pk2(a1[4], a1[5]); o.w = pk2(a1[6], a1[7]); *(v4u*)r1 = o;
  o.x = pk2(a1[8], a1[9]); o.y = pk2(a1[10], a1[11]); o.z = pk2(a1[12], a1[13]); o.w = pk2(a1[14], a1[15]); *(v4u*)(r1 + 8) = o;
}

__device__ __forceinline__ float wave_max_dpp(float v) {
  v = fmaxf(v, __int_as_float(__builtin_amdgcn_mov_dpp(__float_as_int(v), 0xB1, 0xF, 0xF, true)));
  v = fmaxf(v, __int_as_float(__builtin_amdgcn_mov_dpp(__float_as_int(v), 0x4E, 0xF, 0xF, true)));
  v = fmaxf(v, __int_as_float(__builtin_amdgcn_mov_dpp(__float_as_int(v), 0x141, 0xF, 0xF, true)));
  v = fmaxf(v, __int_as_float(__builtin_amdgcn_mov_dpp(__float_as_int(v), 0x140, 0xF, 0xF, true)));
  const int vi = __float_as_int(v);
  return fmaxf(fmaxf(__int_as_float(__builtin_amdgcn_readlane(vi, 0)), __int_as_float(__builtin_amdgcn_readlane(vi, 16))),
               fmaxf(__int_as_float(__builtin_amdgcn_readlane(vi, 32)), __int_as_float(__builtin_amdgcn_readlane(vi, 48))));
}
__device__ __forceinline__ int wave_isum_dpp(int v) {
  v += __builtin_amdgcn_mov_dpp(v, 0xB1, 0xF, 0xF, true);
  v += __builtin_amdgcn_mov_dpp(v, 0x4E, 0xF, 0xF, true);
  v += __builtin_amdgcn_mov_dpp(v, 0x141, 0xF, 0xF, true);
  v += __builtin_amdgcn_mov_dpp(v, 0x140, 0xF, 0xF, true);
  return (__builtin_amdgcn_readlane(v, 0) + __builtin_amdgcn_readlane(v, 16)) + (__builtin_amdgcn_readlane(v, 32) + __builtin_amdgcn_readlane(v, 48));
}
__device__ __forceinline__ unsigned q8(float x, float inv) { const int q = (int)rintf(x * inv); return (unsigned)(q < -127 ? -127 : (q > 127 ? 127 : q)) & 0xFFu; }
__device__ __forceinline__ void tabconv8_row(const Params& P, int r, const float4 (&v)[4], int lane) {
  const int row = r & 16383, tab = (r >> 14) & 1, layer = r >> 15;
  float am = 0.f;
#pragma unroll
  for (int i = 0; i < 4; ++i) am = fmaxf(am, fmaxf(fmaxf(fabsf(v[i].x), fabsf(v[i].y)), fmaxf(fabsf(v[i].z), fabsf(v[i].w))));
  am = wave_max_dpp(am);
  const float sc = am > 0.f ? am * (1.0f / 127.0f) : 1.0f, inv = 1.0f / sc;
  const unsigned off = 0u;
  v4u o; unsigned w[4];
#pragma unroll
  for (int i = 0; i < 4; ++i) w[i] = ((q8(v[i].x, inv) | (q8(v[i].y, inv) << 8) | (q8(v[i].z, inv) << 16) | (q8(v[i].w, inv) << 24)) ^ off);
  o.x = w[0]; o.y = w[1]; o.z = w[2]; o.w = w[3];
  *(v4u*)(P.ws + WS_TAB + (size_t)(layer * 2 + tab) * 16 * MiB + ((size_t)(lane >> 3) * 16384 + row) * 128 + (lane & 7) * 16) = o;
  if (lane == 0) ((float*)(P.ws + WS_SCALE))[(layer * 2 + tab) * 16384 + row] = sc;
}
__device__ __forceinline__ void tabconv8_load(const Params& P, int r, float4 (&v)[4], int lane) {
  const int row = r & 16383, tab = (r >> 14) & 1, layer = r >> 15;
  const float* src = P.in[19 + tab] + ((size_t)layer * 16384 + row) * 1024;
#pragma unroll
  for (int i = 0; i < 4; ++i) v[i] = tab ? *(const float4*)(src + lane * 16 + i * 4) : *(const float4*)(src + i * 256 + lane * 4);
}
__device__ __forceinline__ void phase_tabconv8(const Params& P) {
  const int lane = threadIdx.x & 63, wave = __builtin_amdgcn_readfirstlane(threadIdx.x >> 6);
  const int gw = blockIdx.x * 8 + wave, NGW = gridDim.x * 8;
  float4 a[4], b[4], c[4], d[4];
  for (int r = gw; r < 4 * 16384; r += 4 * NGW) {
    tabconv8_load(P, r, a, lane);
    if (r + NGW < 4 * 16384) tabconv8_load(P, r + NGW, b, lane);
    if (r + 2 * NGW < 4 * 16384) tabconv8_load(P, r + 2 * NGW, c, lane);
    if (r + 3 * NGW < 4 * 16384) tabconv8_load(P, r + 3 * NGW, d, lane);
    tabconv8_row(P, r, a, lane);
    if (r + NGW < 4 * 16384) tabconv8_row(P, r + NGW, b, lane);
    if (r + 2 * NGW < 4 * 16384) tabconv8_row(P, r + 2 * NGW, c, lane);
    if (r + 3 * NGW < 4 * 16384) tabconv8_row(P, r + 3 * NGW, d, lane);
  }
}

constexpr size_t WS_GSU = WS_H;
constexpr size_t WS_GSV = WS_GATE;
__device__ __forceinline__ unsigned enc_key(float s) { const unsigned b = __float_as_uint(s); return (b & 0x80000000u) ? ~b : (b | 0x80000000u); }
__device__ __forceinline__ float dec_key(unsigned u) { return __uint_as_float((u & 0x80000000u) ? (u & 0x7FFFFFFFu) : ~u); }
#define TK_CE(a, b) do { const unsigned _hi = (a) > (b) ? (a) : (b), _lo = (a) > (b) ? (b) : (a); (a) = _hi; (b) = _lo; } while (0)
__device__ __forceinline__ void sort16_desc(unsigned (&k)[16]) {
#pragma unroll
  for (int size = 2; size <= 16; size <<= 1)
#pragma unroll
    for (int stride = size >> 1; stride > 0; stride >>= 1)
#pragma unroll
      for (int i = 0; i < 16; ++i) { const int j = i ^ stride; if (j > i) { if ((i & size) == 0) TK_CE(k[i], k[j]); else TK_CE(k[j], k[i]); } }
}
__device__ __forceinline__ void merge16_desc(unsigned (&k)[16]) {
#pragma unroll
  for (int stride = 8; stride > 0; stride >>= 1)
#pragma unroll
    for (int i = 0; i < 16; ++i) { const int j = i ^ stride; if (j > i) TK_CE(k[i], k[j]); }
}
__device__ __forceinline__ void topmerge16(unsigned (&R)[16], const unsigned (&N)[16]) {
#pragma unroll
  for (int i = 0; i < 16; ++i) R[i] = R[i] > N[15 - i] ? R[i] : N[15 - i];
  merge16_desc(R);
}
__device__ __forceinline__ void topk_ld(const _Float16* wbase, int step, int lane, v4u (&g)[4]) {
#pragma unroll
  for (int i = 0; i < 4; ++i) g[i] = *(const v4u*)(wbase + (size_t)(i * 16 + (lane >> 2)) * 256 + step * 32 + (lane & 3) * 8);
}
__device__ __forceinline__ void topk_put(LAS unsigned char* tile, int lane, const v4u (&g)[4]) {
#pragma unroll
  for (int i = 0; i < 4; ++i) *(LAS v4u*)(tile + (i * 16 + (lane >> 2)) * 80 + (lane & 3) * 16) = g[i];
}
__device__ __forceinline__ void topk_group(LAS unsigned char* tile, int lane, int sub, int gcol, unsigned (&N)[16]) {
  typedef _Float16 h2 __attribute__((ext_vector_type(2)));
#pragma unroll
  for (int q = 0; q < 2; ++q) { const v4u v = *(const LAS v4u*)(tile + lane * 80 + sub * 32 + q * 16); const unsigned vv[4] = {v.x, v.y, v.z, v.w};
#pragma unroll
    for (int j = 0; j < 4; ++j) { const h2 hh = __builtin_bit_cast(h2, vv[j]);
      N[q * 8 + 2 * j + 0] = (enc_key((float)hh.x) & ~0x7Fu) | (unsigned)(127 - (gcol + q * 8 + 2 * j + 0));
      N[q * 8 + 2 * j + 1] = (enc_key((float)hh.y) & ~0x7Fu) | (unsigned)(127 - (gcol + q * 8 + 2 * j + 1)); } }
  sort16_desc(N);
}

__device__ __forceinline__ void phase_topk(const Params& P, LAS unsigned char* lds, int layer) {
  const _Float16* S = (const _Float16*)(P.ws + WS_BIG);
  int* EID = (int*)(P.ws + WS_EID); float* GSU = (float*)(P.ws + WS_GSU); float* GSV = (float*)(P.ws + WS_GSV);
  const float* scu = (const float*)(P.ws + WS_SCALE) + layer * 32768; const float* scv = scu + 16384;
  int lane = threadIdx.x & 63; const int wave = __builtin_amdgcn_readfirstlane(threadIdx.x >> 6);
  asm volatile("" : "+v"(lane));
  LAS unsigned char* my = lds + (wave * 64 + lane) * 36;
  LAS unsigned char* tile = lds + 20480 + wave * 10240;
  const int NT = gridDim.x * blockDim.x;
  for (int row = blockIdx.x * blockDim.x + wave * 64 + lane; row < TOK * 8; row += NT) {
    const _Float16* wbase = S + (size_t)(row - lane) * 256;
    unsigned R1[16], R2[16];
    v4u ld[4];
    topk_ld(wbase, 0, lane, ld);
#pragma unroll
    for (int st = 0; st < 8; ++st) {
      LAS unsigned char* tl = tile + (st & 1) * 5120;
      topk_put(tl, lane, ld);
      if (st + 1 < 8) topk_ld(wbase, st + 1, lane, ld);
#pragma unroll
      for (int sub = 0; sub < 2; ++sub) {
        const int gi = st * 2 + sub;
        unsigned N[16];
        topk_group(tl, lane, sub, (gi & 7) * 16, N);
        if (gi == 0) {
#pragma unroll
          for (int i = 0; i < 16; ++i) R1[i] = N[i];
        } else if (gi < 8) topmerge16(R1, N);
        else if (gi == 8) {
#pragma unroll
          for (int i = 0; i < 16; ++i) R2[i] = N[i];
        } else topmerge16(R2, N);
      }
    }
    float v1[16], v2[16];
#pragma unroll
    for (int i = 0; i < 16; ++i) { v1[i] = dec_key(R1[i] & ~0x7Fu); v2[i] = dec_key(R2[i] & ~0x7Fu); my[i] = (unsigned char)(127u - (R1[i] & 0x7Fu)); my[16 + i] = (unsigned char)(127u - (R2[i] & 0x7Fu)); }
    unsigned C[64];
    {
      int n = 0;
#pragma unroll
      for (int a = 0; a < 16; ++a)
#pragma unroll
        for (int b = 0; b < 16; ++b)
          if ((a + 1) * (b + 1) <= 16) { C[n] = (enc_key(v1[a] + v2[b]) & ~0xFFu) | (unsigned)(255 - (a * 16 + b)); ++n; }
#pragma unroll
      for (int i = 50; i < 64; ++i) C[i] = 0u;
    }
    unsigned R[16], N[16];
#pragma unroll
    for (int i = 0; i < 16; ++i) R[i] = C[i];
    sort16_desc(R);
#pragma unroll
    for (int g = 1; g < 4; ++g) {
#pragma unroll
      for (int i = 0; i < 16; ++i) N[i] = C[g * 16 + i];
      sort16_desc(N); topmerge16(R, N);
    }
    float ev[16]; int ei[16]; float sum = 0.f;
    const float mx = dec_key(R[0] & ~0xFFu);
#pragma unroll
    for (int i = 0; i < 16; ++i) {
      const unsigned pos = 255u - (R[i] & 0xFFu);
      ev[i] = __expf(dec_key(R[i] & ~0xFFu) - mx); sum += ev[i];
      ei[i] = (int)my[pos >> 4] * 128 + (int)my[16 + (pos & 15u)];
    }
    const float inv = 1.0f / sum;
#pragma unroll
    for (int q = 0; q < 4; ++q) {
      *(int4*)(EID + (size_t)row * 16 + q * 4) = make_int4(ei[q * 4], ei[q * 4 + 1], ei[q * 4 + 2], ei[q * 4 + 3]);
      *(float4*)(GSU + (size_t)row * 16 + q * 4) = make_float4(scu[ei[q * 4]], scu[ei[q * 4 + 1]], scu[ei[q * 4 + 2]], scu[ei[q * 4 + 3]]);
      *(float4*)(GSV + (size_t)row * 16 + q * 4) = make_float4(ev[q * 4] * inv * scv[ei[q * 4]], ev[q * 4 + 1] * inv * scv[ei[q * 4 + 1]], ev[q * 4 + 2] * inv * scv[ei[q * 4 + 2]], ev[q * 4 + 3] * inv * scv[ei[q * 4 + 3]]);
    }
  }
}

constexpr size_t WS_H8 = WS_BIG + 256 * MiB;
constexpr size_t WS_SH = WS_BIG + 288 * MiB;
constexpr size_t WS_W = WS_BIG + 289 * MiB;
constexpr size_t WS_WQ = WS_W;
constexpr size_t WS_SW = WS_W + 8 * MiB;
struct VHdr { int4 e[4]; v4u wq; float sw; };
__device__ __forceinline__ void vs_hdr(VHdr& h, const Params& P, int tok, int g) {
  const int4* ep = (const int4*)((const int*)(P.ws + WS_EID) + (size_t)tok * 128 + g * 16);
#pragma unroll
  for (int i = 0; i < 4; ++i) h.e[i] = ep[i];
  h.wq = *(const v4u*)(P.ws + WS_WQ + (size_t)tok * 128 + g * 16);
  h.sw = ((const float*)(P.ws + WS_SW))[tok];
}
#define VS_BP(v, x) __builtin_amdgcn_ds_bpermute((lane ^ (x)) * 4, (v))
template <bool DRY>
__device__ __forceinline__ void vs_step(const Params& P, const VHdr& cur, VHdr& pre, int tok, int pf_tok, const unsigned char* VS, int x, int lane) {
  const int g = lane >> 3, p = lane & 7;
  const int ee[16] = {cur.e[0].x, cur.e[0].y, cur.e[0].z, cur.e[0].w, cur.e[1].x, cur.e[1].y, cur.e[1].z, cur.e[1].w, cur.e[2].x, cur.e[2].y, cur.e[2].z, cur.e[2].w, cur.e[3].x, cur.e[3].y, cur.e[3].z, cur.e[3].w};
  v4u vb[16];
#pragma unroll
  for (int it = 0; it < 16; ++it) vb[it] = *(const v4u*)(VS + (unsigned)(ee[it] * 128 + p * 16));
  float* op = P.out + (size_t)tok * 1024 + x * 128 + p * 16 + g * 2;
  const float2 xo = *(const float2*)op;
  vs_hdr(pre, P, pf_tok < TOK ? pf_tok : tok, g);
  const unsigned wq[4] = {cur.wq.x, cur.wq.y, cur.wq.z, cur.wq.w};
  const float sw = cur.sw;
  int acc[16];
#pragma unroll
  for (int i = 0; i < 16; ++i) acc[i] = 0;
#pragma unroll
  for (int k = 0; k < 4; ++k) {
    const unsigned ra[4] = {vb[4 * k].x, vb[4 * k].y, vb[4 * k].z, vb[4 * k].w}, rb[4] = {vb[4 * k + 1].x, vb[4 * k + 1].y, vb[4 * k + 1].z, vb[4 * k + 1].w};
    const unsigned rc[4] = {vb[4 * k + 2].x, vb[4 * k + 2].y, vb[4 * k + 2].z, vb[4 * k + 2].w}, rd[4] = {vb[4 * k + 3].x, vb[4 * k + 3].y, vb[4 * k + 3].z, vb[4 * k + 3].w};
#pragma unroll
    for (int i = 0; i < 4; ++i) {
      const unsigned ablo = __builtin_amdgcn_perm(rb[i], ra[i], 0x05010400u), abhi = __builtin_amdgcn_perm(rb[i], ra[i], 0x07030602u);
      const unsigned cdlo = __builtin_amdgcn_perm(rd[i], rc[i], 0x05010400u), cdhi = __builtin_amdgcn_perm(rd[i], rc[i], 0x07030602u);
      acc[4 * i + 0] = __builtin_amdgcn_sdot4((int)__builtin_amdgcn_perm(cdlo, ablo, 0x05040100u), (int)wq[k], acc[4 * i + 0], false);
      acc[4 * i + 1] = __builtin_amdgcn_sdot4((int)__builtin_amdgcn_perm(cdlo, ablo, 0x07060302u), (int)wq[k], acc[4 * i + 1], false);
      acc[4 * i + 2] = __builtin_amdgcn_sdot4((int)__builtin_amdgcn_perm(cdhi, abhi, 0x05040100u), (int)wq[k], acc[4 * i + 2], false);
      acc[4 * i + 3] = __builtin_amdgcn_sdot4((int)__builtin_amdgcn_perm(cdhi, abhi, 0x07060302u), (int)wq[k], acc[4 * i + 3], false);
    }
  }
  const bool b5 = lane & 32, b4 = lane & 16, b3 = lane & 8;
  int r8[8], r4[4], r2[2];
#pragma unroll
  for (int i = 0; i < 8; ++i) { const int keep = b5 ? acc[8 + i] : acc[i], send = b5 ? acc[i] : acc[8 + i]; r8[i] = keep + VS_BP(send, 32); }
#pragma unroll
  for (int i = 0; i < 4; ++i) { const int keep = b4 ? r8[4 + i] : r8[i], send = b4 ? r8[i] : r8[4 + i]; r4[i] = keep + VS_BP(send, 16); }
#pragma unroll
  for (int i = 0; i < 2; ++i) { const int keep = b3 ? r4[2 + i] : r4[i], send = b3 ? r4[i] : r4[2 + i]; r2[i] = keep + VS_BP(send, 8); }
  float2 o; o.x = xo.x + (float)r2[0] * sw; o.y = xo.y + (float)r2[1] * sw;
  if (!DRY || o.x == 1234.5f) *(float2*)op = o;
}
template <bool DRY>
__device__ __forceinline__ void phase_vslice(const Params& P, int layer) {
  int lane = threadIdx.x & 63; const int wave = __builtin_amdgcn_readfirstlane(threadIdx.x >> 6);
  asm volatile("" : "+v"(lane));
  const int nsl = (gridDim.x & 7) == 0 ? 8 : 0;
  const int g = lane >> 3;
  const int wi = (nsl ? (blockIdx.x >> 3) : blockIdx.x) * 8 + wave, NW = (nsl ? (gridDim.x >> 3) : gridDim.x) * 8;
  for (int xs = 0; xs < (nsl ? 1 : 8); ++xs) {
    const int x = nsl ? (blockIdx.x & 7) : xs;
    const unsigned char* VS = P.ws + WS_TAB + (size_t)(layer * 2 + 1) * 16 * MiB + (size_t)x * 2 * MiB;
    if (wi >= TOK) continue;
    VHdr h0, h1, h2;
    vs_hdr(h0, P, wi, g);
    vs_hdr(h1, P, wi + NW < TOK ? wi + NW : wi, g);
    for (int tok = wi; tok < TOK; tok += 3 * NW) {
      vs_step<DRY>(P, h0, h2, tok, tok + 2 * NW, VS, x, lane);
      if (tok + NW >= TOK) break;
      vs_step<DRY>(P, h1, h0, tok + NW, tok + 3 * NW, VS, x, lane);
      if (tok + 2 * NW >= TOK) break;
      vs_step<DRY>(P, h2, h1, tok + 2 * NW, tok + 4 * NW, VS, x, lane);
    }
  }
}
__device__ __forceinline__ void phase_final_norm(const Params& P, const float* g) {
  const int lane = threadIdx.x & 63, wave = __builtin_amdgcn_readfirstlane(threadIdx.x >> 6);
  const int gw = blockIdx.x * 8 + wave, NGW = gridDim.x * 8;
  float4 gg[4];
#pragma unroll
  for (int i = 0; i < 4; ++i) gg[i] = *(const float4*)(g + i * 256 + lane * 4);
  for (int tok = gw; tok < TOK; tok += NGW) {
    float* xo = P.out + (size_t)tok * 1024;
    float4 x[4]; float ss = 0.f;
#pragma unroll
    for (int i = 0; i < 4; ++i) { x[i] = *(const float4*)(xo + i * 256 + lane * 4); ss += x[i].x * x[i].x + x[i].y * x[i].y + x[i].z * x[i].z + x[i].w * x[i].w; }
    ss = wave_sum_dpp(ss);
    const float rs = rsqrtf(ss * (1.0f / 1024.0f) + 1e-6f);
#pragma unroll
    for (int i = 0; i < 4; ++i) { float4 y; y.x = x[i].x * rs * gg[i].x; y.y = x[i].y * rs * gg[i].y; y.z = x[i].z * rs * gg[i].z; y.w = x[i].w * rs * gg[i].w; *(float4*)(xo + i * 256 + lane * 4) = y; }
  }
}

constexpr size_t WS_PART = WS_BIG + 128 * MiB;
struct UsHdr { int4 e[4]; v4u hq; };
__device__ __forceinline__ void us_hdr(UsHdr& h, const Params& P, int tok, int g, int p, int x) {
  const int4* ep = (const int4*)((const int*)(P.ws + WS_EID) + (size_t)tok * 128 + g * 16);
#pragma unroll
  for (int i = 0; i < 4; ++i) h.e[i] = ep[i];
  h.hq = *(const v4u*)(P.ws + WS_H8 + (size_t)tok * 1024 + x * 128 + p * 16);
}
template <bool DRY>
__device__ __forceinline__ void us_step(const Params& P, const UsHdr& cur, UsHdr& pre, int tok, int pf_tok, const unsigned char* US, int x, int lane) {
  const int g = lane >> 3, p = lane & 7;
  const int ee[16] = {cur.e[0].x, cur.e[0].y, cur.e[0].z, cur.e[0].w, cur.e[1].x, cur.e[1].y, cur.e[1].z, cur.e[1].w, cur.e[2].x, cur.e[2].y, cur.e[2].z, cur.e[2].w, cur.e[3].x, cur.e[3].y, cur.e[3].z, cur.e[3].w};
  v4u ub[16];
#pragma unroll
  for (int it = 0; it < 16; ++it) ub[it] = *(const v4u*)(US + (unsigned)(ee[it] * 128 + p * 16));
  us_hdr(pre, P, pf_tok < TOK ? pf_tok : tok, g, p, x);
  int r0 = 0, r1 = 0;
#pragma unroll
  for (int it = 0; it < 16; ++it) {
    int is = __builtin_amdgcn_sdot4((int)ub[it].x, (int)cur.hq.x, 0, false);
    is = __builtin_amdgcn_sdot4((int)ub[it].y, (int)cur.hq.y, is, false);
    is = __builtin_amdgcn_sdot4((int)ub[it].z, (int)cur.hq.z, is, false);
    is = __builtin_amdgcn_sdot4((int)ub[it].w, (int)cur.hq.w, is, false);
    is += __builtin_amdgcn_mov_dpp(is, 0xB1, 0xF, 0xF, true); is += __builtin_amdgcn_mov_dpp(is, 0x4E, 0xF, 0xF, true); is += __builtin_amdgcn_mov_dpp(is, 0x141, 0xF, 0xF, true);
    if (it < 8) r0 = (p == it) ? is : r0; else r1 = (p == it - 8) ? is : r1;
  }
  _Float16* part = (_Float16*)(P.ws + WS_PART) + ((size_t)x * TOK + tok) * 128 + g * 16 + p;
  if (!DRY || r0 == 0x7FFFFFFF) { part[0] = (_Float16)((float)r0 * 0.015625f); part[8] = (_Float16)((float)r1 * 0.015625f); }
}
template <bool DRY>
__device__ __forceinline__ void phase_uslice(const Params& P, int layer) {
  int lane = threadIdx.x & 63; const int wave = __builtin_amdgcn_readfirstlane(threadIdx.x >> 6);
  asm volatile("" : "+v"(lane));
  const int nsl = (gridDim.x & 7) == 0 ? 8 : 0;
  const int g = lane >> 3, p = lane & 7;
  const int wi = (nsl ? (blockIdx.x >> 3) : blockIdx.x) * 8 + wave, NW = (nsl ? (gridDim.x >> 3) : gridDim.x) * 8;
  for (int xs = 0; xs < (nsl ? 1 : 8); ++xs) {
    const int x = nsl ? (blockIdx.x & 7) : xs;
    const unsigned char* US = P.ws + WS_TAB + (size_t)(layer * 2) * 16 * MiB + (size_t)x * 2 * MiB;
    if (wi >= TOK) continue;
    UsHdr h0, h1, h2;
    us_hdr(h0, P, wi, g, p, x);
    us_hdr(h1, P, wi + NW < TOK ? wi + NW : wi, g, p, x);
    for (int tok = wi; tok < TOK; tok += 3 * NW) {
      us_step<DRY>(P, h0, h2, tok, tok + 2 * NW, US, x, lane);
      if (tok + NW >= TOK) break;
      us_step<DRY>(P, h1, h0, tok + NW, tok + 3 * NW, US, x, lane);
      if (tok + 2 * NW >= TOK) break;
      us_step<DRY>(P, h2, h1, tok + 2 * NW, tok + 4 * NW, US, x, lane);
    }
  }
}
__device__ __forceinline__ void phase_ureduce(const Params& P) {
  const _Float16* PART = (const _Float16*)(P.ws + WS_PART); const float* GSU = (const float*)(P.ws + WS_GSU); const float* GSV = (const float*)(P.ws + WS_GSV);
  const float* SH = (const float*)(P.ws + WS_SH); unsigned* WQ = (unsigned*)(P.ws + WS_WQ); float* SW = (float*)(P.ws + WS_SW);
  const int lane = threadIdx.x & 63;
  const size_t n4 = (size_t)TOK * 128 / 4, NT = (size_t)gridDim.x * blockDim.x;
  for (size_t i = (size_t)blockIdx.x * blockDim.x + threadIdx.x; i < n4; i += NT) {
    typedef _Float16 h4 __attribute__((ext_vector_type(4)));
    float s0 = 0.f, s1 = 0.f, s2 = 0.f, s3 = 0.f;
#pragma unroll
    for (int x = 0; x < 8; ++x) { const h4 t = *(const h4*)(PART + (size_t)x * TOK * 128 + i * 4); s0 += (float)t[0]; s1 += (float)t[1]; s2 += (float)t[2]; s3 += (float)t[3]; }
    s0 *= 64.f; s1 *= 64.f; s2 *= 64.f; s3 *= 64.f;
    const float4 su = *(const float4*)(GSU + i * 4), gv = *(const float4*)(GSV + i * 4);
    const float sh = SH[i >> 5];
    float4 w;
    w.x = gv.x * gelu_as(s0 * (su.x * sh)); w.y = gv.y * gelu_as(s1 * (su.y * sh));
    w.z = gv.z * gelu_as(s2 * (su.z * sh)); w.w = gv.w * gelu_as(s3 * (su.w * sh));
    float wm = fmaxf(fmaxf(fabsf(w.x), fabsf(w.y)), fmaxf(fabsf(w.z), fabsf(w.w)));
    wm = fmaxf(wm, __int_as_float(__builtin_amdgcn_mov_dpp(__float_as_int(wm), 0xB1, 0xF, 0xF, true)));
    wm = fmaxf(wm, __int_as_float(__builtin_amdgcn_mov_dpp(__float_as_int(wm), 0x4E, 0xF, 0xF, true)));
    wm = fmaxf(wm, __int_as_float(__builtin_amdgcn_mov_dpp(__float_as_int(wm), 0x141, 0xF, 0xF, true)));
    wm = fmaxf(wm, __int_as_float(__builtin_amdgcn_mov_dpp(__float_as_int(wm), 0x140, 0xF, 0xF, true)));
    wm = fmaxf(wm, __int_as_float(__builtin_amdgcn_ds_bpermute((lane ^ 16) * 4, __float_as_int(wm))));
    const float sw = wm > 0.f ? wm * (1.0f / 127.0f) : 1.0f, winv = 1.0f / sw;
    WQ[i] = q8(w.x, winv) | (q8(w.y, winv) << 8) | (q8(w.z, winv) << 16) | (q8(w.w, winv) << 24);
    if ((lane & 31) == 0) SW[i >> 5] = sw;
  }
}
constexpr int GA_PITCH = 136;
constexpr int GA_WL = 0;
constexpr int GA_VT = 34816;
constexpr int GA_ST = 34816 + 69632;
template <bool DRY>
__device__ __forceinline__ void phase_gate_a(const Params& P, LAS unsigned char* lds) {
  const int tid = threadIdx.x, lane = tid & 63, wave = __builtin_amdgcn_readfirstlane(tid >> 6);
  bf16_t* U = (bf16_t*)(P.ws + WS_BIG); const bf16_t* V = U + (size_t)TOK * 2048;
  const float* ln_g = P.in[6]; const float* ln_b = P.in[7]; const float* w_s = P.in[8]; const float* b_s = P.in[9];
  LAS bf16_t* Wl = (LAS bf16_t*)(lds + GA_WL); LAS bf16_t* vT = (LAS bf16_t*)(lds + GA_VT); LAS float* st = (LAS float*)(lds + GA_ST);
  for (int chunk = blockIdx.x; chunk < TOK / 128; chunk += gridDim.x) {
    const size_t T0 = (size_t)chunk * 128;
    for (int i = 0; i < 16; ++i) {
      const int t = wave * 16 + i;
      const bf16_t* vr = V + (T0 + t) * 2048;
      float x[32]; float s = 0.f;
#pragma unroll
      for (int j = 0; j < 4; ++j) { const v4u w = *(const v4u*)(vr + (j * 64 + lane) * 8); const unsigned ww[4] = {w.x, w.y, w.z, w.w};
#pragma unroll
        for (int q = 0; q < 4; ++q) { x[j * 8 + 2 * q] = __uint_as_float(ww[q] << 16); x[j * 8 + 2 * q + 1] = __uint_as_float(ww[q] & 0xFFFF0000u); s += x[j * 8 + 2 * q] + x[j * 8 + 2 * q + 1]; } }
      s = wave_sum_dpp(s); const float mu = s * (1.0f / 2048.0f);
      float q2 = 0.f;
#pragma unroll
      for (int j = 0; j < 32; ++j) { const float d = x[j] - mu; q2 += d * d; }
      q2 = wave_sum_dpp(q2);
      if (lane == 0) { st[2 * t] = mu; st[2 * t + 1] = rsqrtf(q2 * (1.0f / 2048.0f) + 1e-6f); }
    }
    __syncthreads();
    for (int g = 0; g < 8; ++g) {
      {
        const int t = tid >> 2, c0 = (tid & 3) * 32;
        const float* src = w_s + ((size_t)g * 128 + t) * 128 + c0;
#pragma unroll
        for (int q = 0; q < 4; ++q) {
          const float4 a = *(const float4*)(src + q * 8), b = *(const float4*)(src + q * 8 + 4);
          const int s0 = c0 + q * 8;
          v4u o;
          o.x = pk2(s0 + 0 <= t ? a.x : 0.f, s0 + 1 <= t ? a.y : 0.f); o.y = pk2(s0 + 2 <= t ? a.z : 0.f, s0 + 3 <= t ? a.w : 0.f);
          o.z = pk2(s0 + 4 <= t ? b.x : 0.f, s0 + 5 <= t ? b.y : 0.f); o.w = pk2(s0 + 6 <= t ? b.z : 0.f, s0 + 7 <= t ? b.w : 0.f);
          *(LAS v4u*)(Wl + t * GA_PITCH + s0) = o;
        }
      }
      {
        const int sh0 = (wave & 1) * 64 + (lane >> 2), cq = (wave >> 1) * 64 + (lane & 3) * 8;
#pragma unroll
        for (int jc = 0; jc < 2; ++jc) {
          const int c0 = cq + jc * 32;
          const float4 ga = *(const float4*)(ln_g + g * 256 + c0), gb = *(const float4*)(ln_g + g * 256 + c0 + 4), ba = *(const float4*)(ln_b + g * 256 + c0), bb = *(const float4*)(ln_b + g * 256 + c0 + 4);
          const float gg[8] = {ga.x, ga.y, ga.z, ga.w, gb.x, gb.y, gb.z, gb.w}, bv[8] = {ba.x, ba.y, ba.z, ba.w, bb.x, bb.y, bb.z, bb.w};
#pragma unroll
          for (int jr = 0; jr < 4; ++jr) {
            const int s = sh0 + jr * 16;
            const float mu = st[2 * s], rs = st[2 * s + 1];
            const v4u w = *(const v4u*)(V + (T0 + s) * 2048 + g * 256 + c0); const unsigned ww[4] = {w.x, w.y, w.z, w.w};
#pragma unroll
            for (int q = 0; q < 4; ++q) {
              const float y0 = (__uint_as_float(ww[q] << 16) - mu) * rs * gg[2 * q] + bv[2 * q];
              const float y1 = (__uint_as_float(ww[q] & 0xFFFF0000u) - mu) * rs * gg[2 * q + 1] + bv[2 * q + 1];
              vT[(c0 + 2 * q) * GA_PITCH + s] = f2bf(y0); vT[(c0 + 2 * q + 1) * GA_PITCH + s] = f2bf(y1);
            }
          }
        }
      }
      __syncthreads();
      f32x4 acc[2][8];
#pragma unroll
      for (int ci = 0; ci < 2; ++ci)
#pragma unroll
        for (int jt = 0; jt < 8; ++jt) acc[ci][jt] = (f32x4){0.f, 0.f, 0.f, 0.f};
      const int fr = lane & 15, fq = lane >> 4;
#pragma unroll
      for (int kb = 0; kb < 4; ++kb) {
        bf16x8_t a[2];
#pragma unroll
        for (int ci = 0; ci < 2; ++ci) a[ci] = *(const LAS bf16x8_t*)(vT + (wave * 32 + ci * 16 + fr) * GA_PITCH + kb * 32 + fq * 8);
#pragma unroll
        for (int jt = 0; jt < 8; ++jt) {
          if (kb <= (jt >> 1)) {
            const bf16x8_t b = *(const LAS bf16x8_t*)(Wl + (jt * 16 + fr) * GA_PITCH + kb * 32 + fq * 8);
#pragma unroll
            for (int ci = 0; ci < 2; ++ci) acc[ci][jt] = __builtin_amdgcn_mfma_f32_16x16x32_bf16(a[ci], b, acc[ci][jt], 0, 0, 0);
          }
        }
      }
#pragma unroll
      for (int jt = 0; jt < 8; ++jt) {
        const int t = jt * 16 + fr; const float bs = b_s[g * 128 + t];
#pragma unroll
        for (int ci = 0; ci < 2; ++ci) {
          bf16_t* up = U + (T0 + t) * 2048 + g * 256 + wave * 32 + ci * 16 + fq * 4;
          const v2u uu = *(const v2u*)up;
          v2u o;
          o.x = pk2(__uint_as_float(uu.x << 16) * (acc[ci][jt][0] + bs), __uint_as_float(uu.x & 0xFFFF0000u) * (acc[ci][jt][1] + bs));
          o.y = pk2(__uint_as_float(uu.y << 16) * (acc[ci][jt][2] + bs), __uint_as_float(uu.y & 0xFFFF0000u) * (acc[ci][jt][3] + bs));
          if (!DRY || acc[ci][jt][0] == 1234.5f) *(v2u*)up = o;
        }
      }
      __syncthreads();
    }
  }
}
constexpr size_t WS_PROJ = WS_BIG;
constexpr size_t WS_QT = WS_BIG + 208 * MiB;
constexpr size_t WS_KT = WS_BIG + 240 * MiB;
constexpr size_t WS_AM = WS_BIG + 272 * MiB;
constexpr size_t WS_DEC = WS_BIG + 288 * MiB;
constexpr size_t WS_O = WS_H;
__device__ __forceinline__ float row16_sum_dpp(float v) {
  int x;
  x = __builtin_amdgcn_mov_dpp(__float_as_int(v), 0xB1, 0xF, 0xF, true); v += __int_as_float(x);
  x = __builtin_amdgcn_mov_dpp(__float_as_int(v), 0x4E, 0xF, 0xF, true); v += __int_as_float(x);
  x = __builtin_amdgcn_mov_dpp(__float_as_int(v), 0x141, 0xF, 0xF, true); v += __int_as_float(x);
  x = __builtin_amdgcn_mov_dpp(__float_as_int(v), 0x140, 0xF, 0xF, true); v += __int_as_float(x);
  return v;
}

__device__ __forceinline__ void phase_gla_prep(const Params& P, LAS unsigned char* lds) {
  const int tid = threadIdx.x, lane = tid & 63, wave = __builtin_amdgcn_readfirstlane(tid >> 6);
  const int fr = lane & 15, fq = lane >> 4;
  const bf16_t* PROJ = (const bf16_t*)(P.ws + WS_PROJ);
  bf16_t* QT = (bf16_t*)(P.ws + WS_QT); bf16_t* KT = (bf16_t*)(P.ws + WS_KT); bf16_t* AM = (bf16_t*)(P.ws + WS_AM); float* DEC = (float*)(P.ws + WS_DEC);
  const float* w_g2 = P.in[12]; const float* b_g = P.in[13];
  LAS bf16_t* ql = (LAS bf16_t*)lds; LAS bf16_t* kl = (LAS bf16_t*)(lds + 17408); LAS float* tot = (LAS float*)(lds + 34816);
  const int kk = tid & 127, tq = wave >> 1;
  const float scale = 0.08838834764831845f;
  for (int item = blockIdx.x; item < 2048; item += gridDim.x) {
    const int h = item & 3; const size_t T0 = (size_t)(item >> 2) * 64;
    bf16_t qraw[16], kraw[16];
#pragma unroll
    for (int i = 0; i < 16; ++i) { const bf16_t* pr = PROJ + (T0 + tq * 16 + i) * BPROJ + h * 128 + kk; qraw[i] = pr[0]; kraw[i] = pr[512]; }
    float wg[16];
#pragma unroll
    for (int j = 0; j < 16; ++j) wg[j] = w_g2[j * 512 + h * 128 + kk];
    const float bg = b_g[h * 128 + kk];
    float G[16]; float run = 0.f;
#pragma unroll
    for (int i = 0; i < 16; ++i) {
      const float* gl = (const float*)(P.ws + WS_GLR) + (T0 + tq * 16 + i) * 16;
      const float4 g0 = *(const float4*)gl, g1 = *(const float4*)(gl + 4), g2 = *(const float4*)(gl + 8), g3 = *(const float4*)(gl + 12);
      const float gw[16] = {g0.x, g0.y, g0.z, g0.w, g1.x, g1.y, g1.z, g1.w, g2.x, g2.y, g2.z, g2.w, g3.x, g3.y, g3.z, g3.w};
      float a = bg;
#pragma unroll
      for (int j = 0; j < 16; ++j) a += gw[j] * wg[j];
      const float ls = fminf(a, 0.f) - log1pf(__expf(-fabsf(a)));
      run += ls * 0.0625f; G[i] = run;
    }
    tot[tq * 128 + kk] = run;
    __syncthreads();
    float off = 0.f, glast = 0.f;
#pragma unroll
    for (int q = 0; q < 4; ++q) { const float v = tot[q * 128 + kk]; off += (q < tq) ? v : 0.f; glast += v; }
    unsigned kh[8];
#pragma unroll
    for (int i = 0; i < 16; ++i) {
      const int t = tq * 16 + i; const float Gi = G[i] + off;
      const float qv = bf2f(qraw[i]) * scale * __expf(Gi);
      const float kv = bf2f(kraw[i]);
      const bf16_t qb = f2bf(qv);
      ql[t * 136 + kk] = qb; kl[t * 136 + kk] = f2bf(kv * __expf(-Gi));
      QT[((size_t)item * 64 + t) * 128 + kk] = qb;
      const unsigned khb = f2bf(kv * __expf(glast - Gi));
      if (i & 1) kh[i >> 1] |= khb << 16; else kh[i >> 1] = khb;
    }
    {
      bf16_t* kt = KT + ((size_t)item * 128 + kk) * 64 + tq * 16;
      v4u o; o.x = kh[0]; o.y = kh[1]; o.z = kh[2]; o.w = kh[3]; *(v4u*)kt = o;
      o.x = kh[4]; o.y = kh[5]; o.z = kh[6]; o.w = kh[7]; *(v4u*)(kt + 8) = o;
    }
    if (tq == 0) DEC[(size_t)item * 128 + kk] = __expf(glast);
    __syncthreads();
#pragma unroll
    for (int u = 0; u < 2; ++u) {
      const int tile = wave * 2 + u, si = tile >> 2, ti = tile & 3;
      f32x4 acc = (f32x4){0.f, 0.f, 0.f, 0.f};
      if (si <= ti) {
#pragma unroll
        for (int ks = 0; ks < 4; ++ks) {
          const bf16x8_t a = *(const LAS bf16x8_t*)(kl + (si * 16 + fr) * 136 + ks * 32 + fq * 8);
          const bf16x8_t b = *(const LAS bf16x8_t*)(ql + (ti * 16 + fr) * 136 + ks * 32 + fq * 8);
          acc = __builtin_amdgcn_mfma_f32_16x16x32_bf16(a, b, acc, 0, 0, 0);
        }
      }
      const int t = ti * 16 + fr, s0 = si * 16 + 4 * fq;
      v2u o;
      o.x = pk2(s0 + 0 <= t ? acc[0] : 0.f, s0 + 1 <= t ? acc[1] : 0.f);
      o.y = pk2(s0 + 2 <= t ? acc[2] : 0.f, s0 + 3 <= t ? acc[3] : 0.f);
      *(v2u*)(AM + ((size_t)item * 64 + t) * 64 + s0) = o;
    }
    __syncthreads();
  }
}

struct GlaFrag { bf16x8_t am[2], q[4], k[2]; f32x4 dec; v4u vr[2]; };
template <int ROLE>
__device__ __forceinline__ void gla_load(GlaFrag& F, const Params& P, int b, int h, int vs, int c, int wave, int lane) {
  const int fr = lane & 15, fq = lane >> 4;
  const size_t item = ((size_t)b * 128 + c) * 4 + h;
  const bf16_t* QT = (const bf16_t*)(P.ws + WS_QT); const bf16_t* KT = (const bf16_t*)(P.ws + WS_KT); const bf16_t* AM = (const bf16_t*)(P.ws + WS_AM); const float* DEC = (const float*)(P.ws + WS_DEC);
  if (ROLE == 0) {
    const bf16_t* ar = AM + (item * 64 + wave * 16 + fr) * 64 + fq * 8;
    F.am[0] = *(const bf16x8_t*)ar; F.am[1] = *(const bf16x8_t*)(ar + 32);
    const bf16_t* qr = QT + (item * 64 + wave * 16 + fr) * 128 + fq * 8;
#pragma unroll
    for (int kq = 0; kq < 4; ++kq) F.q[kq] = *(const bf16x8_t*)(qr + kq * 32);
  }
  const bf16_t* kr = KT + (item * 128 + wave * 16 + fr) * 64 + fq * 8;
  F.k[0] = *(const bf16x8_t*)kr; F.k[1] = *(const bf16x8_t*)(kr + 32);
  F.dec = *(const f32x4*)(DEC + item * 128 + wave * 16 + fq * 4);
  if (ROLE == 1) {
    const bf16_t* vp = (const bf16_t*)(P.ws + WS_PROJ) + ((size_t)b * SEQ + (size_t)c * 64 + lane) * BPROJ + 1024 + h * 256 + vs * 16;
    F.vr[0] = *(const v4u*)vp; F.vr[1] = *(const v4u*)(vp + 8);
  }
}
__device__ __forceinline__ void gla_write_vt(LAS bf16_t* vT, const GlaFrag& F, int lane) {
  const unsigned w[8] = {F.vr[0].x, F.vr[0].y, F.vr[0].z, F.vr[0].w, F.vr[1].x, F.vr[1].y, F.vr[1].z, F.vr[1].w};
#pragma unroll
  for (int i = 0; i < 8; ++i) { vT[(2 * i) * 72 + lane] = (bf16_t)(w[i] & 0xFFFFu); vT[(2 * i + 1) * 72 + lane] = (bf16_t)(w[i] >> 16); }
}
template <int ROLE, int MODE>
__device__ __forceinline__ void gla_step(const Params& P, const GlaFrag& cur, const GlaFrag& nxt, GlaFrag& pre, int b, int h, int vs, int c, int wave, int lane, LAS bf16_t* vT, LAS bf16_t* ST, f32x4& S) {
  const int fr = lane & 15, fq = lane >> 4;
  bf16_t* O = (bf16_t*)(P.ws + WS_O);
  if (MODE != 2) gla_load<ROLE>(pre, P, b, h, vs, c + 2 < 128 ? c + 2 : 127, wave, lane);
  const bf16x8_t v0 = *(const LAS bf16x8_t*)(vT + fr * 72 + fq * 8), v1 = *(const LAS bf16x8_t*)(vT + fr * 72 + 32 + fq * 8);
  if (ROLE == 0) {
    f32x4 o = (f32x4){0.f, 0.f, 0.f, 0.f};
    o = __builtin_amdgcn_mfma_f32_16x16x32_bf16(v0, cur.am[0], o, 0, 0, 0);
    o = __builtin_amdgcn_mfma_f32_16x16x32_bf16(v1, cur.am[1], o, 0, 0, 0);
#pragma unroll
    for (int kq = 0; kq < 4; ++kq) {
      const bf16x8_t s = *(const LAS bf16x8_t*)(ST + fr * 136 + kq * 32 + fq * 8);
      o = __builtin_amdgcn_mfma_f32_16x16x32_bf16(s, cur.q[kq], o, 0, 0, 0);
    }
    v2u ow; ow.x = pk2(o[0], o[1]); ow.y = pk2(o[2], o[3]);
    if (MODE == 0 || o[0] == 1234.5f) *(v2u*)(O + ((size_t)b * SEQ + (size_t)c * 64 + wave * 16 + fr) * 1024 + h * 256 + vs * 16 + fq * 4) = ow;
  }
  S = S * cur.dec;
  S = __builtin_amdgcn_mfma_f32_16x16x32_bf16(cur.k[0], v0, S, 0, 0, 0);
  S = __builtin_amdgcn_mfma_f32_16x16x32_bf16(cur.k[1], v1, S, 0, 0, 0);
  if (MODE != 1) __syncthreads();
  { v2u sw; sw.x = pk2(S[0], S[1]); sw.y = pk2(S[2], S[3]); *(LAS v2u*)(ST + fr * 136 + wave * 16 + fq * 4) = sw; }
  if (ROLE == 1 && c + 1 < 128) gla_write_vt(vT, nxt, lane);
  if (MODE != 1) __syncthreads();
}
template <int ROLE, int MODE>
__device__ __forceinline__ void gla_scan_role(const Params& P, LAS unsigned char* lds, int wave, int lane) {
  const int fr = lane & 15, fq = lane >> 4;
  LAS bf16_t* vT = (LAS bf16_t*)lds;
  LAS bf16_t* ST = (LAS bf16_t*)(lds + 2304);
  for (int wid = blockIdx.x; wid < 256; wid += gridDim.x) {
    const int xcd = wid & 7, jj = wid >> 3, pair = xcd * 2 + (jj >> 4), vs = jj & 15, b = pair >> 2, h = pair & 3;
    f32x4 S = (f32x4){0.f, 0.f, 0.f, 0.f};
    GlaFrag f0, f1, f2;
    gla_load<ROLE>(f0, P, b, h, vs, 0, wave, lane);
    gla_load<ROLE>(f1, P, b, h, vs, 1, wave, lane);
    __syncthreads();
    *(LAS v2u*)(ST + fr * 136 + wave * 16 + fq * 4) = (v2u){0u, 0u};
    if (ROLE == 1) gla_write_vt(vT, f0, lane);
    __syncthreads();
    for (int c = 0; c < 128; c += 3) {
      gla_step<ROLE, MODE>(P, f0, f1, f2, b, h, vs, c, wave, lane, vT, ST, S);
      if (c + 1 >= 128) break;
      gla_step<ROLE, MODE>(P, f1, f2, f0, b, h, vs, c + 1, wave, lane, vT, ST, S);
      if (c + 2 >= 128) break;
      gla_step<ROLE, MODE>(P, f2, f0, f1, b, h, vs, c + 2, wave, lane, vT, ST, S);
    }
  }
}
template <int MODE = 0>
__device__ __forceinline__ void phase_gla_scan(const Params& P, LAS unsigned char* lds) {
  const int lane = threadIdx.x & 63, wave = __builtin_amdgcn_readfirstlane(threadIdx.x >> 6);
  if (wave < 4) gla_scan_role<0, MODE>(P, lds, wave, lane);
  else if (wave == 4) gla_scan_role<1, MODE>(P, lds, wave, lane);
  else gla_scan_role<2, MODE>(P, lds, wave, lane);
}

struct PostIn { v4u o0, o1, r0, r1; };
__device__ __forceinline__ void gla_post_load(PostIn& x, const Params& P, int tok, int lane) {
  const bf16_t* O = (const bf16_t*)(P.ws + WS_O); const bf16_t* PROJ = (const bf16_t*)(P.ws + WS_PROJ);
  x.o0 = *(const v4u*)(O + (size_t)tok * 1024 + lane * 16); x.o1 = *(const v4u*)(O + (size_t)tok * 1024 + lane * 16 + 8);
  x.r0 = *(const v4u*)(PROJ + (size_t)tok * BPROJ + 2048 + lane * 16); x.r1 = *(const v4u*)(PROJ + (size_t)tok * BPROJ + 2048 + lane * 16 + 8);
}
__device__ __forceinline__ void gla_post_row(const PostIn& in, const Params& P, int tok, int lane, const float (&gn)[16]) {
  const unsigned ow[8] = {in.o0.x, in.o0.y, in.o0.z, in.o0.w, in.o1.x, in.o1.y, in.o1.z, in.o1.w}, rw[8] = {in.r0.x, in.r0.y, in.r0.z, in.r0.w, in.r1.x, in.r1.y, in.r1.z, in.r1.w};
  float x[16], r[16]; float ss = 0.f;
#pragma unroll
  for (int i = 0; i < 8; ++i) { x[2 * i] = __uint_as_float(ow[i] << 16); x[2 * i + 1] = __uint_as_float(ow[i] & 0xFFFF0000u); r[2 * i] = __uint_as_float(rw[i] << 16); r[2 * i + 1] = __uint_as_float(rw[i] & 0xFFFF0000u);
    ss += x[2 * i] * x[2 * i] + x[2 * i + 1] * x[2 * i + 1]; }
  ss = row16_sum_dpp(ss);
  const float rs = rsqrtf(ss * (1.0f / 256.0f) + 1e-6f);
  float y[16];
#pragma unroll
  for (int i = 0; i < 16; ++i) { const float sl = r[i] * __builtin_amdgcn_rcpf(1.0f + __expf(-r[i])); y[i] = x[i] * rs * gn[i] * sl; }
  float am = 0.f;
#pragma unroll
  for (int i = 0; i < 16; ++i) am = fmaxf(am, fabsf(y[i]));
  am = wave_max_dpp(am);
  const float sc = am > 0.f ? am * (1.0f / 127.0f) : 1.0f, inv = 1.0f / sc;
  v4u q;
  q.x = q8(y[0], inv) | (q8(y[1], inv) << 8) | (q8(y[2], inv) << 16) | (q8(y[3], inv) << 24);
  q.y = q8(y[4], inv) | (q8(y[5], inv) << 8) | (q8(y[6], inv) << 16) | (q8(y[7], inv) << 24);
  q.z = q8(y[8], inv) | (q8(y[9], inv) << 8) | (q8(y[10], inv) << 16) | (q8(y[11], inv) << 24);
  q.w = q8(y[12], inv) | (q8(y[13], inv) << 8) | (q8(y[14], inv) << 16) | (q8(y[15], inv) << 24);
  *(v4u*)(P.ws + WS_H8 + (size_t)tok * 1024 + lane * 16) = q;
  if (lane == 0) ((float*)(P.ws + WS_SH))[tok] = sc;
}
__device__ __forceinline__ void phase_gla_post(const Params& P) {
  const int lane = threadIdx.x & 63, wave = __builtin_amdgcn_readfirstlane(threadIdx.x >> 6);
  const int gw = blockIdx.x * 8 + wave, NGW = gridDim.x * 8;
  const float* ng = P.in[14] + (lane & 15) * 16;
  float gn[16];
#pragma unroll
  for (int q = 0; q < 4; ++q) { const float4 g4 = *(const float4*)(ng + q * 4); gn[q * 4] = g4.x; gn[q * 4 + 1] = g4.y; gn[q * 4 + 2] = g4.z; gn[q * 4 + 3] = g4.w; }
  PostIn a, b, c, d;
  for (int tok = gw; tok < TOK; tok += 4 * NGW) {
    const bool vb = tok + NGW < TOK, vc = tok + 2 * NGW < TOK, vd = tok + 3 * NGW < TOK;
    gla_post_load(a, P, tok, lane);
    if (vb) gla_post_load(b, P, tok + NGW, lane);
    if (vc) gla_post_load(c, P, tok + 2 * NGW, lane);
    if (vd) gla_post_load(d, P, tok + 3 * NGW, lane);
    gla_post_row(a, P, tok, lane, gn);
    if (vb) gla_post_row(b, P, tok + NGW, lane, gn);
    if (vc) gla_post_row(c, P, tok + 2 * NGW, lane, gn);
    if (vd) gla_post_row(d, P, tok + 3 * NGW, lane, gn);
  }
}
__device__ __forceinline__ void transpose_item(const float* W, int K, int N, bf16_t* WT, LAS float* scr, int item, int nblk, int lane) {
  const int kb = item / nblk, nb = item % nblk, k0 = 64 * kb, n0 = 32 * nb;
  const int nn = n0 + (lane & 31);
#pragma unroll 8
  for (int i = 0; i < 32; ++i) { const int kk = 2 * i + (lane >> 5); scr[kk * 33 + (lane & 31)] = (nn < N) ? W[(size_t)(k0 + kk) * N + nn] : 0.f; }
  asm volatile("s_waitcnt lgkmcnt(0)" ::: "memory");
  const int c = lane & 7;
#pragma unroll
  for (int j = 0; j < 4; ++j) { const int n = (lane >> 3) + 8 * j; const LAS float* s = scr + (8 * c) * 33 + n;
    v4u o; o.x = pk2(s[0 * 33], s[1 * 33]); o.y = pk2(s[2 * 33], s[3 * 33]); o.z = pk2(s[4 * 33], s[5 * 33]); o.w = pk2(s[6 * 33], s[7 * 33]);
    *(v4u*)(WT + (size_t)(n0 + n) * K + k0 + 8 * c) = o; }
  asm volatile("s_waitcnt lgkmcnt(0)" ::: "memory");
}

__device__ __forceinline__ void phase_prep(const Params& P, LAS unsigned char* lds) {
  const int lane = threadIdx.x & 63, wave = __builtin_amdgcn_readfirstlane(threadIdx.x >> 6);
  LAS float* scr = (LAS float*)(lds + wave * 16384);
  const int gw = blockIdx.x * 8 + wave, NGW = gridDim.x * 8;
  unsigned char* ws = P.ws;
  constexpr int I_AIN = (1024 / 64) * (4096 / 32), I_AOUT = (2048 / 64) * (1024 / 32), I_BIN = (1024 / 64) * (BPROJ / 32), I_BOUT = (1024 / 64) * (1024 / 32), I_FOLD = 2048;
  constexpr int NITEMS = I_AIN + I_AOUT + I_BIN + I_BOUT + I_FOLD;
  for (int it = gw; it < NITEMS; it += NGW) {
    int r = it;
    if (r < I_AIN) { transpose_item(P.in[4], 1024, 4096, (bf16_t*)(ws + WS_WA_IN), scr, r, 4096 / 32, lane); continue; } r -= I_AIN;
    if (r < I_AOUT) { transpose_item(P.in[10], 2048, 1024, (bf16_t*)(ws + WS_WA_OUT), scr, r, 1024 / 32, lane); continue; } r -= I_AOUT;
    if (r < I_BIN) { transpose_item(P.in[11], 1024, 3088, (bf16_t*)(ws + WS_WB_IN), scr, r, BPROJ / 32, lane); continue; } r -= I_BIN;
    if (r < I_BOUT) { transpose_item(P.in[15], 1024, 1024, (bf16_t*)(ws + WS_WB_OUT), scr, r, 1024 / 32, lane); continue; } r -= I_BOUT;
    fold_item(P, r, lane, scr);
  }
}

template <int MODE>
__device__ __forceinline__ void phase_gemm(const Params& P, LAS unsigned char* lds, int layer) {
  unsigned char* ws = P.ws;
  const bf16_t* H = (const bf16_t*)(ws + WS_H);
  if constexpr (MODE == 0) {
    pg8::Gemm g{(const bf16_t*)(ws + WS_H8), (const bf16_t*)(ws + WS_WA_IN8), TOK, 4096, 512}; pg8::StaticOrder S; S.init(TOK, 4096, gridDim.x, blockIdx.x);
    pg8::EpiBf16I8<1> E{(bf16_t*)(ws + WS_BIG), 2048, P.in[5], 2048, (size_t)TOK * 2048, (const float*)(ws + WS_SH), (const float*)(ws + WS_SA_IN)};
    pg8::gemm_phase<pg8::EpiBf16I8<1>, pg8::StaticOrder, true, true, true>(lds, g, S, E);
  } else if constexpr (MODE == 1) {
    pg8::Gemm g{(const bf16_t*)(ws + WS_BIG), (const bf16_t*)(ws + WS_WA_OUT), TOK, 1024, 2048}; pg8::StaticOrder S; S.init(TOK, 1024, gridDim.x, blockIdx.x);
    pg8::EpiResF32 E{P.out, P.in[0], 1024};
    pg8::gemm_phase<pg8::EpiResF32, pg8::StaticOrder, true, true>(lds, g, S, E);
  } else if constexpr (MODE == 2) {
    pg8::Gemm g{H, (const bf16_t*)(ws + WS_WP) + (size_t)layer * 2048 * 1024, TOK, 2048, 1024}; pg8::StaticOrder S; S.init(TOK, 2048, gridDim.x, blockIdx.x);
    pg8::EpiF16 E{(_Float16*)(ws + WS_BIG), 2048};
    pg8::gemm_phase<pg8::EpiF16, pg8::StaticOrder, true, true>(lds, g, S, E);
  } else if constexpr (MODE == 3) {
    pg8::Gemm g{(const bf16_t*)(ws + WS_H8), (const bf16_t*)(ws + WS_WB_IN8), TOK, 3072, 512}; pg8::StaticOrder S; S.init(TOK, 3072, gridDim.x, blockIdx.x);
    pg8::EpiBf16I8<0> E{(bf16_t*)(ws + WS_BIG), BPROJ, nullptr, 0, 0, (const float*)(ws + WS_SH), (const float*)(ws + WS_SB_IN)};
    pg8::gemm_phase<pg8::EpiBf16I8<0>, pg8::StaticOrder, true, true, true>(lds, g, S, E);
  } else {
    pg8::Gemm g{(const bf16_t*)(ws + WS_H8), (const bf16_t*)(ws + WS_WB_OUT8), TOK, 1024, 512}; pg8::StaticOrder S; S.init(TOK, 1024, gridDim.x, blockIdx.x);
    pg8::EpiResF32I8 E{P.out, P.out, (const float*)(ws + WS_SH), (const float*)(ws + WS_SB_OUT), 1024};
    pg8::gemm_phase<pg8::EpiResF32I8, pg8::StaticOrder, true, true, true>(lds, g, S, E);
  }
}

#define RLX_AGENT __ATOMIC_RELAXED, __HIP_MEMORY_SCOPE_AGENT
#define XB_TMO      128
#define XB_XCNT(j)  (256  + 64 * (j))
#define XB_XSUB(j)  (1280 + 64 * (j))
#define XB_XGEN(j)  (2304 + 64 * (j))
#define XB_TOP      3328
#define XB_TOPGEN   3392
#define XCD_BAR_WORDS 3456
#define XB_SPIN_CAP (1u << 18)

__device__ __forceinline__ unsigned xb_ld(unsigned* p)              { return __hip_atomic_load(p, __ATOMIC_RELAXED, __HIP_MEMORY_SCOPE_AGENT); }
__device__ __forceinline__ unsigned xb_add(unsigned* p, unsigned v) { return __hip_atomic_fetch_add(p, v, __ATOMIC_RELAXED, __HIP_MEMORY_SCOPE_AGENT); }
__device__ __forceinline__ unsigned xb_xcc_id() { return (unsigned)__builtin_amdgcn_s_getreg((3 << 11) | 20) & 0xFu; }
#define XB_SPIN(cond, bar) do { unsigned _sp = 0; while (cond) { __builtin_amdgcn_s_sleep(1); \
    if ((++_sp & 255u) == 0u) { if (xb_ld(&(bar)[XB_TMO])) break; if (_sp > XB_SPIN_CAP) { atomicAdd(&(bar)[XB_TMO], 1u); break; } } } } while (0)

struct XcdBarrier {
    unsigned* bar; unsigned x;
    volatile LAS unsigned* st;
};

__device__ __forceinline__ XcdBarrier xcd_barrier_post(unsigned* bar, volatile LAS unsigned* st) {
    XcdBarrier b; b.bar = bar; b.x = xb_xcc_id(); b.st = st;
    if (threadIdx.x == 0) (void)xb_add(&bar[XB_XCNT(b.x)], 1u);
    return b;
}
__device__ __forceinline__ void xcd_barrier_complete(unsigned* bar, unsigned x, unsigned& nloc, unsigned& nx) {
    const unsigned G = gridDim.x * gridDim.y * gridDim.z;
    unsigned sum, cnt, mine, sp = 0u;
    for (;;) {
        sum = 0u; cnt = 0u; mine = 0u;
#pragma unroll
        for (unsigned j = 0; j < 16; ++j) { const unsigned c = xb_ld(&bar[XB_XCNT(j)]); sum += c; cnt += (c > 0u) ? 1u : 0u; mine = (j == x) ? c : mine; }
        if (sum == G) break;
        __builtin_amdgcn_s_sleep(1);
        if ((++sp & 255u) == 0u) { if (xb_ld(&bar[XB_TMO])) break; if (sp > XB_SPIN_CAP) { atomicAdd(&bar[XB_TMO], 1u); break; } }
    }
    nloc = mine > 0u ? mine : 1u; nx = cnt > 0u ? cnt : 1u;
}

__device__ __forceinline__ void xcd_barrier(const XcdBarrier& b) {
    asm volatile("s_waitcnt vmcnt(0)" ::: "memory");
    __syncthreads();
    if (threadIdx.x == 0) {
        unsigned* bar = b.bar;
        __builtin_amdgcn_s_waitcnt(0);
        unsigned nloc = b.st[0], nx = b.st[1];
        if (nloc == 0u) { xcd_barrier_complete(bar, b.x, nloc, nx); b.st[0] = nloc; b.st[1] = nx; }
        const unsigned old = xb_add(&bar[XB_XSUB(b.x)], 1u);
        const unsigned gen = old / nloc;
        if (old + 1u == (gen + 1u) * nloc) {
            __builtin_amdgcn_fence(__ATOMIC_RELEASE, "agent");
            asm volatile("s_waitcnt vmcnt(0)" ::: "memory");
            const unsigned og = xb_add(&bar[XB_TOP], 1u);
            const unsigned tg = og / nx;
            if (og + 1u == (tg + 1u) * nx) xb_add(&bar[XB_TOPGEN], 1u);
            else XB_SPIN(xb_ld(&bar[XB_TOPGEN]) == tg, bar);
            __builtin_amdgcn_fence(__ATOMIC_ACQUIRE, "agent");
            xb_add(&bar[XB_XGEN(b.x)], 1u);
            asm volatile("s_waitcnt vmcnt(0)" ::: "memory");
        } else {
            XB_SPIN(xb_ld(&bar[XB_XGEN(b.x)]) == gen, bar);
            __builtin_amdgcn_fence(__ATOMIC_ACQUIRE, "agent");
            asm volatile("s_waitcnt vmcnt(0)" ::: "memory");
        }
    }
    __syncthreads();
}


__device__ __forceinline__ void phase_glr(const Params& P) {
  typedef int i32x4_t __attribute__((ext_vector_type(4)));
  const int lane = threadIdx.x & 63, wave = __builtin_amdgcn_readfirstlane(threadIdx.x >> 6), fr = lane & 15, fq = lane >> 4;
  const unsigned char* H8 = P.ws + WS_H8; const unsigned char* WT = P.ws + WS_WB_IN8 + (size_t)3072 * 1024;
  const float* SH = (const float*)(P.ws + WS_SH); const float* SB = (const float*)(P.ws + WS_SB_IN) + 3072;
  float* GLR = (float*)(P.ws + WS_GLR);
  for (int job = blockIdx.x * 8 + wave; job < TOK / 16; job += gridDim.x * 8) {
    const unsigned char* ar = H8 + ((size_t)job * 16 + fr) * 1024 + fq * 16; const unsigned char* br = WT + (size_t)fr * 1024 + fq * 16;
    i32x4_t acc = (i32x4_t){0, 0, 0, 0};
#pragma unroll 8
    for (int ks = 0; ks < 16; ++ks) acc = __builtin_amdgcn_mfma_i32_16x16x64_i8(*(const i32x4_t*)(ar + ks * 64), *(const i32x4_t*)(br + ks * 64), acc, 0, 0, 0);
    const float sb = SB[fr];
#pragma unroll
    for (int r = 0; r < 4; ++r) { const size_t tk = (size_t)job * 16 + 4 * fq + r; GLR[tk * 16 + fr] = (float)acc[r] * (SH[tk] * sb); }
  }
}

template <bool EMIT8, bool WRITE_H = true>
__device__ __forceinline__ void rmsnorm_row(const Params& P, int tok, float4 (&x)[4], const float4 (&gg)[4], int lane) {
  bf16_t* H = (bf16_t*)(P.ws + WS_H);
  float ss = 0.f;
#pragma unroll
  for (int i = 0; i < 4; ++i) ss += x[i].x * x[i].x + x[i].y * x[i].y + x[i].z * x[i].z + x[i].w * x[i].w;
  ss = wave_sum_dpp(ss);
  const float rs = rsqrtf(ss * (1.0f / 1024.0f) + 1e-6f);
  float am = 0.f; unsigned hb[8];
#pragma unroll
  for (int i = 0; i < 4; ++i) {
    x[i].x *= rs * gg[i].x; x[i].y *= rs * gg[i].y; x[i].z *= rs * gg[i].z; x[i].w *= rs * gg[i].w;
    hb[2 * i] = pk2(x[i].x, x[i].y); hb[2 * i + 1] = pk2(x[i].z, x[i].w);
    if (WRITE_H) { v2u o; o.x = hb[2 * i]; o.y = hb[2 * i + 1]; *(v2u*)(H + (size_t)tok * 1024 + i * 256 + lane * 4) = o; }
  }
  if (EMIT8) {
    float hv[16];
#pragma unroll
    for (int i = 0; i < 8; ++i) { hv[2 * i] = __uint_as_float(hb[i] << 16); hv[2 * i + 1] = __uint_as_float(hb[i] & 0xFFFF0000u); am = fmaxf(am, fmaxf(fabsf(hv[2 * i]), fabsf(hv[2 * i + 1]))); }
    am = wave_max_dpp(am);
    const float sh = am > 0.f ? am * (1.0f / 127.0f) : 1.0f, hinv = 1.0f / sh;
    v4u q;
    q.x = q8(hv[0], hinv) | (q8(hv[1], hinv) << 8) | (q8(hv[2], hinv) << 16) | (q8(hv[3], hinv) << 24);
    q.y = q8(hv[4], hinv) | (q8(hv[5], hinv) << 8) | (q8(hv[6], hinv) << 16) | (q8(hv[7], hinv) << 24);
    q.z = q8(hv[8], hinv) | (q8(hv[9], hinv) << 8) | (q8(hv[10], hinv) << 16) | (q8(hv[11], hinv) << 24);
    q.w = q8(hv[12], hinv) | (q8(hv[13], hinv) << 8) | (q8(hv[14], hinv) << 16) | (q8(hv[15], hinv) << 24);
    *(v4u*)(P.ws + WS_H8 + (size_t)tok * 1024 + lane * 16) = q;
    if (lane == 0) ((float*)(P.ws + WS_SH))[tok] = sh;
  }
}
template <bool EMIT8, bool WRITE_H = true>
__device__ __forceinline__ void phase_rmsnorm(const Params& P, const float* src, const float* g) {
  const int lane = threadIdx.x & 63, wave = __builtin_amdgcn_readfirstlane(threadIdx.x >> 6);
  const int gw = blockIdx.x * 8 + wave, NGW = gridDim.x * 8;
  float4 gg[4];
#pragma unroll
  for (int i = 0; i < 4; ++i) gg[i] = *(const float4*)(g + i * 256 + lane * 4);
  float4 xa[4], xb[4], xc[4], xd[4];
  for (int tok = gw; tok < TOK; tok += 4 * NGW) {
    const bool vb = tok + NGW < TOK, vc = tok + 2 * NGW < TOK, vd = tok + 3 * NGW < TOK;
#pragma unroll
    for (int i = 0; i < 4; ++i) xa[i] = *(const float4*)(src + (size_t)tok * 1024 + i * 256 + lane * 4);
    if (vb) {
#pragma unroll
      for (int i = 0; i < 4; ++i) xb[i] = *(const float4*)(src + (size_t)(tok + NGW) * 1024 + i * 256 + lane * 4); }
    if (vc) {
#pragma unroll
      for (int i = 0; i < 4; ++i) xc[i] = *(const float4*)(src + (size_t)(tok + 2 * NGW) * 1024 + i * 256 + lane * 4); }
    if (vd) {
#pragma unroll
      for (int i = 0; i < 4; ++i) xd[i] = *(const float4*)(src + (size_t)(tok + 3 * NGW) * 1024 + i * 256 + lane * 4); }
    rmsnorm_row<EMIT8, WRITE_H>(P, tok, xa, gg, lane);
    if (vb) rmsnorm_row<EMIT8, WRITE_H>(P, tok + NGW, xb, gg, lane);
    if (vc) rmsnorm_row<EMIT8, WRITE_H>(P, tok + 2 * NGW, xc, gg, lane);
    if (vd) rmsnorm_row<EMIT8, WRITE_H>(P, tok + 3 * NGW, xd, gg, lane);
  }
}

__device__ __forceinline__ void w8_rows(const Params& P, const bf16_t* src0, unsigned char* dst0, float* sc0, int rows, int lane, int gw, int NGW) {
  for (int r = gw; r < rows; r += NGW) {
    const bf16_t* src = src0 + (size_t)r * 1024;
    float hv[16]; float am = 0.f;
#pragma unroll
    for (int i = 0; i < 4; ++i) { const v2u w = *(const v2u*)(src + i * 256 + lane * 4);
      hv[4 * i] = __uint_as_float(w.x << 16); hv[4 * i + 1] = __uint_as_float(w.x & 0xFFFF0000u); hv[4 * i + 2] = __uint_as_float(w.y << 16); hv[4 * i + 3] = __uint_as_float(w.y & 0xFFFF0000u);
      am = fmaxf(am, fmaxf(fmaxf(fabsf(hv[4 * i]), fabsf(hv[4 * i + 1])), fmaxf(fabsf(hv[4 * i + 2]), fabsf(hv[4 * i + 3])))); }
    am = wave_max_dpp(am);
    const float sc = am > 0.f ? am * (1.0f / 127.0f) : 1.0f, inv = 1.0f / sc;
    v4u q;
    q.x = q8(hv[0], inv) | (q8(hv[1], inv) << 8) | (q8(hv[2], inv) << 16) | (q8(hv[3], inv) << 24);
    q.y = q8(hv[4], inv) | (q8(hv[5], inv) << 8) | (q8(hv[6], inv) << 16) | (q8(hv[7], inv) << 24);
    q.z = q8(hv[8], inv) | (q8(hv[9], inv) << 8) | (q8(hv[10], inv) << 16) | (q8(hv[11], inv) << 24);
    q.w = q8(hv[12], inv) | (q8(hv[13], inv) << 8) | (q8(hv[14], inv) << 16) | (q8(hv[15], inv) << 24);
    *(v4u*)(dst0 + (size_t)r * 1024 + lane * 16) = q;
    if (lane == 0) sc0[r] = sc;
  }
}
__device__ __forceinline__ void phase_w8(const Params& P) {
  const int lane = threadIdx.x & 63, wave = __builtin_amdgcn_readfirstlane(threadIdx.x >> 6);
  const int gw = blockIdx.x * 8 + wave, NGW = gridDim.x * 8;
  w8_rows(P, (const bf16_t*)(P.ws + WS_WA_IN), P.ws + WS_WA_IN8, (float*)(P.ws + WS_SA_IN), 4096, lane, gw, NGW);
  w8_rows(P, (const bf16_t*)(P.ws + WS_WB_IN), P.ws + WS_WB_IN8, (float*)(P.ws + WS_SB_IN), BPROJ, lane, gw, NGW);
  for (int r = gw; r < 1024; r += NGW) {
    const bf16_t* src = (const bf16_t*)(P.ws + WS_WB_OUT) + (size_t)r * 1024 + lane * 16;
    const v4u w0 = *(const v4u*)src, w1 = *(const v4u*)(src + 8); const unsigned ww[8] = {w0.x, w0.y, w0.z, w0.w, w1.x, w1.y, w1.z, w1.w};
    float hv[16]; float am = 0.f;
#pragma unroll
    for (int i = 0; i < 8; ++i) { hv[2 * i] = __uint_as_float(ww[i] << 16); hv[2 * i + 1] = __uint_as_float(ww[i] & 0xFFFF0000u); am = fmaxf(am, fmaxf(fabsf(hv[2 * i]), fabsf(hv[2 * i + 1]))); }
    am = wave_max_dpp(am);
    const float sc = am > 0.f ? am * (1.0f / 127.0f) : 1.0f, inv = 1.0f / sc;
    v4u q;
    q.x = q8(hv[0], inv) | (q8(hv[1], inv) << 8) | (q8(hv[2], inv) << 16) | (q8(hv[3], inv) << 24);
    q.y = q8(hv[4], inv) | (q8(hv[5], inv) << 8) | (q8(hv[6], inv) << 16) | (q8(hv[7], inv) << 24);
    q.z = q8(hv[8], inv) | (q8(hv[9], inv) << 8) | (q8(hv[10], inv) << 16) | (q8(hv[11], inv) << 24);
    q.w = q8(hv[12], inv) | (q8(hv[13], inv) << 8) | (q8(hv[14], inv) << 16) | (q8(hv[15], inv) << 24);
    *(v4u*)(P.ws + WS_WB_OUT8 + (size_t)r * 1024 + lane * 16) = q;
    if (lane == 0) ((float*)(P.ws + WS_SB_OUT))[r] = sc;
  }
}

#ifndef PROBE
#define PROBE 0
#endif
__global__ void __launch_bounds__(512, 2) mega_fwd(Params P) {
  extern __shared__ __attribute__((aligned(16))) unsigned char lds_raw[];
  LAS unsigned char* lds = (LAS unsigned char*)lds_raw;
  cg::grid_group grid = cg::this_grid();
  volatile LAS unsigned* bst = (volatile LAS unsigned*)(lds + 131072 + 64);
  if (threadIdx.x == 0) { bst[0] = 0u; bst[1] = 0u; }
  __syncthreads();
  const XcdBarrier bar = xcd_barrier_post((unsigned*)(P.ws + WS_BAR), bst);
#define SEAM() do { xcd_barrier(bar); } while (0)
#if PROBE & 32
  phase_prep(P, lds); phase_tabconv8(P); phase_rmsnorm<true, false>(P, P.in[0], P.in[1]);
#endif
  phase_prep(P, lds); phase_tabconv8(P); phase_rmsnorm<true, false>(P, P.in[0], P.in[1]);
  grid.sync();
#if PROBE & 8
  phase_gemm<0>(P, lds, 0);
#endif
  phase_w8(P);
  SEAM();
  phase_gemm<0>(P, lds, 0);
  SEAM();
#if PROBE & 262144
  SEAM(); SEAM(); SEAM(); SEAM(); SEAM(); SEAM(); SEAM(); SEAM(); SEAM(); SEAM();
#endif
#if PROBE & 4
  phase_gate_a<true>(P, lds);
#endif
  phase_gate_a<false>(P, lds);
  SEAM();
#if PROBE & 8
  phase_gemm<1>(P, lds, 0);
#endif
  phase_gemm<1>(P, lds, 0);
  SEAM();
#if PROBE & 65536
  phase_rmsnorm<true>(P, P.out, P.in[2]);
#endif
  phase_rmsnorm<true>(P, P.out, P.in[2]);
  SEAM();
#if PROBE & 8
  phase_gemm<2>(P, lds, 0);
#endif
  phase_gemm<2>(P, lds, 0);
  SEAM();
#if PROBE & 16
  phase_topk(P, lds, 0);
#endif
  phase_topk(P, lds, 0);
  SEAM();
  phase_uslice<false>(P, 0);
  SEAM();
  phase_ureduce(P);
  SEAM();
#if PROBE & 1
  phase_vslice<true>(P, 0); SEAM();
#endif
#if PROBE & 256
  phase_uslice<true>(P, 0); SEAM();
#endif
  phase_vslice<false>(P, 0);
  SEAM();
  phase_rmsnorm<true, false>(P, P.out, P.in[1] + 1024);
  SEAM();
#if PROBE & 8
  phase_gemm<3>(P, lds, 0);
#endif
  phase_gemm<3>(P, lds, 0); phase_glr(P);
  SEAM();
#if PROBE & 4098
  phase_gla_prep(P, lds);
#endif
  phase_gla_prep(P, lds);
  SEAM();
#if PROBE & 8194
  phase_gla_scan<3>(P, lds); __syncthreads();
#endif
#if PROBE & 16384
  phase_gla_scan<1>(P, lds); __syncthreads();
#endif
#if PROBE & 32768
  phase_gla_scan<2>(P, lds); __syncthreads();
#endif
  phase_gla_scan(P, lds);
  SEAM();
#if PROBE & 64
  phase_gla_post(P);
#endif
  phase_gla_post(P);
  SEAM();
  phase_gemm<4>(P, lds, 0);
  SEAM();
#if PROBE & 65536
  phase_rmsnorm<true>(P, P.out, P.in[2] + 1024);
#endif
  phase_rmsnorm<true>(P, P.out, P.in[2] + 1024);
  SEAM();
#if PROBE & 131072
  phase_gemm<2>(P, lds, 1);
#endif
  phase_gemm<2>(P, lds, 1);
  SEAM();
#if PROBE & 16
  phase_topk(P, lds, 1);
#endif
  phase_topk(P, lds, 1);
  SEAM();
  phase_uslice<false>(P, 1);
  SEAM();
  phase_ureduce(P);
  SEAM();
#if PROBE & 1
  phase_vslice<true>(P, 1); SEAM();
#endif
  phase_vslice<false>(P, 1);
  SEAM();
  phase_final_norm(P, P.in[3]);
#undef SEAM
}

extern "C" void kernel_launch(void* const* d_in, const int* in_sizes, int n_in, void* d_out, int out_size, void* d_ws, size_t ws_size, hipStream_t stream) {
  static int grid = 0;
  if (grid == 0) {
    int dev = 0, cus = 0, per_cu = 0;
    if (hipGetDevice(&dev) != hipSuccess || hipDeviceGetAttribute(&cus, hipDeviceAttributeMultiprocessorCount, dev) != hipSuccess) { fprintf(stderr, "kernel_launch: device query failed\n"); grid = -1; return; }
    if (hipFuncSetAttribute((const void*)mega_fwd, hipFuncAttributeMaxDynamicSharedMemorySize, LDS_BYTES) != hipSuccess) { fprintf(stderr, "kernel_launch: hipFuncSetAttribute failed\n"); grid = -1; return; }
    if (hipOccupancyMaxActiveBlocksPerMultiprocessor(&per_cu, (const void*)mega_fwd, 512, LDS_BYTES) != hipSuccess || per_cu < 1) { fprintf(stderr, "kernel_launch: occupancy query gave %d\n", per_cu); grid = -1; return; }
    grid = cus * per_cu;
    if (grid > 256) grid = 256;
    fprintf(stderr, "kernel_launch: cus %d per_cu %d grid %d ws %zu\n", cus, per_cu, grid, ws_size);
  }
  if (grid < 0) return;
  (void)hipMemsetAsync((char*)d_ws + WS_BAR, 0, XCD_BAR_WORDS * 4, stream);
  Params P{};
  for (int i = 0; i < 21; ++i) P.in[i] = (const float*)d_in[i];
  P.out = (float*)d_out; P.ws = (unsigned char*)d_ws;
  void* args[] = {&P};
  hipError_t e = hipLaunchCooperativeKernel((const void*)mega_fwd, dim3(grid), dim3(512), args, LDS_BYTES, stream);
  if (e != hipSuccess) fprintf(stderr, "kernel_launch: cooperative launch failed: %s (grid %d)\n", hipGetErrorString(e), grid);
}
```

```cpp
#include <hip/hip_runtime.h>
#include <cstdio>
#include <cstdint>
#include <hip/hip_cooperative_groups.h>
namespace cg = cooperative_groups;
#define PROBE 0
#define VS_VAR 0
namespace pg8 {
#define PG8_LAS __attribute__((address_space(3)))
typedef unsigned short bf16_t;
typedef short bf16x8 __attribute__((ext_vector_type(8)));
typedef float f32x4 __attribute__((ext_vector_type(4)));
typedef unsigned u32x4 __attribute__((ext_vector_type(4)));
constexpr int BM = 256, BK = 64, HALF = 128, HTB = HALF * BK * 2  , STAGE_BYTES = 8 * HTB, NXCD = 8, WGM = 8;

__host__ __device__ __forceinline__ int lds_byte(int r, int c) { const int st = (r >> 4) * 2 + (c >> 5), rr = r & 15, cc = c & 31, ob = rr * 64 + cc * 2; return st * 1024 + (ob ^ (((ob >> 9) & 1) << 5)); }
__host__ __device__ __forceinline__ void stage_rc(int b, int& R, int& C) { const int st = b / 1024, sb = b % 1024, swz = sb ^ (((sb >> 9) & 1) << 5); R = (st >> 1) * 16 + swz / 64; C = (st & 1) * 32 + (swz % 64) / 2; }
__host__ __device__ __forceinline__ int perm32(int rho) { const int n = rho >> 4, i = rho & 15; return 8 * (i >> 2) + 4 * n + (i & 3); }

struct Unit { int pm, pn; };
struct Gemm { const bf16_t* A; const bf16_t* Bt; int M, N, K; };

struct StaticOrder {
    int nM, nN, nwg, G, c;
    __host__ __device__ void init(int M, int N, int G_, int c_) { nM = M / BM; nN = N / BM; nwg = nM * nN; G = G_; c = c_; }
    __host__ __device__ bool next(int i, Unit& u) const {
        const long L = (long)i * G + c; if (L >= nwg) return false;
        int wgid = (int)L; { const int q = nwg / NXCD, r = nwg % NXCD, xcd = wgid % NXCD, off = wgid / NXCD; wgid = (xcd < r ? xcd * (q + 1) : r * (q + 1) + (xcd - r) * q) + off; }
        const int nig = WGM * nN, gid = wgid / nig, fm = gid * WGM, gsz = (nM - fm) < WGM ? (nM - fm) : WGM;
        u.pm = fm + ((wgid % nig) % gsz); u.pn = (wgid % nig) / gsz; return true;
    }
    __device__ __forceinline__ void a_ready(const Unit&) const {}
    __device__ __forceinline__ void done(const Unit&) const {}
};

__device__ __forceinline__ unsigned cvt_pk_bf16(float lo, float hi) { unsigned r; asm volatile("v_cvt_pk_bf16_f32 %0, %1, %2" : "=v"(r) : "v"(lo), "v"(hi)); return r; }
typedef float f32x2 __attribute__((ext_vector_type(2)));
__device__ __forceinline__ f32x2 gelu_pk(f32x2 v) {
    const f32x2 av = __builtin_elementwise_abs(v), d = av * 0.2316418882f + 1.0f;
    f32x2 t; t.x = __builtin_amdgcn_rcpf(d.x); t.y = __builtin_amdgcn_rcpf(d.y);
    f32x2 q = t * 0.5307027145f + (-0.7265760135f); q = q * t + 0.7107068705f; q = q * t + (-0.142248368f); q = q * t + 0.127414796f; q = q * t;
    const f32x2 s = (v * v) * (-0.72134752044f);
    f32x2 e; e.x = __builtin_amdgcn_exp2f(s.x); e.y = __builtin_amdgcn_exp2f(s.y);
    const f32x2 m = v * (q * e), r = v - m;
    f32x2 o; o.x = v.x < 0.f ? m.x : r.x; o.y = v.y < 0.f ? m.y : r.y; return o;
}

template <int ACT  > struct EpiBf16 {
    static constexpr bool PERM = true, AFTER_DRAIN = false; static_assert(ACT == 0 || ACT == 1, "EpiBf16: ACT is 0 (none) or 1 (gelu_pk)");
    bf16_t* O; int ldc; const float* bias; int split_cols; size_t split_stride; float scale0;
    __device__ __forceinline__ void operator()(const f32x4 (&acc)[2][2][4][2], const Unit& u, int wr, int wc, int fr, int fq) const {
        const int row0 = u.pm * BM + wr * 64 + fr; int colt = u.pn * BM; bf16_t* base = O;
        float sc = 1.f; if (split_cols) { const int t = colt / split_cols; base += (size_t)t * split_stride; colt -= t * split_cols; if (t == 0) sc = scale0; }
        const int col0 = colt + wc * 32 + 8 * fq, bcol0 = u.pn * BM + wc * 32 + 8 * fq;
        f32x4 bv[2][2];
#pragma unroll
        for (int bj = 0; bj < 2; ++bj)
#pragma unroll
            for (int n = 0; n < 2; ++n) bv[bj][n] = bias ? *(const f32x4*)(bias + bcol0 + bj * HALF + 4 * n) : (f32x4){0.f, 0.f, 0.f, 0.f};
#pragma unroll
        for (int ai = 0; ai < 2; ++ai)
#pragma unroll
            for (int m = 0; m < 4; ++m) { bf16_t* rowp = base + (size_t)(row0 + ai * HALF + m * 16) * ldc + col0;
#pragma unroll
                for (int bj = 0; bj < 2; ++bj) { f32x4 v0 = acc[ai][bj][m][0] + bv[bj][0], v1 = acc[ai][bj][m][1] + bv[bj][1];
                    if (ACT == 1) { f32x2 a = gelu_pk((f32x2){v0[0], v0[1]}), b = gelu_pk((f32x2){v0[2], v0[3]}), c = gelu_pk((f32x2){v1[0], v1[1]}), d = gelu_pk((f32x2){v1[2], v1[3]});
                        v0 = (f32x4){a.x, a.y, b.x, b.y}; v1 = (f32x4){c.x, c.y, d.x, d.y}; }
                    v0 = v0 * sc; v1 = v1 * sc; u32x4 w; w.x = cvt_pk_bf16(v0[0], v0[1]); w.y = cvt_pk_bf16(v0[2], v0[3]); w.z = cvt_pk_bf16(v1[0], v1[1]); w.w = cvt_pk_bf16(v1[2], v1[3]);
                    *(u32x4*)(rowp + bj * HALF) = w; } }
    }
};

struct EpiResF32 {
    static constexpr bool PERM = false, AFTER_DRAIN = false;
    float* C; const float* R; int ldc;
    __device__ __forceinline__ void operator()(const f32x4 (&acc)[2][2][4][2], const Unit& u, int wr, int wc, int fr, int fq) const {
        const int row0 = u.pm * BM + wr * 64 + fr, col0 = u.pn * BM + wc * 32 + 4 * fq;
#pragma unroll
        for (int ai = 0; ai < 2; ++ai)
#pragma unroll
            for (int m = 0; m < 4; ++m) { const size_t off = (size_t)(row0 + ai * HALF + m * 16) * ldc + col0;
#pragma unroll
                for (int bj = 0; bj < 2; ++bj)
#pragma unroll
                    for (int n = 0; n < 2; ++n) { f32x4 v = acc[ai][bj][m][n]; if (R) v = v + *(const f32x4*)(R + off + bj * HALF + n * 16); *(f32x4*)(C + off + bj * HALF + n * 16) = v; } }
    }
};
typedef int i32x4 __attribute__((ext_vector_type(4)));
template <bool INT8> __device__ __forceinline__ f32x4 pg8_mma(bf16x8 a, bf16x8 b, f32x4 c) {
    if constexpr (INT8) return __builtin_bit_cast(f32x4, __builtin_amdgcn_mfma_i32_16x16x64_i8(__builtin_bit_cast(i32x4, a), __builtin_bit_cast(i32x4, b), __builtin_bit_cast(i32x4, c), 0, 0, 0));
    else return __builtin_amdgcn_mfma_f32_16x16x32_bf16(a, b, c, 0, 0, 0);
}
template <int ACT> struct EpiBf16I8 {
    static constexpr bool PERM = true, AFTER_DRAIN = false;
    bf16_t* O; int ldc; const float* bias; int split_cols; size_t split_stride; const float* sa; const float* sb;
    __device__ __forceinline__ void operator()(const f32x4 (&acc)[2][2][4][2], const Unit& u, int wr, int wc, int fr, int fq) const {
        const int row0 = u.pm * BM + wr * 64 + fr; int colt = u.pn * BM; bf16_t* base = O;
        if (split_cols) { const int t = colt / split_cols; base += (size_t)t * split_stride; colt -= t * split_cols; }
        const int col0 = colt + wc * 32 + 8 * fq, bcol0 = u.pn * BM + wc * 32 + 8 * fq;
        f32x4 bv[2][2], cs[2][2];
#pragma unroll
        for (int bj = 0; bj < 2; ++bj)
#pragma unroll
            for (int n = 0; n < 2; ++n) { bv[bj][n] = bias ? *(const f32x4*)(bias + bcol0 + bj * HALF + 4 * n) : (f32x4){0.f, 0.f, 0.f, 0.f}; cs[bj][n] = *(const f32x4*)(sb + bcol0 + bj * HALF + 4 * n); }
#pragma unroll
        for (int ai = 0; ai < 2; ++ai)
#pragma unroll
            for (int m = 0; m < 4; ++m) { const int row = row0 + ai * HALF + m * 16; const float ra = sa[row]; bf16_t* rowp = base + (size_t)row * ldc + col0;
#pragma unroll
                for (int bj = 0; bj < 2; ++bj) { const i32x4 i0 = __builtin_bit_cast(i32x4, acc[ai][bj][m][0]), i1 = __builtin_bit_cast(i32x4, acc[ai][bj][m][1]);
                    f32x4 v0, v1;
#pragma unroll
                    for (int j = 0; j < 4; ++j) { v0[j] = (float)i0[j] * (ra * cs[bj][0][j]) + bv[bj][0][j]; v1[j] = (float)i1[j] * (ra * cs[bj][1][j]) + bv[bj][1][j]; }
                    if (ACT == 1) { f32x2 a = gelu_pk((f32x2){v0[0], v0[1]}), b = gelu_pk((f32x2){v0[2], v0[3]}), c = gelu_pk((f32x2){v1[0], v1[1]}), d = gelu_pk((f32x2){v1[2], v1[3]});
                        v0 = (f32x4){a.x, a.y, b.x, b.y}; v1 = (f32x4){c.x, c.y, d.x, d.y}; }
                    u32x4 w; w.x = cvt_pk_bf16(v0[0], v0[1]); w.y = cvt_pk_bf16(v0[2], v0[3]); w.z = cvt_pk_bf16(v1[0], v1[1]); w.w = cvt_pk_bf16(v1[2], v1[3]);
                    *(u32x4*)(rowp + bj * HALF) = w; } }
    }
};
struct EpiResF32I8 {
    static constexpr bool PERM = false, AFTER_DRAIN = false;
    float* C; const float* R; const float* sa; const float* sb; int ldc;
    __device__ __forceinline__ void operator()(const f32x4 (&acc)[2][2][4][2], const Unit& u, int wr, int wc, int fr, int fq) const {
        const int row0 = u.pm * BM + wr * 64 + fr, col0 = u.pn * BM + wc * 32 + 4 * fq;
        f32x4 cs[2][2];
#pragma unroll
        for (int bj = 0; bj < 2; ++bj)
#pragma unroll
            for (int n = 0; n < 2; ++n) cs[bj][n] = *(const f32x4*)(sb + col0 + bj * HALF + n * 16);
#pragma unroll
        for (int ai = 0; ai < 2; ++ai)
#pragma unroll
            for (int m = 0; m < 4; ++m) { const int row = row0 + ai * HALF + m * 16; const float ra = sa[row]; const size_t off = (size_t)row * ldc + col0;
#pragma unroll
                for (int bj = 0; bj < 2; ++bj)
#pragma unroll
                    for (int n = 0; n < 2; ++n) { const i32x4 iv = __builtin_bit_cast(i32x4, acc[ai][bj][m][n]); f32x4 v = *(const f32x4*)(R + off + bj * HALF + n * 16);
#pragma unroll
                        for (int j = 0; j < 4; ++j) v[j] += (float)iv[j] * (ra * cs[bj][n][j]);
                        *(f32x4*)(C + off + bj * HALF + n * 16) = v; } }
    }
};
struct EpiF16 {
    static constexpr bool PERM = true, AFTER_DRAIN = false;
    _Float16* O; int ldc;
    __device__ __forceinline__ void operator()(const f32x4 (&acc)[2][2][4][2], const Unit& u, int wr, int wc, int fr, int fq) const {
        typedef _Float16 h2 __attribute__((ext_vector_type(2)));
        const int row0 = u.pm * BM + wr * 64 + fr, col0 = u.pn * BM + wc * 32 + 8 * fq;
#pragma unroll
        for (int ai = 0; ai < 2; ++ai)
#pragma unroll
            for (int m = 0; m < 4; ++m) { _Float16* rowp = O + (size_t)(row0 + ai * HALF + m * 16) * ldc + col0;
#pragma unroll
                for (int bj = 0; bj < 2; ++bj) { const f32x4 v0 = acc[ai][bj][m][0], v1 = acc[ai][bj][m][1];
                    u32x4 w;
                    w.x = __builtin_bit_cast(unsigned, (h2){(_Float16)v0[0], (_Float16)v0[1]}); w.y = __builtin_bit_cast(unsigned, (h2){(_Float16)v0[2], (_Float16)v0[3]});
                    w.z = __builtin_bit_cast(unsigned, (h2){(_Float16)v1[0], (_Float16)v1[1]}); w.w = __builtin_bit_cast(unsigned, (h2){(_Float16)v1[2], (_Float16)v1[3]});
                    *(u32x4*)(rowp + bj * HALF) = w; } }
    }
};
template <class Epi, class Sched, bool ALIGN_EPI = false, bool SP2 = false, bool INT8 = false>
__device__ __forceinline__ void gemm_phase(PG8_LAS unsigned char* lds, const Gemm g, const Sched& S, const Epi& E) {
    int tid = threadIdx.x; asm volatile("" : "+v"(tid));
    const int wid = __builtin_amdgcn_readfirstlane(tid >> 6), lane = tid & 63, wr = wid >> 2, wc = wid & 3, fr = lane & 15, fq = lane >> 4;
    const int K = g.K, nt = K / BK;
    unsigned voffA[2], voffB[2];
#pragma unroll
    for (int i = 0; i < 2; ++i) { int R, C; stage_rc(tid * 16 + i * 8192, R, C); const int Rb = Epi::PERM ? ((R & ~31) + perm32(R & 31)) : R;
        voffA[i] = (unsigned)(R * K + C) * 2u; voffB[i] = (unsigned)(Rb * K + C) * 2u; }
    const size_t kstep = (size_t)(BK * 2);
    const size_t hstep = (size_t)HALF * K * 2;
    const size_t tstep = 2 * hstep;
    const unsigned ldsw = (unsigned)wid * 1024u;
    const int aoff = lds_byte(wr * 64 + fr, fq * 8), boff = lds_byte(wc * 32 + fr, fq * 8);
#define PG8_SA(b, h) (((b) * 2 + (h)) * HTB)
#define PG8_SB(b, h) ((4 + (b) * 2 + (h)) * HTB)
#define PG8_STAGE(bufoff, gbase, voff) do { _Pragma("unroll") for (int _i = 0; _i < 2; ++_i) \
        __builtin_amdgcn_global_load_lds((const unsigned*)((const char*)(gbase) + (voff)[_i]), (PG8_LAS unsigned*)(lds + (bufoff) + ldsw + _i * 8192), 16, 0, 0); } while (0)
#define PG8_LDA(dst, b, h) do { _Pragma("unroll") for (int m = 0; m < 4; ++m) _Pragma("unroll") for (int k = 0; k < 2; ++k) dst[m][k] = *(const PG8_LAS bf16x8*)(lds + PG8_SA(b, h) + aoff + m * 2048 + k * 1024); } while (0)
#define PG8_LDB(dst, b, h) do { _Pragma("unroll") for (int n = 0; n < 2; ++n) _Pragma("unroll") for (int k = 0; k < 2; ++k) dst[n][k] = *(const PG8_LAS bf16x8*)(lds + PG8_SB(b, h) + boff + n * 2048 + k * 1024); } while (0)
#define PG8_MMA(ai, bj, At, Bt) do { __builtin_amdgcn_s_setprio(1); _Pragma("unroll") for (int m = 0; m < 4; ++m) _Pragma("unroll") for (int n = 0; n < 2; ++n) _Pragma("unroll") for (int k = 0; k < 2; ++k) \
        acc[ai][bj][m][n] = pg8_mma<INT8>(Bt[n][k], At[m][k], acc[ai][bj][m][n]); __builtin_amdgcn_s_setprio(0); } while (0)
#define PG8_WAIT_V(n) asm volatile("s_waitcnt vmcnt(" #n ")" ::: "memory")
#define PG8_WAIT_L(n) asm volatile("s_waitcnt lgkmcnt(" #n ")" ::: "memory")
#define PG8_BAR __builtin_amdgcn_s_barrier()
#define PG8_SCHED __builtin_amdgcn_sched_barrier(0)
    Unit cur, nxt; int ui = 0;
    if (!S.next(0, cur)) return;
    f32x4 acc[2][2][4][2];
#pragma unroll
    for (int a = 0; a < 2; ++a)
#pragma unroll
        for (int b = 0; b < 2; ++b)
#pragma unroll
            for (int m = 0; m < 4; ++m)
#pragma unroll
                for (int n = 0; n < 2; ++n) acc[a][b][m][n] = (f32x4){0.f, 0.f, 0.f, 0.f};
    bf16x8 At[4][2], B0[2][2], B1[2][2];
    const char* cA = (const char*)g.A + (size_t)cur.pm * tstep; const char* cB = (const char*)g.Bt + (size_t)cur.pn * tstep;
    S.a_ready(cur);
    if constexpr (SP2) {
        PG8_STAGE(PG8_SB(0, 0), cB, voffB); PG8_STAGE(PG8_SB(0, 1), cB + hstep, voffB); PG8_STAGE(PG8_SA(0, 0), cA, voffA); PG8_STAGE(PG8_SA(0, 1), cA + hstep, voffA);
        if (wr == 1) PG8_BAR;
        PG8_WAIT_V(2); PG8_BAR;
        PG8_STAGE(PG8_SB(1, 0), cB + kstep, voffB); PG8_STAGE(PG8_SA(1, 0), cA + kstep, voffA); PG8_STAGE(PG8_SB(1, 1), cB + hstep + kstep, voffB);
        PG8_WAIT_V(6); PG8_BAR;
    } else {
        PG8_STAGE(PG8_SB(0, 0), cB, voffB); PG8_STAGE(PG8_SA(0, 0), cA, voffA); PG8_STAGE(PG8_SB(0, 1), cB + hstep, voffB); PG8_STAGE(PG8_SA(0, 1), cA + hstep, voffA);
        if (wr == 1) PG8_BAR;
        PG8_WAIT_V(4); PG8_BAR;
        PG8_STAGE(PG8_SB(1, 0), cB + kstep, voffB); PG8_STAGE(PG8_SA(1, 0), cA + kstep, voffA); PG8_STAGE(PG8_SB(1, 1), cB + hstep + kstep, voffB);
        PG8_WAIT_V(6); PG8_BAR;
    }
    for (;;) {
        const bool has_next = S.next(ui + 1, nxt);
        const char* nA = has_next ? (const char*)g.A + (size_t)nxt.pm * tstep : cA; const char* nB = has_next ? (const char*)g.Bt + (size_t)nxt.pn * tstep : cB;
        for (int t = 0; t < nt; t += 2) {
            const bool last = (t == nt - 2);
            const char* a1 = cA + (size_t)(t + 1) * kstep;
            const char* a2 = last ? nA : cA + (size_t)(t + 2) * kstep; const char* b2 = last ? nB : cB + (size_t)(t + 2) * kstep;
            const char* a3 = a2 + kstep; const char* b3 = b2 + kstep;
            if (last && has_next) S.a_ready(nxt);
            if constexpr (SP2) {
            PG8_LDB(B0, 0, 0); PG8_LDB(B1, 0, 1); PG8_SCHED; PG8_LDA(At, 0, 0); PG8_STAGE(PG8_SA(1, 1), a1 + hstep, voffA);
            PG8_WAIT_V(8); PG8_WAIT_L(0); PG8_BAR; PG8_MMA(0, 0, At, B0); PG8_MMA(0, 1, At, B1); PG8_BAR; PG8_SCHED;
            PG8_LDA(At, 0, 1); PG8_STAGE(PG8_SB(0, 0), b2, voffB); PG8_STAGE(PG8_SB(0, 1), b2 + hstep, voffB); PG8_STAGE(PG8_SA(0, 0), a2, voffA);
            PG8_WAIT_V(8); PG8_WAIT_L(0); PG8_BAR; PG8_MMA(1, 0, At, B0); PG8_MMA(1, 1, At, B1); PG8_BAR; PG8_SCHED;
            PG8_LDB(B0, 1, 0); PG8_LDB(B1, 1, 1); PG8_SCHED; PG8_LDA(At, 1, 0); PG8_STAGE(PG8_SA(0, 1), a2 + hstep, voffA);
            PG8_WAIT_V(8); PG8_WAIT_L(0); PG8_BAR; PG8_MMA(0, 0, At, B0); PG8_MMA(0, 1, At, B1); PG8_BAR; PG8_SCHED;
            PG8_LDA(At, 1, 1); PG8_STAGE(PG8_SB(1, 0), b3, voffB); PG8_STAGE(PG8_SB(1, 1), b3 + hstep, voffB); PG8_STAGE(PG8_SA(1, 0), a3, voffA);
            PG8_WAIT_V(8); PG8_WAIT_L(0); PG8_BAR; PG8_MMA(1, 0, At, B0); PG8_MMA(1, 1, At, B1); PG8_BAR; PG8_SCHED;
            } else {
            PG8_LDB(B0, 0, 0); PG8_SCHED; PG8_LDA(At, 0, 0); PG8_STAGE(PG8_SA(1, 1), a1 + hstep, voffA);
            PG8_WAIT_L(8); PG8_BAR; PG8_WAIT_L(0); PG8_MMA(0, 0, At, B0); PG8_BAR; PG8_SCHED;
            PG8_LDB(B1, 0, 1); PG8_STAGE(PG8_SB(0, 0), b2, voffB);
            PG8_BAR; PG8_WAIT_L(0); PG8_MMA(0, 1, At, B1); PG8_BAR;
            PG8_LDA(At, 0, 1); PG8_STAGE(PG8_SA(0, 0), a2, voffA);
            PG8_BAR; PG8_WAIT_L(0); PG8_MMA(1, 0, At, B0); PG8_BAR; PG8_SCHED;
            PG8_STAGE(PG8_SB(0, 1), b2 + hstep, voffB);
            PG8_WAIT_V(6); PG8_BAR; PG8_MMA(1, 1, At, B1); PG8_BAR;
            PG8_LDB(B0, 1, 0); PG8_SCHED; PG8_LDA(At, 1, 0); PG8_STAGE(PG8_SA(0, 1), a2 + hstep, voffA);
            PG8_WAIT_L(8); PG8_BAR; PG8_WAIT_L(0); PG8_MMA(0, 0, At, B0); PG8_BAR; PG8_SCHED;
            PG8_LDB(B1, 1, 1); PG8_STAGE(PG8_SB(1, 0), b3, voffB);
            PG8_BAR; PG8_WAIT_L(0); PG8_MMA(0, 1, At, B1); PG8_BAR;
            PG8_LDA(At, 1, 1); PG8_STAGE(PG8_SA(1, 0), a3, voffA);
            PG8_BAR; PG8_WAIT_L(0); PG8_MMA(1, 0, At, B0); PG8_BAR; PG8_SCHED;
            PG8_STAGE(PG8_SB(1, 1), b3 + hstep, voffB);
            PG8_WAIT_V(6); PG8_BAR; PG8_MMA(1, 1, At, B1); PG8_BAR;
            }
        }
        if constexpr (ALIGN_EPI) { if (wr == 0) PG8_BAR; }
        if constexpr (!Epi::AFTER_DRAIN) { E(acc, cur, wr, wc, fr, fq); S.done(cur); }
        if (!has_next) break;
#pragma unroll
        for (int a = 0; a < 2; ++a)
#pragma unroll
            for (int b = 0; b < 2; ++b)
#pragma unroll
                for (int m = 0; m < 4; ++m)
#pragma unroll
                    for (int n = 0; n < 2; ++n) acc[a][b][m][n] = (f32x4){0.f, 0.f, 0.f, 0.f};
        cur = nxt; cA = nA; cB = nB; ++ui;
        if constexpr (ALIGN_EPI) { if (wr == 1) PG8_BAR; }
    }
    PG8_WAIT_V(0);
    if constexpr (!ALIGN_EPI) { if (wr == 0) PG8_BAR; }
    PG8_BAR;
    if constexpr (Epi::AFTER_DRAIN) { E.fused(acc, cur, wr, wc, fr, fq, lds, wid, lane); S.done(cur); }
#undef PG8_SA
#undef PG8_SB
#undef PG8_STAGE
#undef PG8_LDA
#undef PG8_LDB
#undef PG8_MMA
#undef PG8_WAIT_V
#undef PG8_WAIT_L
#undef PG8_BAR
#undef PG8_SCHED
}
}
#define LAS __attribute__((address_space(3)))
typedef unsigned short bf16_t;
typedef unsigned v4u __attribute__((ext_vector_type(4)));
typedef unsigned v2u __attribute__((ext_vector_type(2)));
typedef short bf16x8_t __attribute__((ext_vector_type(8)));
typedef float f32x4 __attribute__((ext_vector_type(4)));

constexpr int TOK = 32768, DM = 1024, SEQ = 8192;
constexpr int BPROJ = 3328;
constexpr size_t MiB = 1ull << 20;
constexpr size_t WS_CTL = 0;
constexpr size_t WS_BAR = 512 * 1024;
constexpr size_t WS_DUMMY = 768 * 1024;
constexpr size_t WS_SCALE = 0;
constexpr size_t WS_WA_IN = 1 * MiB;
constexpr size_t WS_WA_OUT = 9 * MiB;
constexpr size_t WS_WB_IN = 13 * MiB;
constexpr size_t WS_WB_OUT = 20 * MiB;
constexpr size_t WS_WP = 22 * MiB;
constexpr size_t WS_H = 32 * MiB;
constexpr size_t WS_EID = 96 * MiB;
constexpr size_t WS_GATE = 112 * MiB;
constexpr size_t WS_TAB = 128 * MiB;
constexpr size_t WS_BIG = 192 * MiB;
constexpr size_t WS_GLR = WS_BIG + 305 * MiB;
constexpr size_t WS_WA_IN8 = WS_BIG + 309 * MiB;
constexpr size_t WS_WB_IN8 = WS_BIG + 313 * MiB;
constexpr size_t WS_WB_OUT8 = WS_BIG + 317 * MiB;
constexpr size_t WS_SB_OUT = 352 * 1024;
constexpr size_t WS_SA_IN = 288 * 1024;
constexpr size_t WS_SB_IN = 320 * 1024;
constexpr int LDS_BYTES = 147456;

struct Params { const float* in[21]; float* out; unsigned char* ws; };

__device__ __forceinline__ bf16_t f2bf(float f) { unsigned u = __float_as_uint(f); u += 0x7FFFu + ((u >> 16) & 1u); return (bf16_t)(u >> 16); }
typedef __bf16 bf16n2 __attribute__((ext_vector_type(2)));
__device__ __forceinline__ unsigned pk2(float lo, float hi) { typedef float f32n2 __attribute__((ext_vector_type(2))); const f32n2 v = {lo, hi}; return __builtin_bit_cast(unsigned, __builtin_convertvector(v, bf16n2)); }
__device__ __forceinline__ float bf2f(bf16_t b) { return __uint_as_float(((unsigned)b) << 16); }
__device__ __forceinline__ float gelu_exact(float x) { return 0.5f * x * (1.0f + erff(x * 0.70710678118654752f)); }
__device__ __forceinline__ float wave_sum(float v) {
#pragma unroll
  for (int o = 32; o > 0; o >>= 1) v += __shfl_xor(v, o);
  return v;
}

typedef __bf16 bf16x2_t __attribute__((ext_vector_type(2)));
__device__ __forceinline__ float dot2bf(unsigned a, unsigned b, float c) { return __builtin_amdgcn_fdot2_f32_bf16(__builtin_bit_cast(bf16x2_t, a), __builtin_bit_cast(bf16x2_t, b), c, false); }
__device__ __forceinline__ float wave_sum_dpp(float v) {
  int x;
  x = __builtin_amdgcn_mov_dpp(__float_as_int(v), 0xB1, 0xF, 0xF, true); v += __int_as_float(x);
  x = __builtin_amdgcn_mov_dpp(__float_as_int(v), 0x4E, 0xF, 0xF, true); v += __int_as_float(x);
  x = __builtin_amdgcn_mov_dpp(__float_as_int(v), 0x141, 0xF, 0xF, true); v += __int_as_float(x);
  x = __builtin_amdgcn_mov_dpp(__float_as_int(v), 0x140, 0xF, 0xF, true); v += __int_as_float(x);
  const int vi = __float_as_int(v);
  return (__int_as_float(__builtin_amdgcn_readlane(vi, 0)) + __int_as_float(__builtin_amdgcn_readlane(vi, 16))) +
         (__int_as_float(__builtin_amdgcn_readlane(vi, 32)) + __int_as_float(__builtin_amdgcn_readlane(vi, 48)));
}
__device__ __forceinline__ float gelu_as(float v) {
  const float av = fabsf(v), t = __builtin_amdgcn_rcpf(av * 0.2316418882f + 1.0f);
  float q = t * 0.5307027145f + (-0.7265760135f); q = q * t + 0.7107068705f; q = q * t + (-0.142248368f); q = q * t + 0.127414796f; q = q * t;
  const float e = __builtin_amdgcn_exp2f((v * v) * (-0.72134752044f));
  const float m = v * (q * e);
  return v < 0.f ? m : v - m;
}

__device__ __forceinline__ void fold_item(const Params& P, int it, int lane, LAS float* scr) {
  const int kk0 = (it & 63) * 16, half = (it >> 6) & 1, head = (it >> 7) & 7, layer = it >> 10;
  const float* kx = (half ? P.in[18] : P.in[17]) + (size_t)layer * 16384;
  const float* wq = P.in[16] + (size_t)layer * 1024 * 2048 + head * 256 + half * 128;
#pragma unroll
  for (int i = 0; i < 8; ++i) { const int e = i * 64 + lane, r = e >> 5, c4 = e & 31;
    const float4 v = *(const float4*)(wq + (size_t)(kk0 + r) * 2048 + c4 * 4);
    *(LAS f32x4*)(scr + r * 128 + c4 * 4) = (f32x4){v.x, v.y, v.z, v.w}; }
  asm volatile("s_waitcnt lgkmcnt(0)" ::: "memory");
  float a0[16], a1[16];
#pragma unroll
  for (int i = 0; i < 16; ++i) { a0[i] = 0.f; a1[i] = 0.f; }
#pragma unroll 2
  for (int d4 = 0; d4 < 32; ++d4) {
    const float4 x0 = *(const float4*)(kx + (size_t)lane * 128 + d4 * 4), x1 = *(const float4*)(kx + (size_t)(lane + 64) * 128 + d4 * 4);
#pragma unroll
    for (int kk = 0; kk < 16; ++kk) {
      const f32x4 b = *(const LAS f32x4*)(scr + kk * 128 + d4 * 4);
      a0[kk] += x0.x * b[0] + x0.y * b[1] + x0.z * b[2] + x0.w * b[3];
      a1[kk] += x1.x * b[0] + x1.y * b[1] + x1.z * b[2] + x1.w * b[3];
    }
  }
  asm volatile("s_waitcnt lgkmcnt(0)" ::: "memory");
  bf16_t* wt = (bf16_t*)(P.ws + WS_WP) + (size_t)layer * 2048 * 1024;
  bf16_t* r0 = wt + (size_t)(head * 256 + half * 128 + lane) * 1024 + kk0;
  bf16_t* r1 = r0 + (size_t)64 * 1024;
  v4u o;
  o.x = pk2(a0[0], a0[1]); o.y = pk2(a0[2], a0[3]); o.z = pk2(a0[4], a0[5]); o.w = pk2(a0[6], a0[7]); *(v4u*)r0 = o;
  o.x = pk2(a0[8], a0[9]); o.y = pk2(a0[10], a0[11]); o.z = pk2(a0[12], a0[13]); o.w = pk2(a0[14], a0[15]); *(v4u*)(r0 + 8) = o;
  o.x = pk2(a1[0], a1[1]); o.y = pk2(a1[2], a1[3]); o.z = pk2(a1[4], a1[5]); o.w = pk2(a1[6], a1[7]); *(v4u*)r1 = o;
  o.x = pk2(a1[8], a1[9]); o.y = pk2(a1[10], a1[11]); o.z = pk2(a1[12], a1[13]); o.w = pk2(a1[14], a1[15]); *(v4u*)(r1 + 8) = o;
}

__device__ __forceinline__ float wave_max_dpp(float v) {
  v = fmaxf(v, __int_as_float(__builtin_amdgcn_mov_dpp(__float_as_int(v), 0xB1, 0xF, 0xF, true)));
  v = fmaxf(v, __int_as_float(__builtin_amdgcn_mov_dpp(__float_as_int(v), 0x4E, 0xF, 0xF, true)));
  v = fmaxf(v, __int_as_float(__builtin_amdgcn_mov_dpp(__float_as_int(v), 0x141, 0xF, 0xF, true)));
  v = fmaxf(v, __int_as_float(__builtin_amdgcn_mov_dpp(__float_as_int(v), 0x140, 0xF, 0xF, true)));
  const int vi = __float_as_int(v);
  return fmaxf(fmaxf(__int_as_float(__builtin_amdgcn_readlane(vi, 0)), __int_as_float(__builtin_amdgcn_readlane(vi, 16))),
               fmaxf(__int_as_float(__builtin_amdgcn_readlane(vi, 32)), __int_as_float(__builtin_amdgcn_readlane(vi, 48))));
}
__device__ __forceinline__ int wave_isum_dpp(int v) {
  v += __builtin_amdgcn_mov_dpp(v, 0xB1, 0xF, 0xF, true);
  v += __builtin_amdgcn_mov_dpp(v, 0x4E, 0xF, 0xF, true);
  v += __builtin_amdgcn_mov_dpp(v, 0x141, 0xF, 0xF, true);
  v += __builtin_amdgcn_mov_dpp(v, 0x140, 0xF, 0xF, true);
  return (__builtin_amdgcn_readlane(v, 0) + __builtin_amdgcn_readlane(v, 16)) + (__builtin_amdgcn_readlane(v, 32) + __builtin_amdgcn_readlane(v, 48));
}
__device__ __forceinline__ unsigned q8(float x, float inv) { const int q = (int)rintf(x * inv); return (unsigned)(q < -127 ? -127 : (q > 127 ? 127 : q)) & 0xFFu; }
__device__ __forceinline__ void tabconv8_row(const Params& P, int r, const float4 (&v)[4], int lane) {
  const int row = r & 16383, tab = (r >> 14) & 1, layer = r >> 15;
  float am = 0.f;
#pragma unroll
  for (int i = 0; i < 4; ++i) am = fmaxf(am, fmaxf(fmaxf(fabsf(v[i].x), fabsf(v[i].y)), fmaxf(fabsf(v[i].z), fabsf(v[i].w))));
  am = wave_max_dpp(am);
  const float sc = am > 0.f ? am * (1.0f / 127.0f) : 1.0f, inv = 1.0f / sc;
  const unsigned off = 0u;
  v4u o; unsigned w[4];
#pragma unroll
  for (int i = 0; i < 4; ++i) w[i] = ((q8(v[i].x, inv) | (q8(v[i].y, inv) << 8) | (q8(v[i].z, inv) << 16) | (q8(v[i].w, inv) << 24)) ^ off);
  o.x = w[0]; o.y = w[1]; o.z = w[2]; o.w = w[3];
  *(v4u*)(P.ws + WS_TAB + (size_t)(layer * 2 + tab) * 16 * MiB + ((size_t)(lane >> 3) * 16384 + row) * 128 + (lane & 7) * 16) = o;
  if (lane == 0) ((float*)(P.ws + WS_SCALE))[(layer * 2 + tab) * 16384 + row] = sc;
}
__device__ __forceinline__ void tabconv8_load(const Params& P, int r, float4 (&v)[4], int lane) {
  const int row = r & 16383, tab = (r >> 14) & 1, layer = r >> 15;
  const float* src = P.in[19 + tab] + ((size_t)layer * 16384 + row) * 1024;
#pragma unroll
  for (int i = 0; i < 4; ++i) v[i] = tab ? *(const float4*)(src + lane * 16 + i * 4) : *(const float4*)(src + i * 256 + lane * 4);
}
__device__ __forceinline__ void phase_tabconv8(const Params& P) {
  const int lane = threadIdx.x & 63, wave = __builtin_amdgcn_readfirstlane(threadIdx.x >> 6);
  const int gw = blockIdx.x * 8 + wave, NGW = gridDim.x * 8;
  float4 a[4], b[4], c[4], d[4];
  for (int r = gw; r < 4 * 16384; r += 4 * NGW) {
    tabconv8_load(P, r, a, lane);
    if (r + NGW < 4 * 16384) tabconv8_load(P, r + NGW, b, lane);
    if (r + 2 * NGW < 4 * 16384) tabconv8_load(P, r + 2 * NGW, c, lane);
    if (r + 3 * NGW < 4 * 16384) tabconv8_load(P, r + 3 * NGW, d, lane);
    tabconv8_row(P, r, a, lane);
    if (r + NGW < 4 * 16384) tabconv8_row(P, r + NGW, b, lane);
    if (r + 2 * NGW < 4 * 16384) tabconv8_row(P, r + 2 * NGW, c, lane);
    if (r + 3 * NGW < 4 * 16384) tabconv8_row(P, r + 3 * NGW, d, lane);
  }
}

constexpr size_t WS_GSU = WS_H;
constexpr size_t WS_GSV = WS_GATE;
__device__ __forceinline__ unsigned enc_key(float s) { const unsigned b = __float_as_uint(s); return (b & 0x80000000u) ? ~b : (b | 0x80000000u); }
__device__ __forceinline__ float dec_key(unsigned u) { return __uint_as_float((u & 0x80000000u) ? (u & 0x7FFFFFFFu) : ~u); }
#define TK_CE(a, b) do { const unsigned _hi = (a) > (b) ? (a) : (b), _lo = (a) > (b) ? (b) : (a); (a) = _hi; (b) = _lo; } while (0)
__device__ __forceinline__ void sort16_desc(unsigned (&k)[16]) {
#pragma unroll
  for (int size = 2; size <= 16; size <<= 1)
#pragma unroll
    for (int stride = size >> 1; stride > 0; stride >>= 1)
#pragma unroll
      for (int i = 0; i < 16; ++i) { const int j = i ^ stride; if (j > i) { if ((i & size) == 0) TK_CE(k[i], k[j]); else TK_CE(k[j], k[i]); } }
}
__device__ __forceinline__ void merge16_desc(unsigned (&k)[16]) {
#pragma unroll
  for (int stride = 8; stride > 0; stride >>= 1)
#pragma unroll
    for (int i = 0; i < 16; ++i) { const int j = i ^ stride; if (j > i) TK_CE(k[i], k[j]); }
}
__device__ __forceinline__ void topmerge16(unsigned (&R)[16], const unsigned (&N)[16]) {
#pragma unroll
  for (int i = 0; i < 16; ++i) R[i] = R[i] > N[15 - i] ? R[i] : N[15 - i];
  merge16_desc(R);
}
__device__ __forceinline__ void topk_ld(const _Float16* wbase, int step, int lane, v4u (&g)[4]) {
#pragma unroll
  for (int i = 0; i < 4; ++i) g[i] = *(const v4u*)(wbase + (size_t)(i * 16 + (lane >> 2)) * 256 + step * 32 + (lane & 3) * 8);
}
__device__ __forceinline__ void topk_put(LAS unsigned char* tile, int lane, const v4u (&g)[4]) {
#pragma unroll
  for (int i = 0; i < 4; ++i) *(LAS v4u*)(tile + (i * 16 + (lane >> 2)) * 80 + (lane & 3) * 16) = g[i];
}
__device__ __forceinline__ void topk_group(LAS unsigned char* tile, int lane, int sub, int gcol, unsigned (&N)[16]) {
  typedef _Float16 h2 __attribute__((ext_vector_type(2)));
#pragma unroll
  for (int q = 0; q < 2; ++q) { const v4u v = *(const LAS v4u*)(tile + lane * 80 + sub * 32 + q * 16); const unsigned vv[4] = {v.x, v.y, v.z, v.w};
#pragma unroll
    for (int j = 0; j < 4; ++j) { const h2 hh = __builtin_bit_cast(h2, vv[j]);
      N[q * 8 + 2 * j + 0] = (enc_key((float)hh.x) & ~0x7Fu) | (unsigned)(127 - (gcol + q * 8 + 2 * j + 0));
      N[q * 8 + 2 * j + 1] = (enc_key((float)hh.y) & ~0x7Fu) | (unsigned)(127 - (gcol + q * 8 + 2 * j + 1)); } }
  sort16_desc(N);
}

__device__ __forceinline__ void phase_topk(const Params& P, LAS unsigned char* lds, int layer) {
  const _Float16* S = (const _Float16*)(P.ws + WS_BIG);
  int* EID = (int*)(P.ws + WS_EID); float* GSU = (float*)(P.ws + WS_GSU); float* GSV = (float*)(P.ws + WS_GSV);
  const float* scu = (const float*)(P.ws + WS_SCALE) + layer * 32768; const float* scv = scu + 16384;
  int lane = threadIdx.x & 63; const int wave = __builtin_amdgcn_readfirstlane(threadIdx.x >> 6);
  asm volatile("" : "+v"(lane));
  LAS unsigned char* my = lds + (wave * 64 + lane) * 36;
  LAS unsigned char* tile = lds + 20480 + wave * 10240;
  const int NT = gridDim.x * blockDim.x;
  for (int row = blockIdx.x * blockDim.x + wave * 64 + lane; row < TOK * 8; row += NT) {
    const _Float16* wbase = S + (size_t)(row - lane) * 256;
    unsigned R1[16], R2[16];
    v4u ld[4];
    topk_ld(wbase, 0, lane, ld);
#pragma unroll
    for (int st = 0; st < 8; ++st) {
      LAS unsigned char* tl = tile + (st & 1) * 5120;
      topk_put(tl, lane, ld);
      if (st + 1 < 8) topk_ld(wbase, st + 1, lane, ld);
#pragma unroll
      for (int sub = 0; sub < 2; ++sub) {
        const int gi = st * 2 + sub;
        unsigned N[16];
        topk_group(tl, lane, sub, (gi & 7) * 16, N);
        if (gi == 0) {
#pragma unroll
          for (int i = 0; i < 16; ++i) R1[i] = N[i];
        } else if (gi < 8) topmerge16(R1, N);
        else if (gi == 8) {
#pragma unroll
          for (int i = 0; i < 16; ++i) R2[i] = N[i];
        } else topmerge16(R2, N);
      }
    }
    float v1[16], v2[16];
#pragma unroll
    for (int i = 0; i < 16; ++i) { v1[i] = dec_key(R1[i] & ~0x7Fu); v2[i] = dec_key(R2[i] & ~0x7Fu); my[i] = (unsigned char)(127u - (R1[i] & 0x7Fu)); my[16 + i] = (unsigned char)(127u - (R2[i] & 0x7Fu)); }
    unsigned C[64];
    {
      int n = 0;
#pragma unroll
      for (int a = 0; a < 16; ++a)
#pragma unroll
        for (int b = 0; b < 16; ++b)
          if ((a + 1) * (b + 1) <= 16) { C[n] = (enc_key(v1[a] + v2[b]) & ~0xFFu) | (unsigned)(255 - (a * 16 + b)); ++n; }
#pragma unroll
      for (int i = 50; i < 64; ++i) C[i] = 0u;
    }
    unsigned R[16], N[16];
#pragma unroll
    for (int i = 0; i < 16; ++i) R[i] = C[i];
    sort16_desc(R);
#pragma unroll
    for (int g = 1; g < 4; ++g) {
#pragma unroll
      for (int i = 0; i < 16; ++i) N[i] = C[g * 16 + i];
      sort16_desc(N); topmerge16(R, N);
    }
    float ev[16]; int ei[16]; float sum = 0.f;
    const float mx = dec_key(R[0] & ~0xFFu);
#pragma unroll
    for (int i = 0; i < 16; ++i) {
      const unsigned pos = 255u - (R[i] & 0xFFu);
      ev[i] = __expf(dec_key(R[i] & ~0xFFu) - mx); sum += ev[i];
      ei[i] = (int)my[pos >> 4] * 128 + (int)my[16 + (pos & 15u)];
    }
    const float inv = 1.0f / sum;
#pragma unroll
    for (int q = 0; q < 4; ++q) {
      *(int4*)(EID + (size_t)row * 16 + q * 4) = make_int4(ei[q * 4], ei[q * 4 + 1], ei[q * 4 + 2], ei[q * 4 + 3]);
      *(float4*)(GSU + (size_t)row * 16 + q * 4) = make_float4(scu[ei[q * 4]], scu[ei[q * 4 + 1]], scu[ei[q * 4 + 2]], scu[ei[q * 4 + 3]]);
      *(float4*)(GSV + (size_t)row * 16 + q * 4) = make_float4(ev[q * 4] * inv * scv[ei[q * 4]], ev[q * 4 + 1] * inv * scv[ei[q * 4 + 1]], ev[q * 4 + 2] * inv * scv[ei[q * 4 + 2]], ev[q * 4 + 3] * inv * scv[ei[q * 4 + 3]]);
    }
  }
}

constexpr size_t WS_H8 = WS_BIG + 256 * MiB;
constexpr size_t WS_SH = WS_BIG + 288 * MiB;
constexpr size_t WS_W = WS_BIG + 289 * MiB;
constexpr size_t WS_WQ = WS_W;
constexpr size_t WS_SW = WS_W + 8 * MiB;
struct VsHdrLane { const unsigned char* base; int sh, mask; };
__device__ __forceinline__ VsHdrLane vs_hdr_lane(const Params& P, int lane) {
  VsHdrLane h;
  h.base = P.ws + (lane < 32 ? WS_EID + lane * 16 : lane < 40 ? WS_WQ + (lane - 32) * 16 : WS_SW);
  h.sh = lane < 32 ? 9 : lane < 40 ? 7 : 2; h.mask = lane < 40 ? -1 : ~3;
  return h;
}
__device__ __forceinline__ void vs_hdr_issue(const VsHdrLane& h, int tok, LAS unsigned char* slot) {
  const unsigned char* src = h.base + ((unsigned)(tok & h.mask) << h.sh);
  asm volatile("s_mov_b32 m0, %1\n\ts_nop 0\n\tglobal_load_lds_dwordx4 %0, off" :: "v"(src), "s"((unsigned)(size_t)slot) : "m0", "memory");
}
#define VS_BP(v, x) __builtin_amdgcn_ds_bpermute((lane ^ (x)) * 4, (v))
#define VS_PIN_ROWS(q) asm volatile("" : "+v"(q[0]), "+v"(q[1]), "+v"(q[2]), "+v"(q[3]))
#define VS_PIN_ACC(a) asm volatile("" : "+v"(a[0]), "+v"(a[1]), "+v"(a[2]), "+v"(a[3]), "+v"(a[4]), "+v"(a[5]), "+v"(a[6]), "+v"(a[7]), "+v"(a[8]), "+v"(a[9]), "+v"(a[10]), "+v"(a[11]), "+v"(a[12]), "+v"(a[13]), "+v"(a[14]), "+v"(a[15]))
__device__ __forceinline__ void vs_rows4(v4u (&vb)[4], const v4u& e, const unsigned char* VS, int p) {
  unsigned e0 = e.x, e1 = e.y, e2 = e.z, e3 = e.w;
  asm volatile("" : "+v"(e0), "+v"(e1), "+v"(e2), "+v"(e3));
  vb[0] = *(const v4u*)(VS + (e0 * 128u + p * 16)); vb[1] = *(const v4u*)(VS + (e1 * 128u + p * 16));
  vb[2] = *(const v4u*)(VS + (e2 * 128u + p * 16)); vb[3] = *(const v4u*)(VS + (e3 * 128u + p * 16));
}
__device__ __forceinline__ void vs_acc4(int (&acc)[16], const v4u& a, const v4u& b, const v4u& c, const v4u& d, unsigned wq) {
  const unsigned ra[4] = {a.x, a.y, a.z, a.w}, rb[4] = {b.x, b.y, b.z, b.w}, rc[4] = {c.x, c.y, c.z, c.w}, rd[4] = {d.x, d.y, d.z, d.w};
#pragma unroll
  for (int i = 0; i < 4; ++i) {
    const unsigned ablo = __builtin_amdgcn_perm(rb[i], ra[i], 0x05010400u), abhi = __builtin_amdgcn_perm(rb[i], ra[i], 0x07030602u);
    const unsigned cdlo = __builtin_amdgcn_perm(rd[i], rc[i], 0x05010400u), cdhi = __builtin_amdgcn_perm(rd[i], rc[i], 0x07030602u);
    acc[4 * i + 0] = __builtin_amdgcn_sdot4((int)__builtin_amdgcn_perm(cdlo, ablo, 0x05040100u), (int)wq, acc[4 * i + 0], false);
    acc[4 * i + 1] = __builtin_amdgcn_sdot4((int)__builtin_amdgcn_perm(cdlo, ablo, 0x07060302u), (int)wq, acc[4 * i + 1], false);
    acc[4 * i + 2] = __builtin_amdgcn_sdot4((int)__builtin_amdgcn_perm(cdhi, abhi, 0x05040100u), (int)wq, acc[4 * i + 2], false);
    acc[4 * i + 3] = __builtin_amdgcn_sdot4((int)__builtin_amdgcn_perm(cdhi, abhi, 0x07060302u), (int)wq, acc[4 * i + 3], false);
  }
}
#ifndef VS_VAR
#define VS_VAR 0
#endif
__device__ __forceinline__ void vs_xor4(int (&acc)[16], const v4u& a, const v4u& b, const v4u& c, const v4u& d) {
  acc[0] ^= (int)(a.x ^ a.y ^ a.z ^ a.w); acc[1] ^= (int)(b.x ^ b.y ^ b.z ^ b.w); acc[2] ^= (int)(c.x ^ c.y ^ c.z ^ c.w); acc[3] ^= (int)(d.x ^ d.y ^ d.z ^ d.w);
}
template <bool DRY>
__device__ __forceinline__ void vs_step(const Params& P, int tok, int pf_tok, int last, const unsigned char* VS, int x, int lane, const VsHdrLane& hl, LAS unsigned char* scur, LAS unsigned char* snxt, LAS unsigned char* snew,
                                        v4u (&q0)[4], v4u (&q1)[4], v4u (&q2)[4], v4u (&q3)[4]) {
  const int g = lane >> 3, p = lane & 7;
  const int tokc = tok < TOK ? tok : last;
  asm volatile("s_waitcnt vmcnt(17)" ::: "memory");
  const v4u wq = *(const LAS v4u*)(scur + 512 + g * 16);
  const float sw = *(const LAS float*)(scur + 640 + (tokc & 3) * 4);
  v4u e[4];
#pragma unroll
  for (int i = 0; i < 4; ++i) e[i] = *(const LAS v4u*)(snxt + g * 64 + i * 16);
  __builtin_amdgcn_sched_barrier(0);
  vs_hdr_issue(hl, pf_tok < TOK ? pf_tok : last, snew);
  __builtin_amdgcn_sched_barrier(0);
  float* op = (tok < TOK ? P.out + (size_t)tok * 1024 : (float*)(P.ws + WS_DUMMY)) + x * 128 + p * 16 + g * 2;
  const float2 xo = *(const float2*)op;
  int acc[16];
#pragma unroll
  for (int i = 0; i < 16; ++i) acc[i] = 0;
  __builtin_amdgcn_sched_barrier(0);
  VS_PIN_ROWS(q0);
  if (DRY && VS_VAR == 1) vs_xor4(acc, q0[0], q0[1], q0[2], q0[3]); else
  vs_acc4(acc, q0[0], q0[1], q0[2], q0[3], wq.x);
  VS_PIN_ACC(acc);
  __builtin_amdgcn_sched_barrier(0);
  if (!(DRY && VS_VAR == 2))
  vs_rows4(q0, e[0], VS, p);
  __builtin_amdgcn_sched_barrier(0);
  VS_PIN_ROWS(q1);
  if (DRY && VS_VAR == 1) vs_xor4(acc, q1[0], q1[1], q1[2], q1[3]); else
  vs_acc4(acc, q1[0], q1[1], q1[2], q1[3], wq.y);
  VS_PIN_ACC(acc);
  __builtin_amdgcn_sched_barrier(0);
  if (!(DRY && VS_VAR == 2))
  vs_rows4(q1, e[1], VS, p);
  __builtin_amdgcn_sched_barrier(0);
  VS_PIN_ROWS(q2);
  if (DRY && VS_VAR == 1) vs_xor4(acc, q2[0], q2[1], q2[2], q2[3]); else
  vs_acc4(acc, q2[0], q2[1], q2[2], q2[3], wq.z);
  VS_PIN_ACC(acc);
  __builtin_amdgcn_sched_barrier(0);
  if (!(DRY && VS_VAR == 2))
  vs_rows4(q2, e[2], VS, p);
  __builtin_amdgcn_sched_barrier(0);
  VS_PIN_ROWS(q3);
  if (DRY && VS_VAR == 1) vs_xor4(acc, q3[0], q3[1], q3[2], q3[3]); else
  vs_acc4(acc, q3[0], q3[1], q3[2], q3[3], wq.w);
  VS_PIN_ACC(acc);
  __builtin_amdgcn_sched_barrier(0);
  if (!(DRY && VS_VAR == 2))
  vs_rows4(q3, e[3], VS, p);
  __builtin_amdgcn_sched_barrier(0);
  const bool b5 = lane & 32, b4 = lane & 16, b3 = lane & 8;
  int r8[8], r4[4], r2[2];
#pragma unroll
  for (int i = 0; i < 8; ++i) { const int keep = b5 ? acc[8 + i] : acc[i], send = b5 ? acc[i] : acc[8 + i]; r8[i] = keep + VS_BP(send, 32); }
#pragma unroll
  for (int i = 0; i < 4; ++i) { const int keep = b4 ? r8[4 + i] : r8[i], send = b4 ? r8[i] : r8[4 + i]; r4[i] = keep + VS_BP(send, 16); }
#pragma unroll
  for (int i = 0; i < 2; ++i) { const int keep = b3 ? r4[2 + i] : r4[i], send = b3 ? r4[i] : r4[2 + i]; r2[i] = keep + VS_BP(send, 8); }
  float2 o; o.x = xo.x + (float)r2[0] * sw; o.y = xo.y + (float)r2[1] * sw;
  if (!DRY || o.x == 1234.5f) *(float2*)op = o;
}
template <bool DRY>
__device__ __forceinline__ void phase_vslice(const Params& P, LAS unsigned char* lds, int layer) {
  int lane = threadIdx.x & 63; const int wave = __builtin_amdgcn_readfirstlane(threadIdx.x >> 6);
  asm volatile("" : "+v"(lane));
  const int nsl = (gridDim.x & 7) == 0 ? 8 : 0;
  const int g = lane >> 3, p = lane & 7;
  const int wi = (nsl ? (blockIdx.x >> 3) : blockIdx.x) * 8 + wave, NW = (nsl ? (gridDim.x >> 3) : gridDim.x) * 8;
  const VsHdrLane hl = vs_hdr_lane(P, lane);
  LAS unsigned char* r0 = lds + wave * 3072; LAS unsigned char* r1 = r0 + 1024; LAS unsigned char* r2 = r0 + 2048;
  for (int xs = 0; xs < (nsl ? 1 : 8); ++xs) {
    const int x = nsl ? (blockIdx.x & 7) : xs;
    const unsigned char* VS = P.ws + WS_TAB + (size_t)(layer * 2 + 1) * 16 * MiB + (size_t)x * 2 * MiB;
    if (wi >= TOK) continue;
    v4u q0[4], q1[4], q2[4], q3[4];
    const int last = wi + ((TOK - 1 - wi) / NW) * NW;
    vs_hdr_issue(hl, wi, r0);
    vs_hdr_issue(hl, wi + NW < TOK ? wi + NW : last, r1);
    asm volatile("s_waitcnt vmcnt(0)" ::: "memory");
    {
      v4u e[4];
#pragma unroll
      for (int i = 0; i < 4; ++i) e[i] = *(const LAS v4u*)(r0 + g * 64 + i * 16);
      vs_rows4(q0, e[0], VS, p); vs_rows4(q1, e[1], VS, p); vs_rows4(q2, e[2], VS, p); vs_rows4(q3, e[3], VS, p);
    }
    for (int tok = wi; tok < TOK; tok += 3 * NW) {
      vs_step<DRY>(P, tok, tok + 2 * NW, last, VS, x, lane, hl, r0, r1, r2, q0, q1, q2, q3);
      vs_step<DRY>(P, tok + NW, tok + 3 * NW, last, VS, x, lane, hl, r1, r2, r0, q0, q1, q2, q3);
      vs_step<DRY>(P, tok + 2 * NW, tok + 4 * NW, last, VS, x, lane, hl, r2, r0, r1, q0, q1, q2, q3);
    }
    asm volatile("s_waitcnt vmcnt(0)" ::: "memory");
  }
}
__device__ __forceinline__ void phase_final_norm(const Params& P, const float* g) {
  const int lane = threadIdx.x & 63, wave = __builtin_amdgcn_readfirstlane(threadIdx.x >> 6);
  const int gw = blockIdx.x * 8 + wave, NGW = gridDim.x * 8;
  float4 gg[4];
#pragma unroll
  for (int i = 0; i < 4; ++i) gg[i] = *(const float4*)(g + i * 256 + lane * 4);
  for (int tok = gw; tok < TOK; tok += NGW) {
    float* xo = P.out + (size_t)tok * 1024;
    float4 x[4]; float ss = 0.f;
#pragma unroll
    for (int i = 0; i < 4; ++i) { x[i] = *(const float4*)(xo + i * 256 + lane * 4); ss += x[i].x * x[i].x + x[i].y * x[i].y + x[i].z * x[i].z + x[i].w * x[i].w; }
    ss = wave_sum_dpp(ss);
    const float rs = rsqrtf(ss * (1.0f / 1024.0f) + 1e-6f);
#pragma unroll
    for (int i = 0; i < 4; ++i) { float4 y; y.x = x[i].x * rs * gg[i].x; y.y = x[i].y * rs * gg[i].y; y.z = x[i].z * rs * gg[i].z; y.w = x[i].w * rs * gg[i].w; *(float4*)(xo + i * 256 + lane * 4) = y; }
  }
}

constexpr size_t WS_PART = WS_BIG + 128 * MiB;
struct UsHdr { int4 e[4]; v4u hq; };
__device__ __forceinline__ void us_hdr(UsHdr& h, const Params& P, int tok, int g, int p, int x) {
  const int4* ep = (const int4*)((const int*)(P.ws + WS_EID) + (size_t)tok * 128 + g * 16);
#pragma unroll
  for (int i = 0; i < 4; ++i) h.e[i] = ep[i];
  h.hq = *(const v4u*)(P.ws + WS_H8 + (size_t)tok * 1024 + x * 128 + p * 16);
}
template <bool DRY>
__device__ __forceinline__ void us_step(const Params& P, const UsHdr& cur, UsHdr& pre, int tok, int pf_tok, const unsigned char* US, int x, int lane) {
  const int g = lane >> 3, p = lane & 7;
  const int ee[16] = {cur.e[0].x, cur.e[0].y, cur.e[0].z, cur.e[0].w, cur.e[1].x, cur.e[1].y, cur.e[1].z, cur.e[1].w, cur.e[2].x, cur.e[2].y, cur.e[2].z, cur.e[2].w, cur.e[3].x, cur.e[3].y, cur.e[3].z, cur.e[3].w};
  v4u ub[16];
#pragma unroll
  for (int it = 0; it < 16; ++it) ub[it] = *(const v4u*)(US + (unsigned)(ee[it] * 128 + p * 16));
  us_hdr(pre, P, pf_tok < TOK ? pf_tok : tok, g, p, x);
  int r0 = 0, r1 = 0;
#pragma unroll
  for (int it = 0; it < 16; ++it) {
    int is = __builtin_amdgcn_sdot4((int)ub[it].x, (int)cur.hq.x, 0, false);
    is = __builtin_amdgcn_sdot4((int)ub[it].y, (int)cur.hq.y, is, false);
    is = __builtin_amdgcn_sdot4((int)ub[it].z, (int)cur.hq.z, is, false);
    is = __builtin_amdgcn_sdot4((int)ub[it].w, (int)cur.hq.w, is, false);
    is += __builtin_amdgcn_mov_dpp(is, 0xB1, 0xF, 0xF, true); is += __builtin_amdgcn_mov_dpp(is, 0x4E, 0xF, 0xF, true); is += __builtin_amdgcn_mov_dpp(is, 0x141, 0xF, 0xF, true);
    if (it < 8) r0 = (p == it) ? is : r0; else r1 = (p == it - 8) ? is : r1;
  }
  _Float16* part = (_Float16*)(P.ws + WS_PART) + ((size_t)x * TOK + tok) * 128 + g * 16 + p;
  if (!DRY || r0 == 0x7FFFFFFF) { part[0] = (_Float16)((float)r0 * 0.015625f); part[8] = (_Float16)((float)r1 * 0.015625f); }
}
template <bool DRY>
__device__ __forceinline__ void phase_uslice(const Params& P, int layer) {
  int lane = threadIdx.x & 63; const int wave = __builtin_amdgcn_readfirstlane(threadIdx.x >> 6);
  asm volatile("" : "+v"(lane));
  const int nsl = (gridDim.x & 7) == 0 ? 8 : 0;
  const int g = lane >> 3, p = lane & 7;
  const int wi = (nsl ? (blockIdx.x >> 3) : blockIdx.x) * 8 + wave, NW = (nsl ? (gridDim.x >> 3) : gridDim.x) * 8;
  for (int xs = 0; xs < (nsl ? 1 : 8); ++xs) {
    const int x = nsl ? (blockIdx.x & 7) : xs;
    const unsigned char* US = P.ws + WS_TAB + (size_t)(layer * 2) * 16 * MiB + (size_t)x * 2 * MiB;
    if (wi >= TOK) continue;
    UsHdr h0, h1, h2;
    us_hdr(h0, P, wi, g, p, x);
    us_hdr(h1, P, wi + NW < TOK ? wi + NW : wi, g, p, x);
    for (int tok = wi; tok < TOK; tok += 3 * NW) {
      us_step<DRY>(P, h0, h2, tok, tok + 2 * NW, US, x, lane);
      if (tok + NW >= TOK) break;
      us_step<DRY>(P, h1, h0, tok + NW, tok + 3 * NW, US, x, lane);
      if (tok + 2 * NW >= TOK) break;
      us_step<DRY>(P, h2, h1, tok + 2 * NW, tok + 4 * NW, US, x, lane);
    }
  }
}
__device__ __forceinline__ void phase_ureduce(const Params& P) {
  const _Float16* PART = (const _Float16*)(P.ws + WS_PART); const float* GSU = (const float*)(P.ws + WS_GSU); const float* GSV = (const float*)(P.ws + WS_GSV);
  const float* SH = (const float*)(P.ws + WS_SH); unsigned* WQ = (unsigned*)(P.ws + WS_WQ); float* SW = (float*)(P.ws + WS_SW);
  const int lane = threadIdx.x & 63;
  const size_t n4 = (size_t)TOK * 128 / 4, NT = (size_t)gridDim.x * blockDim.x;
  for (size_t i = (size_t)blockIdx.x * blockDim.x + threadIdx.x; i < n4; i += NT) {
    typedef _Float16 h4 __attribute__((ext_vector_type(4)));
    float s0 = 0.f, s1 = 0.f, s2 = 0.f, s3 = 0.f;
#pragma unroll
    for (int x = 0; x < 8; ++x) { const h4 t = *(const h4*)(PART + (size_t)x * TOK * 128 + i * 4); s0 += (float)t[0]; s1 += (float)t[1]; s2 += (float)t[2]; s3 += (float)t[3]; }
    s0 *= 64.f; s1 *= 64.f; s2 *= 64.f; s3 *= 64.f;
    const float4 su = *(const float4*)(GSU + i * 4), gv = *(const float4*)(GSV + i * 4);
    const float sh = SH[i >> 5];
    float4 w;
    w.x = gv.x * gelu_as(s0 * (su.x * sh)); w.y = gv.y * gelu_as(s1 * (su.y * sh));
    w.z = gv.z * gelu_as(s2 * (su.z * sh)); w.w = gv.w * gelu_as(s3 * (su.w * sh));
    float wm = fmaxf(fmaxf(fabsf(w.x), fabsf(w.y)), fmaxf(fabsf(w.z), fabsf(w.w)));
    wm = fmaxf(wm, __int_as_float(__builtin_amdgcn_mov_dpp(__float_as_int(wm), 0xB1, 0xF, 0xF, true)));
    wm = fmaxf(wm, __int_as_float(__builtin_amdgcn_mov_dpp(__float_as_int(wm), 0x4E, 0xF, 0xF, true)));
    wm = fmaxf(wm, __int_as_float(__builtin_amdgcn_mov_dpp(__float_as_int(wm), 0x141, 0xF, 0xF, true)));
    wm = fmaxf(wm, __int_as_float(__builtin_amdgcn_mov_dpp(__float_as_int(wm), 0x140, 0xF, 0xF, true)));
    wm = fmaxf(wm, __int_as_float(__builtin_amdgcn_ds_bpermute((lane ^ 16) * 4, __float_as_int(wm))));
    const float sw = wm > 0.f ? wm * (1.0f / 127.0f) : 1.0f, winv = 1.0f / sw;
    WQ[i] = q8(w.x, winv) | (q8(w.y, winv) << 8) | (q8(w.z, winv) << 16) | (q8(w.w, winv) << 24);
    if ((lane & 31) == 0) SW[i >> 5] = sw;
  }
}
constexpr int GA_PITCH = 136;
constexpr int GA_WL = 0;
constexpr int GA_VT = 34816;
constexpr int GA_ST = 34816 + 69632;
template <bool DRY>
__device__ __forceinline__ void phase_gate_a(const Params& P, LAS unsigned char* lds) {
  const int tid = threadIdx.x, lane = tid & 63, wave = __builtin_amdgcn_readfirstlane(tid >> 6);
  bf16_t* U = (bf16_t*)(P.ws + WS_BIG); const bf16_t* V = U + (size_t)TOK * 2048;
  const float* ln_g = P.in[6]; const float* ln_b = P.in[7]; const float* w_s = P.in[8]; const float* b_s = P.in[9];
  LAS bf16_t* Wl = (LAS bf16_t*)(lds + GA_WL); LAS bf16_t* vT = (LAS bf16_t*)(lds + GA_VT); LAS float* st = (LAS float*)(lds + GA_ST);
  for (int chunk = blockIdx.x; chunk < TOK / 128; chunk += gridDim.x) {
    const size_t T0 = (size_t)chunk * 128;
    for (int i = 0; i < 16; ++i) {
      const int t = wave * 16 + i;
      const bf16_t* vr = V + (T0 + t) * 2048;
      float x[32]; float s = 0.f;
#pragma unroll
      for (int j = 0; j < 4; ++j) { const v4u w = *(const v4u*)(vr + (j * 64 + lane) * 8); const unsigned ww[4] = {w.x, w.y, w.z, w.w};
#pragma unroll
        for (int q = 0; q < 4; ++q) { x[j * 8 + 2 * q] = __uint_as_float(ww[q] << 16); x[j * 8 + 2 * q + 1] = __uint_as_float(ww[q] & 0xFFFF0000u); s += x[j * 8 + 2 * q] + x[j * 8 + 2 * q + 1]; } }
      s = wave_sum_dpp(s); const float mu = s * (1.0f / 2048.0f);
      float q2 = 0.f;
#pragma unroll
      for (int j = 0; j < 32; ++j) { const float d = x[j] - mu; q2 += d * d; }
      q2 = wave_sum_dpp(q2);
      if (lane == 0) { st[2 * t] = mu; st[2 * t + 1] = rsqrtf(q2 * (1.0f / 2048.0f) + 1e-6f); }
    }
    __syncthreads();
    for (int g = 0; g < 8; ++g) {
      {
        const int t = tid >> 2, c0 = (tid & 3) * 32;
        const float* src = w_s + ((size_t)g * 128 + t) * 128 + c0;
#pragma unroll
        for (int q = 0; q < 4; ++q) {
          const float4 a = *(const float4*)(src + q * 8), b = *(const float4*)(src + q * 8 + 4);
          const int s0 = c0 + q * 8;
          v4u o;
          o.x = pk2(s0 + 0 <= t ? a.x : 0.f, s0 + 1 <= t ? a.y : 0.f); o.y = pk2(s0 + 2 <= t ? a.z : 0.f, s0 + 3 <= t ? a.w : 0.f);
          o.z = pk2(s0 + 4 <= t ? b.x : 0.f, s0 + 5 <= t ? b.y : 0.f); o.w = pk2(s0 + 6 <= t ? b.z : 0.f, s0 + 7 <= t ? b.w : 0.f);
          *(LAS v4u*)(Wl + t * GA_PITCH + s0) = o;
        }
      }
      {
        const int sh0 = (wave & 1) * 64 + (lane >> 2), cq = (wave >> 1) * 64 + (lane & 3) * 8;
#pragma unroll
        for (int jc = 0; jc < 2; ++jc) {
          const int c0 = cq + jc * 32;
          const float4 ga = *(const float4*)(ln_g + g * 256 + c0), gb = *(const float4*)(ln_g + g * 256 + c0 + 4), ba = *(const float4*)(ln_b + g * 256 + c0), bb = *(const float4*)(ln_b + g * 256 + c0 + 4);
          const float gg[8] = {ga.x, ga.y, ga.z, ga.w, gb.x, gb.y, gb.z, gb.w}, bv[8] = {ba.x, ba.y, ba.z, ba.w, bb.x, bb.y, bb.z, bb.w};
#pragma unroll
          for (int jr = 0; jr < 4; ++jr) {
            const int s = sh0 + jr * 16;
            const float mu = st[2 * s], rs = st[2 * s + 1];
            const v4u w = *(const v4u*)(V + (T0 + s) * 2048 + g * 256 + c0); const unsigned ww[4] = {w.x, w.y, w.z, w.w};
#pragma unroll
            for (int q = 0; q < 4; ++q) {
              const float y0 = (__uint_as_float(ww[q] << 16) - mu) * rs * gg[2 * q] + bv[2 * q];
              const float y1 = (__uint_as_float(ww[q] & 0xFFFF0000u) - mu) * rs * gg[2 * q + 1] + bv[2 * q + 1];
              vT[(c0 + 2 * q) * GA_PITCH + s] = f2bf(y0); vT[(c0 + 2 * q + 1) * GA_PITCH + s] = f2bf(y1);
            }
          }
        }
      }
      __syncthreads();
      f32x4 acc[2][8];
#pragma unroll
      for (int ci = 0; ci < 2; ++ci)
#pragma unroll
        for (int jt = 0; jt < 8; ++jt) acc[ci][jt] = (f32x4){0.f, 0.f, 0.f, 0.f};
      const int fr = lane & 15, fq = lane >> 4;
#pragma unroll
      for (int kb = 0; kb < 4; ++kb) {
        bf16x8_t a[2];
#pragma unroll
        for (int ci = 0; ci < 2; ++ci) a[ci] = *(const LAS bf16x8_t*)(vT + (wave * 32 + ci * 16 + fr) * GA_PITCH + kb * 32 + fq * 8);
#pragma unroll
        for (int jt = 0; jt < 8; ++jt) {
          if (kb <= (jt >> 1)) {
            const bf16x8_t b = *(const LAS bf16x8_t*)(Wl + (jt * 16 + fr) * GA_PITCH + kb * 32 + fq * 8);
#pragma unroll
            for (int ci = 0; ci < 2; ++ci) acc[ci][jt] = __builtin_amdgcn_mfma_f32_16x16x32_bf16(a[ci], b, acc[ci][jt], 0, 0, 0);
          }
        }
      }
#pragma unroll
      for (int jt = 0; jt < 8; ++jt) {
        const int t = jt * 16 + fr; const float bs = b_s[g * 128 + t];
#pragma unroll
        for (int ci = 0; ci < 2; ++ci) {
          bf16_t* up = U + (T0 + t) * 2048 + g * 256 + wave * 32 + ci * 16 + fq * 4;
          const v2u uu = *(const v2u*)up;
          v2u o;
          o.x = pk2(__uint_as_float(uu.x << 16) * (acc[ci][jt][0] + bs), __uint_as_float(uu.x & 0xFFFF0000u) * (acc[ci][jt][1] + bs));
          o.y = pk2(__uint_as_float(uu.y << 16) * (acc[ci][jt][2] + bs), __uint_as_float(uu.y & 0xFFFF0000u) * (acc[ci][jt][3] + bs));
          if (!DRY || acc[ci][jt][0] == 1234.5f) *(v2u*)up = o;
        }
      }
      __syncthreads();
    }
  }
}
constexpr size_t WS_PROJ = WS_BIG;
constexpr size_t WS_QT = WS_BIG + 208 * MiB;
constexpr size_t WS_KT = WS_BIG + 240 * MiB;
constexpr size_t WS_AM = WS_BIG + 272 * MiB;
constexpr size_t WS_DEC = WS_BIG + 288 * MiB;
constexpr size_t WS_O = WS_H;
__device__ __forceinline__ float row16_sum_dpp(float v) {
  int x;
  x = __builtin_amdgcn_mov_dpp(__float_as_int(v), 0xB1, 0xF, 0xF, true); v += __int_as_float(x);
  x = __builtin_amdgcn_mov_dpp(__float_as_int(v), 0x4E, 0xF, 0xF, true); v += __int_as_float(x);
  x = __builtin_amdgcn_mov_dpp(__float_as_int(v), 0x141, 0xF, 0xF, true); v += __int_as_float(x);
  x = __builtin_amdgcn_mov_dpp(__float_as_int(v), 0x140, 0xF, 0xF, true); v += __int_as_float(x);
  return v;
}

__device__ __forceinline__ void phase_gla_prep(const Params& P, LAS unsigned char* lds) {
  const int tid = threadIdx.x, lane = tid & 63, wave = __builtin_amdgcn_readfirstlane(tid >> 6);
  const int fr = lane & 15, fq = lane >> 4;
  const bf16_t* PROJ = (const bf16_t*)(P.ws + WS_PROJ);
  bf16_t* QT = (bf16_t*)(P.ws + WS_QT); bf16_t* KT = (bf16_t*)(P.ws + WS_KT); bf16_t* AM = (bf16_t*)(P.ws + WS_AM); float* DEC = (float*)(P.ws + WS_DEC);
  const float* w_g2 = P.in[12]; const float* b_g = P.in[13];
  LAS bf16_t* ql = (LAS bf16_t*)lds; LAS bf16_t* kl = (LAS bf16_t*)(lds + 17408); LAS float* tot = (LAS float*)(lds + 34816);
  const int kk = tid & 127, tq = wave >> 1;
  const float scale = 0.08838834764831845f;
  for (int item = blockIdx.x; item < 2048; item += gridDim.x) {
    const int h = item & 3; const size_t T0 = (size_t)(item >> 2) * 64;
    bf16_t qraw[16], kraw[16];
#pragma unroll
    for (int i = 0; i < 16; ++i) { const bf16_t* pr = PROJ + (T0 + tq * 16 + i) * BPROJ + h * 128 + kk; qraw[i] = pr[0]; kraw[i] = pr[512]; }
    float wg[16];
#pragma unroll
    for (int j = 0; j < 16; ++j) wg[j] = w_g2[j * 512 + h * 128 + kk];
    const float bg = b_g[h * 128 + kk];
    float G[16]; float run = 0.f;
#pragma unroll
    for (int i = 0; i < 16; ++i) {
      const float* gl = (const float*)(P.ws + WS_GLR) + (T0 + tq * 16 + i) * 16;
      const float4 g0 = *(const float4*)gl, g1 = *(const float4*)(gl + 4), g2 = *(const float4*)(gl + 8), g3 = *(const float4*)(gl + 12);
      const float gw[16] = {g0.x, g0.y, g0.z, g0.w, g1.x, g1.y, g1.z, g1.w, g2.x, g2.y, g2.z, g2.w, g3.x, g3.y, g3.z, g3.w};
      float a = bg;
#pragma unroll
      for (int j = 0; j < 16; ++j) a += gw[j] * wg[j];
      const float ls = fminf(a, 0.f) - log1pf(__expf(-fabsf(a)));
      run += ls * 0.0625f; G[i] = run;
    }
    tot[tq * 128 + kk] = run;
    __syncthreads();
    float off = 0.f, glast = 0.f;
#pragma unroll
    for (int q = 0; q < 4; ++q) { const float v = tot[q * 128 + kk]; off += (q < tq) ? v : 0.f; glast += v; }
    unsigned kh[8];
#pragma unroll
    for (int i = 0; i < 16; ++i) {
      const int t = tq * 16 + i; const float Gi = G[i] + off;
      const float qv = bf2f(qraw[i]) * scale * __expf(Gi);
      const float kv = bf2f(kraw[i]);
      const bf16_t qb = f2bf(qv);
      ql[t * 136 + kk] = qb; kl[t * 136 + kk] = f2bf(kv * __expf(-Gi));
      QT[((size_t)item * 64 + t) * 128 + kk] = qb;
      const unsigned khb = f2bf(kv * __expf(glast - Gi));
      if (i & 1) kh[i >> 1] |= khb << 16; else kh[i >> 1] = khb;
    }
    {
      bf16_t* kt = KT + ((size_t)item * 128 + kk) * 64 + tq * 16;
      v4u o; o.x = kh[0]; o.y = kh[1]; o.z = kh[2]; o.w = kh[3]; *(v4u*)kt = o;
      o.x = kh[4]; o.y = kh[5]; o.z = kh[6]; o.w = kh[7]; *(v4u*)(kt + 8) = o;
    }
    if (tq == 0) DEC[(size_t)item * 128 + kk] = __expf(glast);
    __syncthreads();
#pragma unroll
    for (int u = 0; u < 2; ++u) {
      const int tile = wave * 2 + u, si = tile >> 2, ti = tile & 3;
      f32x4 acc = (f32x4){0.f, 0.f, 0.f, 0.f};
      if (si <= ti) {
#pragma unroll
        for (int ks = 0; ks < 4; ++ks) {
          const bf16x8_t a = *(const LAS bf16x8_t*)(kl + (si * 16 + fr) * 136 + ks * 32 + fq * 8);
          const bf16x8_t b = *(const LAS bf16x8_t*)(ql + (ti * 16 + fr) * 136 + ks * 32 + fq * 8);
          acc = __builtin_amdgcn_mfma_f32_16x16x32_bf16(a, b, acc, 0, 0, 0);
        }
      }
      const int t = ti * 16 + fr, s0 = si * 16 + 4 * fq;
      v2u o;
      o.x = pk2(s0 + 0 <= t ? acc[0] : 0.f, s0 + 1 <= t ? acc[1] : 0.f);
      o.y = pk2(s0 + 2 <= t ? acc[2] : 0.f, s0 + 3 <= t ? acc[3] : 0.f);
      *(v2u*)(AM + ((size_t)item * 64 + t) * 64 + s0) = o;
    }
    __syncthreads();
  }
}

struct GlaFrag { bf16x8_t am[2], q[4], k[2]; f32x4 dec; v4u vr[2]; };
template <int ROLE>
__device__ __forceinline__ void gla_load(GlaFrag& F, const Params& P, int b, int h, int vs, int c, int wave, int lane) {
  const int fr = lane & 15, fq = lane >> 4;
  const size_t item = ((size_t)b * 128 + c) * 4 + h;
  const bf16_t* QT = (const bf16_t*)(P.ws + WS_QT); const bf16_t* KT = (const bf16_t*)(P.ws + WS_KT); const bf16_t* AM = (const bf16_t*)(P.ws + WS_AM); const float* DEC = (const float*)(P.ws + WS_DEC);
  if (ROLE == 0) {
    const bf16_t* ar = AM + (item * 64 + wave * 16 + fr) * 64 + fq * 8;
    F.am[0] = *(const bf16x8_t*)ar; F.am[1] = *(const bf16x8_t*)(ar + 32);
    const bf16_t* qr = QT + (item * 64 + wave * 16 + fr) * 128 + fq * 8;
#pragma unroll
    for (int kq = 0; kq < 4; ++kq) F.q[kq] = *(const bf16x8_t*)(qr + kq * 32);
  }
  const bf16_t* kr = KT + (item * 128 + wave * 16 + fr) * 64 + fq * 8;
  F.k[0] = *(const bf16x8_t*)kr; F.k[1] = *(const bf16x8_t*)(kr + 32);
  F.dec = *(const f32x4*)(DEC + item * 128 + wave * 16 + fq * 4);
  if (ROLE == 1) {
    const bf16_t* vp = (const bf16_t*)(P.ws + WS_PROJ) + ((size_t)b * SEQ + (size_t)c * 64 + lane) * BPROJ + 1024 + h * 256 + vs * 16;
    F.vr[0] = *(const v4u*)vp; F.vr[1] = *(const v4u*)(vp + 8);
  }
}
__device__ __forceinline__ void gla_write_vt(LAS bf16_t* vT, const GlaFrag& F, int lane) {
  const unsigned w[8] = {F.vr[0].x, F.vr[0].y, F.vr[0].z, F.vr[0].w, F.vr[1].x, F.vr[1].y, F.vr[1].z, F.vr[1].w};
#pragma unroll
  for (int i = 0; i < 8; ++i) { vT[(2 * i) * 72 + lane] = (bf16_t)(w[i] & 0xFFFFu); vT[(2 * i + 1) * 72 + lane] = (bf16_t)(w[i] >> 16); }
}
template <int ROLE, int MODE>
__device__ __forceinline__ void gla_step(const Params& P, const GlaFrag& cur, const GlaFrag& nxt, GlaFrag& pre, int b, int h, int vs, int c, int wave, int lane, LAS bf16_t* vT, LAS bf16_t* ST, f32x4& S) {
  const int fr = lane & 15, fq = lane >> 4;
  bf16_t* O = (bf16_t*)(P.ws + WS_O);
  if (MODE != 2 && ROLE != 0) gla_load<ROLE>(pre, P, b, h, vs, c + 3 < 128 ? c + 3 : 127, wave, lane);
  const bf16x8_t v0 = *(const LAS bf16x8_t*)(vT + fr * 72 + fq * 8), v1 = *(const LAS bf16x8_t*)(vT + fr * 72 + 32 + fq * 8);
  if (ROLE == 0) {
    f32x4 o = (f32x4){0.f, 0.f, 0.f, 0.f};
    o = __builtin_amdgcn_mfma_f32_16x16x32_bf16(v0, cur.am[0], o, 0, 0, 0);
    o = __builtin_amdgcn_mfma_f32_16x16x32_bf16(v1, cur.am[1], o, 0, 0, 0);
#pragma unroll
    for (int kq = 0; kq < 4; ++kq) {
      const bf16x8_t s = *(const LAS bf16x8_t*)(ST + fr * 136 + kq * 32 + fq * 8);
      o = __builtin_amdgcn_mfma_f32_16x16x32_bf16(s, cur.q[kq], o, 0, 0, 0);
    }
    v2u ow; ow.x = pk2(o[0], o[1]); ow.y = pk2(o[2], o[3]);
    if (MODE == 0 || o[0] == 1234.5f) *(v2u*)(O + ((size_t)b * SEQ + (size_t)c * 64 + wave * 16 + fr) * 1024 + h * 256 + vs * 16 + fq * 4) = ow;
  }
  S = S * cur.dec;
  S = __builtin_amdgcn_mfma_f32_16x16x32_bf16(cur.k[0], v0, S, 0, 0, 0);
  S = __builtin_amdgcn_mfma_f32_16x16x32_bf16(cur.k[1], v1, S, 0, 0, 0);
  if (MODE != 1) __syncthreads();
  { v2u sw; sw.x = pk2(S[0], S[1]); sw.y = pk2(S[2], S[3]); *(LAS v2u*)(ST + fr * 136 + wave * 16 + fq * 4) = sw; }
  if (ROLE == 1 && c + 1 < 128) gla_write_vt(vT, nxt, lane);
  if (MODE != 2 && ROLE == 0) gla_load<ROLE>(pre, P, b, h, vs, c + 3 < 128 ? c + 3 : 127, wave, lane);
  if (MODE != 1) __syncthreads();
}
template <int ROLE, int MODE>
__device__ __forceinline__ void gla_scan_role(const Params& P, LAS unsigned char* lds, int wave, int lane) {
  const int fr = lane & 15, fq = lane >> 4;
  LAS bf16_t* vT = (LAS bf16_t*)lds;
  LAS bf16_t* ST = (LAS bf16_t*)(lds + 2304);
  for (int wid = blockIdx.x; wid < 256; wid += gridDim.x) {
    const int xcd = wid & 7, jj = wid >> 3, pair = xcd * 2 + (jj >> 4), vs = jj & 15, b = pair >> 2, h = pair & 3;
    f32x4 S = (f32x4){0.f, 0.f, 0.f, 0.f};
    GlaFrag f0, f1, f2, f3;
    gla_load<ROLE>(f0, P, b, h, vs, 0, wave, lane);
    gla_load<ROLE>(f1, P, b, h, vs, 1, wave, lane);
    gla_load<ROLE>(f2, P, b, h, vs, 2, wave, lane);
    __syncthreads();
    *(LAS v2u*)(ST + fr * 136 + wave * 16 + fq * 4) = (v2u){0u, 0u};
    if (ROLE == 1) gla_write_vt(vT, f0, lane);
    __syncthreads();
    for (int c = 0; c < 128; c += 4) {
      gla_step<ROLE, MODE>(P, f0, f1, f3, b, h, vs, c, wave, lane, vT, ST, S);
      gla_step<ROLE, MODE>(P, f1, f2, f0, b, h, vs, c + 1, wave, lane, vT, ST, S);
      gla_step<ROLE, MODE>(P, f2, f3, f1, b, h, vs, c + 2, wave, lane, vT, ST, S);
      gla_step<ROLE, MODE>(P, f3, f0, f2, b, h, vs, c + 3, wave, lane, vT, ST, S);
    }
  }
}
template <int MODE = 0>
__device__ __forceinline__ void phase_gla_scan(const Params& P, LAS unsigned char* lds) {
  const int lane = threadIdx.x & 63, wave = __builtin_amdgcn_readfirstlane(threadIdx.x >> 6);
  if (wave < 4) gla_scan_role<0, MODE>(P, lds, wave, lane);
  else if (wave == 4) gla_scan_role<1, MODE>(P, lds, wave, lane);
  else gla_scan_role<2, MODE>(P, lds, wave, lane);
}

struct PostIn { v4u o0, o1, r0, r1; };
__device__ __forceinline__ void gla_post_load(PostIn& x, const Params& P, int tok, int lane) {
  const bf16_t* O = (const bf16_t*)(P.ws + WS_O); const bf16_t* PROJ = (const bf16_t*)(P.ws + WS_PROJ);
  x.o0 = *(const v4u*)(O + (size_t)tok * 1024 + lane * 16); x.o1 = *(const v4u*)(O + (size_t)tok * 1024 + lane * 16 + 8);
  x.r0 = *(const v4u*)(PROJ + (size_t)tok * BPROJ + 2048 + lane * 16); x.r1 = *(const v4u*)(PROJ + (size_t)tok * BPROJ + 2048 + lane * 16 + 8);
}
__device__ __forceinline__ void gla_post_row(const PostIn& in, const Params& P, int tok, int lane, const float (&gn)[16]) {
  const unsigned ow[8] = {in.o0.x, in.o0.y, in.o0.z, in.o0.w, in.o1.x, in.o1.y, in.o1.z, in.o1.w}, rw[8] = {in.r0.x, in.r0.y, in.r0.z, in.r0.w, in.r1.x, in.r1.y, in.r1.z, in.r1.w};
  float x[16], r[16]; float ss = 0.f;
#pragma unroll
  for (int i = 0; i < 8; ++i) { x[2 * i] = __uint_as_float(ow[i] << 16); x[2 * i + 1] = __uint_as_float(ow[i] & 0xFFFF0000u); r[2 * i] = __uint_as_float(rw[i] << 16); r[2 * i + 1] = __uint_as_float(rw[i] & 0xFFFF0000u);
    ss += x[2 * i] * x[2 * i] + x[2 * i + 1] * x[2 * i + 1]; }
  ss = row16_sum_dpp(ss);
  const float rs = rsqrtf(ss * (1.0f / 256.0f) + 1e-6f);
  float y[16];
#pragma unroll
  for (int i = 0; i < 16; ++i) { const float sl = r[i] * __builtin_amdgcn_rcpf(1.0f + __expf(-r[i])); y[i] = x[i] * rs * gn[i] * sl; }
  float am = 0.f;
#pragma unroll
  for (int i = 0; i < 16; ++i) am = fmaxf(am, fabsf(y[i]));
  am = wave_max_dpp(am);
  const float sc = am > 0.f ? am * (1.0f / 127.0f) : 1.0f, inv = 1.0f / sc;
  v4u q;
  q.x = q8(y[0], inv) | (q8(y[1], inv) << 8) | (q8(y[2], inv) << 16) | (q8(y[3], inv) << 24);
  q.y = q8(y[4], inv) | (q8(y[5], inv) << 8) | (q8(y[6], inv) << 16) | (q8(y[7], inv) << 24);
  q.z = q8(y[8], inv) | (q8(y[9], inv) << 8) | (q8(y[10], inv) << 16) | (q8(y[11], inv) << 24);
  q.w = q8(y[12], inv) | (q8(y[13], inv) << 8) | (q8(y[14], inv) << 16) | (q8(y[15], inv) << 24);
  *(v4u*)(P.ws + WS_H8 + (size_t)tok * 1024 + lane * 16) = q;
  if (lane == 0) ((float*)(P.ws + WS_SH))[tok] = sc;
}
__device__ __forceinline__ void phase_gla_post(const Params& P) {
  const int lane = threadIdx.x & 63, wave = __builtin_amdgcn_readfirstlane(threadIdx.x >> 6);
  const int gw = blockIdx.x * 8 + wave, NGW = gridDim.x * 8;
  const float* ng = P.in[14] + (lane & 15) * 16;
  float gn[16];
#pragma unroll
  for (int q = 0; q < 4; ++q) { const float4 g4 = *(const float4*)(ng + q * 4); gn[q * 4] = g4.x; gn[q * 4 + 1] = g4.y; gn[q * 4 + 2] = g4.z; gn[q * 4 + 3] = g4.w; }
  PostIn a, b, c, d;
  for (int tok = gw; tok < TOK; tok += 4 * NGW) {
    const bool vb = tok + NGW < TOK, vc = tok + 2 * NGW < TOK, vd = tok + 3 * NGW < TOK;
    gla_post_load(a, P, tok, lane);
    if (vb) gla_post_load(b, P, tok + NGW, lane);
    if (vc) gla_post_load(c, P, tok + 2 * NGW, lane);
    if (vd) gla_post_load(d, P, tok + 3 * NGW, lane);
    gla_post_row(a, P, tok, lane, gn);
    if (vb) gla_post_row(b, P, tok + NGW, lane, gn);
    if (vc) gla_post_row(c, P, tok + 2 * NGW, lane, gn);
    if (vd) gla_post_row(d, P, tok + 3 * NGW, lane, gn);
  }
}
__device__ __forceinline__ void transpose_item(const float* W, int K, int N, bf16_t* WT, LAS float* scr, int item, int nblk, int lane) {
  const int kb = item / nblk, nb = item % nblk, k0 = 64 * kb, n0 = 32 * nb;
  const int nn = n0 + (lane & 31);
#pragma unroll 8
  for (int i = 0; i < 32; ++i) { const int kk = 2 * i + (lane >> 5); scr[kk * 33 + (lane & 31)] = (nn < N) ? W[(size_t)(k0 + kk) * N + nn] : 0.f; }
  asm volatile("s_waitcnt lgkmcnt(0)" ::: "memory");
  const int c = lane & 7;
#pragma unroll
  for (int j = 0; j < 4; ++j) { const int n = (lane >> 3) + 8 * j; const LAS float* s = scr + (8 * c) * 33 + n;
    v4u o; o.x = pk2(s[0 * 33], s[1 * 33]); o.y = pk2(s[2 * 33], s[3 * 33]); o.z = pk2(s[4 * 33], s[5 * 33]); o.w = pk2(s[6 * 33], s[7 * 33]);
    *(v4u*)(WT + (size_t)(n0 + n) * K + k0 + 8 * c) = o; }
  asm volatile("s_waitcnt lgkmcnt(0)" ::: "memory");
}

__device__ __forceinline__ void phase_prep(const Params& P, LAS unsigned char* lds) {
  const int lane = threadIdx.x & 63, wave = __builtin_amdgcn_readfirstlane(threadIdx.x >> 6);
  LAS float* scr = (LAS float*)(lds + wave * 16384);
  const int gw = blockIdx.x * 8 + wave, NGW = gridDim.x * 8;
  unsigned char* ws = P.ws;
  constexpr int I_AIN = (1024 / 64) * (4096 / 32), I_AOUT = (2048 / 64) * (1024 / 32), I_BIN = (1024 / 64) * (BPROJ / 32), I_BOUT = (1024 / 64) * (1024 / 32), I_FOLD = 2048;
  constexpr int NITEMS = I_AIN + I_AOUT + I_BIN + I_BOUT + I_FOLD;
  for (int it = gw; it < NITEMS; it += NGW) {
    int r = it;
    if (r < I_AIN) { transpose_item(P.in[4], 1024, 4096, (bf16_t*)(ws + WS_WA_IN), scr, r, 4096 / 32, lane); continue; } r -= I_AIN;
    if (r < I_AOUT) { transpose_item(P.in[10], 2048, 1024, (bf16_t*)(ws + WS_WA_OUT), scr, r, 1024 / 32, lane); continue; } r -= I_AOUT;
    if (r < I_BIN) { transpose_item(P.in[11], 1024, 3088, (bf16_t*)(ws + WS_WB_IN), scr, r, BPROJ / 32, lane); continue; } r -= I_BIN;
    if (r < I_BOUT) { transpose_item(P.in[15], 1024, 1024, (bf16_t*)(ws + WS_WB_OUT), scr, r, 1024 / 32, lane); continue; } r -= I_BOUT;
    fold_item(P, r, lane, scr);
  }
}

template <int MODE>
__device__ __forceinline__ void phase_gemm(const Params& P, LAS unsigned char* lds, int layer) {
  unsigned char* ws = P.ws;
  const bf16_t* H = (const bf16_t*)(ws + WS_H);
  if constexpr (MODE == 0) {
    pg8::Gemm g{(const bf16_t*)(ws + WS_H8), (const bf16_t*)(ws + WS_WA_IN8), TOK, 4096, 512}; pg8::StaticOrder S; S.init(TOK, 4096, gridDim.x, blockIdx.x);
    pg8::EpiBf16I8<1> E{(bf16_t*)(ws + WS_BIG), 2048, P.in[5], 2048, (size_t)TOK * 2048, (const float*)(ws + WS_SH), (const float*)(ws + WS_SA_IN)};
    pg8::gemm_phase<pg8::EpiBf16I8<1>, pg8::StaticOrder, true, true, true>(lds, g, S, E);
  } else if constexpr (MODE == 1) {
    pg8::Gemm g{(const bf16_t*)(ws + WS_BIG), (const bf16_t*)(ws + WS_WA_OUT), TOK, 1024, 2048}; pg8::StaticOrder S; S.init(TOK, 1024, gridDim.x, blockIdx.x);
    pg8::EpiResF32 E{P.out, P.in[0], 1024};
    pg8::gemm_phase<pg8::EpiResF32, pg8::StaticOrder, true, true>(lds, g, S, E);
  } else if constexpr (MODE == 2) {
    pg8::Gemm g{H, (const bf16_t*)(ws + WS_WP) + (size_t)layer * 2048 * 1024, TOK, 2048, 1024}; pg8::StaticOrder S; S.init(TOK, 2048, gridDim.x, blockIdx.x);
    pg8::EpiF16 E{(_Float16*)(ws + WS_BIG), 2048};
    pg8::gemm_phase<pg8::EpiF16, pg8::StaticOrder, true, true>(lds, g, S, E);
  } else if constexpr (MODE == 3) {
    pg8::Gemm g{(const bf16_t*)(ws + WS_H8), (const bf16_t*)(ws + WS_WB_IN8), TOK, 3072, 512}; pg8::StaticOrder S; S.init(TOK, 3072, gridDim.x, blockIdx.x);
    pg8::EpiBf16I8<0> E{(bf16_t*)(ws + WS_BIG), BPROJ, nullptr, 0, 0, (const float*)(ws + WS_SH), (const float*)(ws + WS_SB_IN)};
    pg8::gemm_phase<pg8::EpiBf16I8<0>, pg8::StaticOrder, true, true, true>(lds, g, S, E);
  } else {
    pg8::Gemm g{(const bf16_t*)(ws + WS_H8), (const bf16_t*)(ws + WS_WB_OUT8), TOK, 1024, 512}; pg8::StaticOrder S; S.init(TOK, 1024, gridDim.x, blockIdx.x);
    pg8::EpiResF32I8 E{P.out, P.out, (const float*)(ws + WS_SH), (const float*)(ws + WS_SB_OUT), 1024};
    pg8::gemm_phase<pg8::EpiResF32I8, pg8::StaticOrder, true, true, true>(lds, g, S, E);
  }
}

#define RLX_AGENT __ATOMIC_RELAXED, __HIP_MEMORY_SCOPE_AGENT
#define XB_TMO      128
#define XB_XCNT(j)  (256  + 64 * (j))
#define XB_XSUB(j)  (1280 + 64 * (j))
#define XB_XGEN(j)  (2304 + 64 * (j))
#define XB_TOP      3328
#define XB_TOPGEN   3392
#define XCD_BAR_WORDS 3456
#define XB_SPIN_CAP (1u << 18)

__device__ __forceinline__ unsigned xb_ld(unsigned* p)              { return __hip_atomic_load(p, __ATOMIC_RELAXED, __HIP_MEMORY_SCOPE_AGENT); }
__device__ __forceinline__ unsigned xb_add(unsigned* p, unsigned v) { return __hip_atomic_fetch_add(p, v, __ATOMIC_RELAXED, __HIP_MEMORY_SCOPE_AGENT); }
__device__ __forceinline__ unsigned xb_xcc_id() { return (unsigned)__builtin_amdgcn_s_getreg((3 << 11) | 20) & 0xFu; }
#define XB_SPIN(cond, bar) do { unsigned _sp = 0; while (cond) { __builtin_amdgcn_s_sleep(1); \
    if ((++_sp & 255u) == 0u) { if (xb_ld(&(bar)[XB_TMO])) break; if (_sp > XB_SPIN_CAP) { atomicAdd(&(bar)[XB_TMO], 1u); break; } } } } while (0)

struct XcdBarrier {
    unsigned* bar; unsigned x;
    volatile LAS unsigned* st;
};

__device__ __forceinline__ XcdBarrier xcd_barrier_post(unsigned* bar, volatile LAS unsigned* st) {
    XcdBarrier b; b.bar = bar; b.x = xb_xcc_id(); b.st = st;
    if (threadIdx.x == 0) (void)xb_add(&bar[XB_XCNT(b.x)], 1u);
    return b;
}
__device__ __forceinline__ void xcd_barrier_complete(unsigned* bar, unsigned x, unsigned& nloc, unsigned& nx) {
    const unsigned G = gridDim.x * gridDim.y * gridDim.z;
    unsigned sum, cnt, mine, sp = 0u;
    for (;;) {
        sum = 0u; cnt = 0u; mine = 0u;
#pragma unroll
        for (unsigned j = 0; j < 16; ++j) { const unsigned c = xb_ld(&bar[XB_XCNT(j)]); sum += c; cnt += (c > 0u) ? 1u : 0u; mine = (j == x) ? c : mine; }
        if (sum == G) break;
        __builtin_amdgcn_s_sleep(1);
        if ((++sp & 255u) == 0u) { if (xb_ld(&bar[XB_TMO])) break; if (sp > XB_SPIN_CAP) { atomicAdd(&bar[XB_TMO], 1u); break; } }
    }
    nloc = mine > 0u ? mine : 1u; nx = cnt > 0u ? cnt : 1u;
}

__device__ __forceinline__ void xcd_barrier(const XcdBarrier& b) {
    asm volatile("s_waitcnt vmcnt(0)" ::: "memory");
    __syncthreads();
    if (threadIdx.x == 0) {
        unsigned* bar = b.bar;
        __builtin_amdgcn_s_waitcnt(0);
        unsigned nloc = b.st[0], nx = b.st[1];
        if (nloc == 0u) { xcd_barrier_complete(bar, b.x, nloc, nx); b.st[0] = nloc; b.st[1] = nx; }
        const unsigned old = xb_add(&bar[XB_XSUB(b.x)], 1u);
        const unsigned gen = old / nloc;
        if (old + 1u == (gen + 1u) * nloc) {
            __builtin_amdgcn_fence(__ATOMIC_RELEASE, "agent");
            asm volatile("s_waitcnt vmcnt(0)" ::: "memory");
            const unsigned og = xb_add(&bar[XB_TOP], 1u);
            const unsigned tg = og / nx;
            if (og + 1u == (tg + 1u) * nx) xb_add(&bar[XB_TOPGEN], 1u);
            else XB_SPIN(xb_ld(&bar[XB_TOPGEN]) == tg, bar);
            __builtin_amdgcn_fence(__ATOMIC_ACQUIRE, "agent");
            xb_add(&bar[XB_XGEN(b.x)], 1u);
            asm volatile("s_waitcnt vmcnt(0)" ::: "memory");
        } else {
            XB_SPIN(xb_ld(&bar[XB_XGEN(b.x)]) == gen, bar);
            __builtin_amdgcn_fence(__ATOMIC_ACQUIRE, "agent");
            asm volatile("s_waitcnt vmcnt(0)" ::: "memory");
        }
    }
    __syncthreads();
}


__device__ __forceinline__ void phase_glr(const Params& P) {
  typedef int i32x4_t __attribute__((ext_vector_type(4)));
  const int lane = threadIdx.x & 63, wave = __builtin_amdgcn_readfirstlane(threadIdx.x >> 6), fr = lane & 15, fq = lane >> 4;
  const unsigned char* H8 = P.ws + WS_H8; const unsigned char* WT = P.ws + WS_WB_IN8 + (size_t)3072 * 1024;
  const float* SH = (const float*)(P.ws + WS_SH); const float* SB = (const float*)(P.ws + WS_SB_IN) + 3072;
  float* GLR = (float*)(P.ws + WS_GLR);
  for (int job = blockIdx.x * 8 + wave; job < TOK / 16; job += gridDim.x * 8) {
    const unsigned char* ar = H8 + ((size_t)job * 16 + fr) * 1024 + fq * 16; const unsigned char* br = WT + (size_t)fr * 1024 + fq * 16;
    i32x4_t acc = (i32x4_t){0, 0, 0, 0};
#pragma unroll 8
    for (int ks = 0; ks < 16; ++ks) acc = __builtin_amdgcn_mfma_i32_16x16x64_i8(*(const i32x4_t*)(ar + ks * 64), *(const i32x4_t*)(br + ks * 64), acc, 0, 0, 0);
    const float sb = SB[fr];
#pragma unroll
    for (int r = 0; r < 4; ++r) { const size_t tk = (size_t)job * 16 + 4 * fq + r; GLR[tk * 16 + fr] = (float)acc[r] * (SH[tk] * sb); }
  }
}

template <bool EMIT8, bool WRITE_H = true>
__device__ __forceinline__ void rmsnorm_row(const Params& P, int tok, float4 (&x)[4], const float4 (&gg)[4], int lane) {
  bf16_t* H = (bf16_t*)(P.ws + WS_H);
  float ss = 0.f;
#pragma unroll
  for (int i = 0; i < 4; ++i) ss += x[i].x * x[i].x + x[i].y * x[i].y + x[i].z * x[i].z + x[i].w * x[i].w;
  ss = wave_sum_dpp(ss);
  const float rs = rsqrtf(ss * (1.0f / 1024.0f) + 1e-6f);
  float am = 0.f; unsigned hb[8];
#pragma unroll
  for (int i = 0; i < 4; ++i) {
    x[i].x *= rs * gg[i].x; x[i].y *= rs * gg[i].y; x[i].z *= rs * gg[i].z; x[i].w *= rs * gg[i].w;
    hb[2 * i] = pk2(x[i].x, x[i].y); hb[2 * i + 1] = pk2(x[i].z, x[i].w);
    if (WRITE_H) { v2u o; o.x = hb[2 * i]; o.y = hb[2 * i + 1]; *(v2u*)(H + (size_t)tok * 1024 + i * 256 + lane * 4) = o; }
  }
  if (EMIT8) {
    float hv[16];
#pragma unroll
    for (int i = 0; i < 8; ++i) { hv[2 * i] = __uint_as_float(hb[i] << 16); hv[2 * i + 1] = __uint_as_float(hb[i] & 0xFFFF0000u); am = fmaxf(am, fmaxf(fabsf(hv[2 * i]), fabsf(hv[2 * i + 1]))); }
    am = wave_max_dpp(am);
    const float sh = am > 0.f ? am * (1.0f / 127.0f) : 1.0f, hinv = 1.0f / sh;
    v4u q;
    q.x = q8(hv[0], hinv) | (q8(hv[1], hinv) << 8) | (q8(hv[2], hinv) << 16) | (q8(hv[3], hinv) << 24);
    q.y = q8(hv[4], hinv) | (q8(hv[5], hinv) << 8) | (q8(hv[6], hinv) << 16) | (q8(hv[7], hinv) << 24);
    q.z = q8(hv[8], hinv) | (q8(hv[9], hinv) << 8) | (q8(hv[10], hinv) << 16) | (q8(hv[11], hinv) << 24);
    q.w = q8(hv[12], hinv) | (q8(hv[13], hinv) << 8) | (q8(hv[14], hinv) << 16) | (q8(hv[15], hinv) << 24);
    *(v4u*)(P.ws + WS_H8 + (size_t)tok * 1024 + lane * 16) = q;
    if (lane == 0) ((float*)(P.ws + WS_SH))[tok] = sh;
  }
}
template <bool EMIT8, bool WRITE_H = true>
__device__ __forceinline__ void phase_rmsnorm(const Params& P, const float* src, const float* g) {
  const int lane = threadIdx.x & 63, wave = __builtin_amdgcn_readfirstlane(threadIdx.x >> 6);
  const int gw = blockIdx.x * 8 + wave, NGW = gridDim.x * 8;
  float4 gg[4];
#pragma unroll
  for (int i = 0; i < 4; ++i) gg[i] = *(const float4*)(g + i * 256 + lane * 4);
  float4 xa[4], xb[4], xc[4], xd[4];
  for (int tok = gw; tok < TOK; tok += 4 * NGW) {
    const bool vb = tok + NGW < TOK, vc = tok + 2 * NGW < TOK, vd = tok + 3 * NGW < TOK;
#pragma unroll
    for (int i = 0; i < 4; ++i) xa[i] = *(const float4*)(src + (size_t)tok * 1024 + i * 256 + lane * 4);
    if (vb) {
#pragma unroll
      for (int i = 0; i < 4; ++i) xb[i] = *(const float4*)(src + (size_t)(tok + NGW) * 1024 + i * 256 + lane * 4); }
    if (vc) {
#pragma unroll
      for (int i = 0; i < 4; ++i) xc[i] = *(const float4*)(src + (size_t)(tok + 2 * NGW) * 1024 + i * 256 + lane * 4); }
    if (vd) {
#pragma unroll
      for (int i = 0; i < 4; ++i) xd[i] = *(const float4*)(src + (size_t)(tok + 3 * NGW) * 1024 + i * 256 + lane * 4); }
    rmsnorm_row<EMIT8, WRITE_H>(P, tok, xa, gg, lane);
    if (vb) rmsnorm_row<EMIT8, WRITE_H>(P, tok + NGW, xb, gg, lane);
    if (vc) rmsnorm_row<EMIT8, WRITE_H>(P, tok + 2 * NGW, xc, gg, lane);
    if (vd) rmsnorm_row<EMIT8, WRITE_H>(P, tok + 3 * NGW, xd, gg, lane);
  }
}

__device__ __forceinline__ void w8_rows(const Params& P, const bf16_t* src0, unsigned char* dst0, float* sc0, int rows, int lane, int gw, int NGW) {
  for (int r = gw; r < rows; r += NGW) {
    const bf16_t* src = src0 + (size_t)r * 1024;
    float hv[16]; float am = 0.f;
#pragma unroll
    for (int i = 0; i < 4; ++i) { const v2u w = *(const v2u*)(src + i * 256 + lane * 4);
      hv[4 * i] = __uint_as_float(w.x << 16); hv[4 * i + 1] = __uint_as_float(w.x & 0xFFFF0000u); hv[4 * i + 2] = __uint_as_float(w.y << 16); hv[4 * i + 3] = __uint_as_float(w.y & 0xFFFF0000u);
      am = fmaxf(am, fmaxf(fmaxf(fabsf(hv[4 * i]), fabsf(hv[4 * i + 1])), fmaxf(fabsf(hv[4 * i + 2]), fabsf(hv[4 * i + 3])))); }
    am = wave_max_dpp(am);
    const float sc = am > 0.f ? am * (1.0f / 127.0f) : 1.0f, inv = 1.0f / sc;
    v4u q;
    q.x = q8(hv[0], inv) | (q8(hv[1], inv) << 8) | (q8(hv[2], inv) << 16) | (q8(hv[3], inv) << 24);
    q.y = q8(hv[4], inv) | (q8(hv[5], inv) << 8) | (q8(hv[6], inv) << 16) | (q8(hv[7], inv) << 24);
    q.z = q8(hv[8], inv) | (q8(hv[9], inv) << 8) | (q8(hv[10], inv) << 16) | (q8(hv[11], inv) << 24);
    q.w = q8(hv[12], inv) | (q8(hv[13], inv) << 8) | (q8(hv[14], inv) << 16) | (q8(hv[15], inv) << 24);
    *(v4u*)(dst0 + (size_t)r * 1024 + lane * 16) = q;
    if (lane == 0) sc0[r] = sc;
  }
}
__device__ __forceinline__ void phase_w8(const Params& P) {
  const int lane = threadIdx.x & 63, wave = __builtin_amdgcn_readfirstlane(threadIdx.x >> 6);
  const int gw = blockIdx.x * 8 + wave, NGW = gridDim.x * 8;
  w8_rows(P, (const bf16_t*)(P.ws + WS_WA_IN), P.ws + WS_WA_IN8, (float*)(P.ws + WS_SA_IN), 4096, lane, gw, NGW);
  w8_rows(P, (const bf16_t*)(P.ws + WS_WB_IN), P.ws + WS_WB_IN8, (float*)(P.ws + WS_SB_IN), BPROJ, lane, gw, NGW);
  for (int r = gw; r < 1024; r += NGW) {
    const bf16_t* src = (const bf16_t*)(P.ws + WS_WB_OUT) + (size_t)r * 1024 + lane * 16;
    const v4u w0 = *(const v4u*)src, w1 = *(const v4u*)(src + 8); const unsigned ww[8] = {w0.x, w0.y, w0.z, w0.w, w1.x, w1.y, w1.z, w1.w};
    float hv[16]; float am = 0.f;
#pragma unroll
    for (int i = 0; i < 8; ++i) { hv[2 * i] = __uint_as_float(ww[i] << 16); hv[2 * i + 1] = __uint_as_float(ww[i] & 0xFFFF0000u); am = fmaxf(am, fmaxf(fabsf(hv[2 * i]), fabsf(hv[2 * i + 1]))); }
    am = wave_max_dpp(am);
    const float sc = am > 0.f ? am * (1.0f / 127.0f) : 1.0f, inv = 1.0f / sc;
    v4u q;
    q.x = q8(hv[0], inv) | (q8(hv[1], inv) << 8) | (q8(hv[2], inv) << 16) | (q8(hv[3], inv) << 24);
    q.y = q8(hv[4], inv) | (q8(hv[5], inv) << 8) | (q8(hv[6], inv) << 16) | (q8(hv[7], inv) << 24);
    q.z = q8(hv[8], inv) | (q8(hv[9], inv) << 8) | (q8(hv[10], inv) << 16) | (q8(hv[11], inv) << 24);
    q.w = q8(hv[12], inv) | (q8(hv[13], inv) << 8) | (q8(hv[14], inv) << 16) | (q8(hv[15], inv) << 24);
    *(v4u*)(P.ws + WS_WB_OUT8 + (size_t)r * 1024 + lane * 16) = q;
    if (lane == 0) ((float*)(P.ws + WS_SB_OUT))[r] = sc;
  }
}

#ifndef PROBE
#define PROBE 0
#endif
__global__ void __launch_bounds__(512, 2) mega_fwd(Params P) {
  extern __shared__ __attribute__((aligned(16))) unsigned char lds_raw[];
  LAS unsigned char* lds = (LAS unsigned char*)lds_raw;
  cg::grid_group grid = cg::this_grid();
  volatile LAS unsigned* bst = (volatile LAS unsigned*)(lds + 131072 + 64);
  if (threadIdx.x == 0) { bst[0] = 0u; bst[1] = 0u; }
  __syncthreads();
  const XcdBarrier bar = xcd_barrier_post((unsigned*)(P.ws + WS_BAR), bst);
#define SEAM() do { xcd_barrier(bar); } while (0)
#if PROBE & 32
  phase_prep(P, lds); phase_tabconv8(P); phase_rmsnorm<true, false>(P, P.in[0], P.in[1]);
#endif
  phase_prep(P, lds); phase_tabconv8(P); phase_rmsnorm<true, false>(P, P.in[0], P.in[1]);
  grid.sync();
#if PROBE & 8
  phase_gemm<0>(P, lds, 0);
#endif
  phase_w8(P);
  SEAM();
  phase_gemm<0>(P, lds, 0);
  SEAM();
#if PROBE & 262144
  SEAM(); SEAM(); SEAM(); SEAM(); SEAM(); SEAM(); SEAM(); SEAM(); SEAM(); SEAM();
#endif
#if PROBE & 4
  phase_gate_a<true>(P, lds);
#endif
  phase_gate_a<false>(P, lds);
  SEAM();
#if PROBE & 8
  phase_gemm<1>(P, lds, 0);
#endif
  phase_gemm<1>(P, lds, 0);
  SEAM();
#if PROBE & 65536
  phase_rmsnorm<true>(P, P.out, P.in[2]);
#endif
  phase_rmsnorm<true>(P, P.out, P.in[2]);
  SEAM();
#if PROBE & 8
  phase_gemm<2>(P, lds, 0);
#endif
  phase_gemm<2>(P, lds, 0);
  SEAM();
#if PROBE & 16
  phase_topk(P, lds, 0);
#endif
  phase_topk(P, lds, 0);
  SEAM();
  phase_uslice<false>(P, 0);
  SEAM();
  phase_ureduce(P);
  SEAM();
#if PROBE & 1
  phase_vslice<true>(P, lds, 0); SEAM();
#endif
#if PROBE & 256
  phase_uslice<true>(P, 0); SEAM();
#endif
  phase_vslice<false>(P, lds, 0);
  SEAM();
  phase_rmsnorm<true, false>(P, P.out, P.in[1] + 1024);
  SEAM();
#if PROBE & 8
  phase_gemm<3>(P, lds, 0);
#endif
  phase_gemm<3>(P, lds, 0); phase_glr(P);
  SEAM();
#if PROBE & 4098
  phase_gla_prep(P, lds);
#endif
  phase_gla_prep(P, lds);
  SEAM();
#if PROBE & 8194
  phase_gla_scan<3>(P, lds); __syncthreads();
#endif
#if PROBE & 16384
  phase_gla_scan<1>(P, lds); __syncthreads();
#endif
#if PROBE & 32768
  phase_gla_scan<2>(P, lds); __syncthreads();
#endif
  phase_gla_scan(P, lds);
  SEAM();
#if PROBE & 64
  phase_gla_post(P);
#endif
  phase_gla_post(P);
  SEAM();
  phase_gemm<4>(P, lds, 0);
  SEAM();
#if PROBE & 65536
  phase_rmsnorm<true>(P, P.out, P.in[2] + 1024);
#endif
  phase_rmsnorm<true>(P, P.out, P.in[2] + 1024);
  SEAM();
#if PROBE & 131072
  phase_gemm<2>(P, lds, 1);
#endif
  phase_gemm<2>(P, lds, 1);
  SEAM();
#if PROBE & 16
  phase_topk(P, lds, 1);
#endif
  phase_topk(P, lds, 1);
  SEAM();
  phase_uslice<false>(P, 1);
  SEAM();
  phase_ureduce(P);
  SEAM();
#if PROBE & 1
  phase_vslice<true>(P, lds, 1); SEAM();
#endif
  phase_vslice<false>(P, lds, 1);
  SEAM();
  phase_final_norm(P, P.in[3]);
#undef SEAM
}

extern "C" void kernel_launch(void* const* d_in, const int* in_sizes, int n_in, void* d_out, int out_size, void* d_ws, size_t ws_size, hipStream_t stream) {
  static int grid = 0;
  if (grid == 0) {
    int dev = 0, cus = 0, per_cu = 0;
    if (hipGetDevice(&dev) != hipSuccess || hipDeviceGetAttribute(&cus, hipDeviceAttributeMultiprocessorCount, dev) != hipSuccess) { fprintf(stderr, "kernel_launch: device query failed\n"); grid = -1; return; }
    if (hipFuncSetAttribute((const void*)mega_fwd, hipFuncAttributeMaxDynamicSharedMemorySize, LDS_BYTES) != hipSuccess) { fprintf(stderr, "kernel_launch: hipFuncSetAttribute failed\n"); grid = -1; return; }
    if (hipOccupancyMaxActiveBlocksPerMultiprocessor(&per_cu, (const void*)mega_fwd, 512, LDS_BYTES) != hipSuccess || per_cu < 1) { fprintf(stderr, "kernel_launch: occupancy query gave %d\n", per_cu); grid = -1; return; }
    grid = cus * per_cu;
    if (grid > 256) grid = 256;
    fprintf(stderr, "kernel_launch: cus %d per_cu %d grid %d ws %zu\n", cus, per_cu, grid, ws_size);
  }
  if (grid < 0) return;
  (void)hipMemsetAsync((char*)d_ws + WS_BAR, 0, XCD_BAR_WORDS * 4, stream);
  Params P{};
  for (int i = 0; i < 21; ++i) P.in[i] = (const float*)d_in[i];
  P.out = (float*)d_out; P.ws = (unsigned char*)d_ws;
  void* args[] = {&P};
  hipError_t e = hipLaunchCooperativeKernel((const void*)mega_fwd, dim3(grid), dim3(512), args, LDS_BYTES, stream);
  if (e != hipSuccess) fprintf(stderr, "kernel_launch: cooperative launch failed: %s (grid %d)\n", hipGetErrorString(e), grid);
}
```

```cpp
#include <hip/hip_runtime.h>
#include <cstdio>
#include <cstdint>
#include <hip/hip_cooperative_groups.h>
namespace cg = cooperative_groups;
#define PROBE 0
#define VS_VAR 0
namespace pg8 {
#define PG8_LAS __attribute__((address_space(3)))
typedef unsigned short bf16_t;
typedef short bf16x8 __attribute__((ext_vector_type(8)));
typedef float f32x4 __attribute__((ext_vector_type(4)));
typedef unsigned u32x4 __attribute__((ext_vector_type(4)));
constexpr int BM = 256, BK = 64, HALF = 128, HTB = HALF * BK * 2  , STAGE_BYTES = 8 * HTB, NXCD = 8, WGM = 8;

__host__ __device__ __forceinline__ int lds_byte(int r, int c) { const int st = (r >> 4) * 2 + (c >> 5), rr = r & 15, cc = c & 31, ob = rr * 64 + cc * 2; return st * 1024 + (ob ^ (((ob >> 9) & 1) << 5)); }
__host__ __device__ __forceinline__ void stage_rc(int b, int& R, int& C) { const int st = b / 1024, sb = b % 1024, swz = sb ^ (((sb >> 9) & 1) << 5); R = (st >> 1) * 16 + swz / 64; C = (st & 1) * 32 + (swz % 64) / 2; }
__host__ __device__ __forceinline__ int perm32(int rho) { const int n = rho >> 4, i = rho & 15; return 8 * (i >> 2) + 4 * n + (i & 3); }

struct Unit { int pm, pn; };
struct Gemm { const bf16_t* A; const bf16_t* Bt; int M, N, K; };

struct StaticOrder {
    int nM, nN, nwg, G, c;
    __host__ __device__ void init(int M, int N, int G_, int c_) { nM = M / BM; nN = N / BM; nwg = nM * nN; G = G_; c = c_; }
    __host__ __device__ bool next(int i, Unit& u) const {
        const long L = (long)i * G + c; if (L >= nwg) return false;
        int wgid = (int)L; { const int q = nwg / NXCD, r = nwg % NXCD, xcd = wgid % NXCD, off = wgid / NXCD; wgid = (xcd < r ? xcd * (q + 1) : r * (q + 1) + (xcd - r) * q) + off; }
        const int nig = WGM * nN, gid = wgid / nig, fm = gid * WGM, gsz = (nM - fm) < WGM ? (nM - fm) : WGM;
        u.pm = fm + ((wgid % nig) % gsz); u.pn = (wgid % nig) / gsz; return true;
    }
    __device__ __forceinline__ void a_ready(const Unit&) const {}
    __device__ __forceinline__ void done(const Unit&) const {}
};

__device__ __forceinline__ unsigned cvt_pk_bf16(float lo, float hi) { unsigned r; asm volatile("v_cvt_pk_bf16_f32 %0, %1, %2" : "=v"(r) : "v"(lo), "v"(hi)); return r; }
typedef float f32x2 __attribute__((ext_vector_type(2)));
__device__ __forceinline__ f32x2 gelu_pk(f32x2 v) {
    const f32x2 av = __builtin_elementwise_abs(v), d = av * 0.2316418882f + 1.0f;
    f32x2 t; t.x = __builtin_amdgcn_rcpf(d.x); t.y = __builtin_amdgcn_rcpf(d.y);
    f32x2 q = t * 0.5307027145f + (-0.7265760135f); q = q * t + 0.7107068705f; q = q * t + (-0.142248368f); q = q * t + 0.127414796f; q = q * t;
    const f32x2 s = (v * v) * (-0.72134752044f);
    f32x2 e; e.x = __builtin_amdgcn_exp2f(s.x); e.y = __builtin_amdgcn_exp2f(s.y);
    const f32x2 m = v * (q * e), r = v - m;
    f32x2 o; o.x = v.x < 0.f ? m.x : r.x; o.y = v.y < 0.f ? m.y : r.y; return o;
}

template <int ACT  > struct EpiBf16 {
    static constexpr bool PERM = true, AFTER_DRAIN = false; static_assert(ACT == 0 || ACT == 1, "EpiBf16: ACT is 0 (none) or 1 (gelu_pk)");
    bf16_t* O; int ldc; const float* bias; int split_cols; size_t split_stride; float scale0;
    __device__ __forceinline__ void operator()(const f32x4 (&acc)[2][2][4][2], const Unit& u, int wr, int wc, int fr, int fq) const {
        const int row0 = u.pm * BM + wr * 64 + fr; int colt = u.pn * BM; bf16_t* base = O;
        float sc = 1.f; if (split_cols) { const int t = colt / split_cols; base += (size_t)t * split_stride; colt -= t * split_cols; if (t == 0) sc = scale0; }
        const int col0 = colt + wc * 32 + 8 * fq, bcol0 = u.pn * BM + wc * 32 + 8 * fq;
        f32x4 bv[2][2];
#pragma unroll
        for (int bj = 0; bj < 2; ++bj)
#pragma unroll
            for (int n = 0; n < 2; ++n) bv[bj][n] = bias ? *(const f32x4*)(bias + bcol0 + bj * HALF + 4 * n) : (f32x4){0.f, 0.f, 0.f, 0.f};
#pragma unroll
        for (int ai = 0; ai < 2; ++ai)
#pragma unroll
            for (int m = 0; m < 4; ++m) { bf16_t* rowp = base + (size_t)(row0 + ai * HALF + m * 16) * ldc + col0;
#pragma unroll
                for (int bj = 0; bj < 2; ++bj) { f32x4 v0 = acc[ai][bj][m][0] + bv[bj][0], v1 = acc[ai][bj][m][1] + bv[bj][1];
                    if (ACT == 1) { f32x2 a = gelu_pk((f32x2){v0[0], v0[1]}), b = gelu_pk((f32x2){v0[2], v0[3]}), c = gelu_pk((f32x2){v1[0], v1[1]}), d = gelu_pk((f32x2){v1[2], v1[3]});
                        v0 = (f32x4){a.x, a.y, b.x, b.y}; v1 = (f32x4){c.x, c.y, d.x, d.y}; }
                    v0 = v0 * sc; v1 = v1 * sc; u32x4 w; w.x = cvt_pk_bf16(v0[0], v0[1]); w.y = cvt_pk_bf16(v0[2], v0[3]); w.z = cvt_pk_bf16(v1[0], v1[1]); w.w = cvt_pk_bf16(v1[2], v1[3]);
                    *(u32x4*)(rowp + bj * HALF) = w; } }
    }
};

struct EpiResF32 {
    static constexpr bool PERM = false, AFTER_DRAIN = false;
    float* C; const float* R; int ldc;
    __device__ __forceinline__ void operator()(const f32x4 (&acc)[2][2][4][2], const Unit& u, int wr, int wc, int fr, int fq) const {
        const int row0 = u.pm * BM + wr * 64 + fr, col0 = u.pn * BM + wc * 32 + 4 * fq;
#pragma unroll
        for (int ai = 0; ai < 2; ++ai)
#pragma unroll
            for (int m = 0; m < 4; ++m) { const size_t off = (size_t)(row0 + ai * HALF + m * 16) * ldc + col0;
#pragma unroll
                for (int bj = 0; bj < 2; ++bj)
#pragma unroll
                    for (int n = 0; n < 2; ++n) { f32x4 v = acc[ai][bj][m][n]; if (R) v = v + *(const f32x4*)(R + off + bj * HALF + n * 16); *(f32x4*)(C + off + bj * HALF + n * 16) = v; } }
    }
};
typedef int i32x4 __attribute__((ext_vector_type(4)));
template <bool INT8> __device__ __forceinline__ f32x4 pg8_mma(bf16x8 a, bf16x8 b, f32x4 c) {
    if constexpr (INT8) return __builtin_bit_cast(f32x4, __builtin_amdgcn_mfma_i32_16x16x64_i8(__builtin_bit_cast(i32x4, a), __builtin_bit_cast(i32x4, b), __builtin_bit_cast(i32x4, c), 0, 0, 0));
    else return __builtin_amdgcn_mfma_f32_16x16x32_bf16(a, b, c, 0, 0, 0);
}
template <int ACT> struct EpiBf16I8 {
    static constexpr bool PERM = true, AFTER_DRAIN = false;
    bf16_t* O; int ldc; const float* bias; int split_cols; size_t split_stride; const float* sa; const float* sb;
    __device__ __forceinline__ void operator()(const f32x4 (&acc)[2][2][4][2], const Unit& u, int wr, int wc, int fr, int fq) const {
        const int row0 = u.pm * BM + wr * 64 + fr; int colt = u.pn * BM; bf16_t* base = O;
        if (split_cols) { const int t = colt / split_cols; base += (size_t)t * split_stride; colt -= t * split_cols; }
        const int col0 = colt + wc * 32 + 8 * fq, bcol0 = u.pn * BM + wc * 32 + 8 * fq;
        f32x4 bv[2][2], cs[2][2];
#pragma unroll
        for (int bj = 0; bj < 2; ++bj)
#pragma unroll
            for (int n = 0; n < 2; ++n) { bv[bj][n] = bias ? *(const f32x4*)(bias + bcol0 + bj * HALF + 4 * n) : (f32x4){0.f, 0.f, 0.f, 0.f}; cs[bj][n] = *(const f32x4*)(sb + bcol0 + bj * HALF + 4 * n); }
#pragma unroll
        for (int ai = 0; ai < 2; ++ai)
#pragma unroll
            for (int m = 0; m < 4; ++m) { const int row = row0 + ai * HALF + m * 16; const float ra = sa[row]; bf16_t* rowp = base + (size_t)row * ldc + col0;
#pragma unroll
                for (int bj = 0; bj < 2; ++bj) { const i32x4 i0 = __builtin_bit_cast(i32x4, acc[ai][bj][m][0]), i1 = __builtin_bit_cast(i32x4, acc[ai][bj][m][1]);
                    f32x4 v0, v1;
#pragma unroll
                    for (int j = 0; j < 4; ++j) { v0[j] = (float)i0[j] * (ra * cs[bj][0][j]) + bv[bj][0][j]; v1[j] = (float)i1[j] * (ra * cs[bj][1][j]) + bv[bj][1][j]; }
                    if (ACT == 1) { f32x2 a = gelu_pk((f32x2){v0[0], v0[1]}), b = gelu_pk((f32x2){v0[2], v0[3]}), c = gelu_pk((f32x2){v1[0], v1[1]}), d = gelu_pk((f32x2){v1[2], v1[3]});
                        v0 = (f32x4){a.x, a.y, b.x, b.y}; v1 = (f32x4){c.x, c.y, d.x, d.y}; }
                    u32x4 w; w.x = cvt_pk_bf16(v0[0], v0[1]); w.y = cvt_pk_bf16(v0[2], v0[3]); w.z = cvt_pk_bf16(v1[0], v1[1]); w.w = cvt_pk_bf16(v1[2], v1[3]);
                    *(u32x4*)(rowp + bj * HALF) = w; } }
    }
};
struct EpiResF32I8 {
    static constexpr bool PERM = false, AFTER_DRAIN = false;
    float* C; const float* R; const float* sa; const float* sb; int ldc;
    __device__ __forceinline__ void operator()(const f32x4 (&acc)[2][2][4][2], const Unit& u, int wr, int wc, int fr, int fq) const {
        const int row0 = u.pm * BM + wr * 64 + fr, col0 = u.pn * BM + wc * 32 + 4 * fq;
        f32x4 cs[2][2];
#pragma unroll
        for (int bj = 0; bj < 2; ++bj)
#pragma unroll
            for (int n = 0; n < 2; ++n) cs[bj][n] = *(const f32x4*)(sb + col0 + bj * HALF + n * 16);
#pragma unroll
        for (int ai = 0; ai < 2; ++ai)
#pragma unroll
            for (int m = 0; m < 4; ++m) { const int row = row0 + ai * HALF + m * 16; const float ra = sa[row]; const size_t off = (size_t)row * ldc + col0;
#pragma unroll
                for (int bj = 0; bj < 2; ++bj)
#pragma unroll
                    for (int n = 0; n < 2; ++n) { const i32x4 iv = __builtin_bit_cast(i32x4, acc[ai][bj][m][n]); f32x4 v = *(const f32x4*)(R + off + bj * HALF + n * 16);
#pragma unroll
                        for (int j = 0; j < 4; ++j) v[j] += (float)iv[j] * (ra * cs[bj][n][j]);
                        *(f32x4*)(C + off + bj * HALF + n * 16) = v; } }
    }
};
struct EpiF16 {
    static constexpr bool PERM = true, AFTER_DRAIN = false;
    _Float16* O; int ldc;
    __device__ __forceinline__ void operator()(const f32x4 (&acc)[2][2][4][2], const Unit& u, int wr, int wc, int fr, int fq) const {
        typedef _Float16 h2 __attribute__((ext_vector_type(2)));
        const int row0 = u.pm * BM + wr * 64 + fr, col0 = u.pn * BM + wc * 32 + 8 * fq;
#pragma unroll
        for (int ai = 0; ai < 2; ++ai)
#pragma unroll
            for (int m = 0; m < 4; ++m) { _Float16* rowp = O + (size_t)(row0 + ai * HALF + m * 16) * ldc + col0;
#pragma unroll
                for (int bj = 0; bj < 2; ++bj) { const f32x4 v0 = acc[ai][bj][m][0], v1 = acc[ai][bj][m][1];
                    u32x4 w;
                    w.x = __builtin_bit_cast(unsigned, (h2){(_Float16)v0[0], (_Float16)v0[1]}); w.y = __builtin_bit_cast(unsigned, (h2){(_Float16)v0[2], (_Float16)v0[3]});
                    w.z = __builtin_bit_cast(unsigned, (h2){(_Float16)v1[0], (_Float16)v1[1]}); w.w = __builtin_bit_cast(unsigned, (h2){(_Float16)v1[2], (_Float16)v1[3]});
                    *(u32x4*)(rowp + bj * HALF) = w; } }
    }
};
template <class Epi, class Sched, bool ALIGN_EPI = false, bool SP2 = false, bool INT8 = false>
__device__ __forceinline__ void gemm_phase(PG8_LAS unsigned char* lds, const Gemm g, const Sched& S, const Epi& E) {
    int tid = threadIdx.x; asm volatile("" : "+v"(tid));
    const int wid = __builtin_amdgcn_readfirstlane(tid >> 6), lane = tid & 63, wr = wid >> 2, wc = wid & 3, fr = lane & 15, fq = lane >> 4;
    const int K = g.K, nt = K / BK;
    unsigned voffA[2], voffB[2];
#pragma unroll
    for (int i = 0; i < 2; ++i) { int R, C; stage_rc(tid * 16 + i * 8192, R, C); const int Rb = Epi::PERM ? ((R & ~31) + perm32(R & 31)) : R;
        voffA[i] = (unsigned)(R * K + C) * 2u; voffB[i] = (unsigned)(Rb * K + C) * 2u; }
    const size_t kstep = (size_t)(BK * 2);
    const size_t hstep = (size_t)HALF * K * 2;
    const size_t tstep = 2 * hstep;
    const unsigned ldsw = (unsigned)wid * 1024u;
    const int aoff = lds_byte(wr * 64 + fr, fq * 8), boff = lds_byte(wc * 32 + fr, fq * 8);
#define PG8_SA(b, h) (((b) * 2 + (h)) * HTB)
#define PG8_SB(b, h) ((4 + (b) * 2 + (h)) * HTB)
#define PG8_STAGE(bufoff, gbase, voff) do { _Pragma("unroll") for (int _i = 0; _i < 2; ++_i) \
        __builtin_amdgcn_global_load_lds((const unsigned*)((const char*)(gbase) + (voff)[_i]), (PG8_LAS unsigned*)(lds + (bufoff) + ldsw + _i * 8192), 16, 0, 0); } while (0)
#define PG8_LDA(dst, b, h) do { _Pragma("unroll") for (int m = 0; m < 4; ++m) _Pragma("unroll") for (int k = 0; k < 2; ++k) dst[m][k] = *(const PG8_LAS bf16x8*)(lds + PG8_SA(b, h) + aoff + m * 2048 + k * 1024); } while (0)
#define PG8_LDB(dst, b, h) do { _Pragma("unroll") for (int n = 0; n < 2; ++n) _Pragma("unroll") for (int k = 0; k < 2; ++k) dst[n][k] = *(const PG8_LAS bf16x8*)(lds + PG8_SB(b, h) + boff + n * 2048 + k * 1024); } while (0)
#define PG8_MMA(ai, bj, At, Bt) do { __builtin_amdgcn_s_setprio(1); _Pragma("unroll") for (int m = 0; m < 4; ++m) _Pragma("unroll") for (int n = 0; n < 2; ++n) _Pragma("unroll") for (int k = 0; k < 2; ++k) \
        acc[ai][bj][m][n] = pg8_mma<INT8>(Bt[n][k], At[m][k], acc[ai][bj][m][n]); __builtin_amdgcn_s_setprio(0); } while (0)
#define PG8_WAIT_V(n) asm volatile("s_waitcnt vmcnt(" #n ")" ::: "memory")
#define PG8_WAIT_L(n) asm volatile("s_waitcnt lgkmcnt(" #n ")" ::: "memory")
#define PG8_BAR __builtin_amdgcn_s_barrier()
#define PG8_SCHED __builtin_amdgcn_sched_barrier(0)
    Unit cur, nxt; int ui = 0;
    if (!S.next(0, cur)) return;
    f32x4 acc[2][2][4][2];
#pragma unroll
    for (int a = 0; a < 2; ++a)
#pragma unroll
        for (int b = 0; b < 2; ++b)
#pragma unroll
            for (int m = 0; m < 4; ++m)
#pragma unroll
                for (int n = 0; n < 2; ++n) acc[a][b][m][n] = (f32x4){0.f, 0.f, 0.f, 0.f};
    bf16x8 At[4][2], B0[2][2], B1[2][2];
    const char* cA = (const char*)g.A + (size_t)cur.pm * tstep; const char* cB = (const char*)g.Bt + (size_t)cur.pn * tstep;
    S.a_ready(cur);
    if constexpr (SP2) {
        PG8_STAGE(PG8_SB(0, 0), cB, voffB); PG8_STAGE(PG8_SB(0, 1), cB + hstep, voffB); PG8_STAGE(PG8_SA(0, 0), cA, voffA); PG8_STAGE(PG8_SA(0, 1), cA + hstep, voffA);
        if (wr == 1) PG8_BAR;
        PG8_WAIT_V(2); PG8_BAR;
        PG8_STAGE(PG8_SB(1, 0), cB + kstep, voffB); PG8_STAGE(PG8_SA(1, 0), cA + kstep, voffA); PG8_STAGE(PG8_SB(1, 1), cB + hstep + kstep, voffB);
        PG8_WAIT_V(6); PG8_BAR;
    } else {
        PG8_STAGE(PG8_SB(0, 0), cB, voffB); PG8_STAGE(PG8_SA(0, 0), cA, voffA); PG8_STAGE(PG8_SB(0, 1), cB + hstep, voffB); PG8_STAGE(PG8_SA(0, 1), cA + hstep, voffA);
        if (wr == 1) PG8_BAR;
        PG8_WAIT_V(4); PG8_BAR;
        PG8_STAGE(PG8_SB(1, 0), cB + kstep, voffB); PG8_STAGE(PG8_SA(1, 0), cA + kstep, voffA); PG8_STAGE(PG8_SB(1, 1), cB + hstep + kstep, voffB);
        PG8_WAIT_V(6); PG8_BAR;
    }
    for (;;) {
        const bool has_next = S.next(ui + 1, nxt);
        const char* nA = has_next ? (const char*)g.A + (size_t)nxt.pm * tstep : cA; const char* nB = has_next ? (const char*)g.Bt + (size_t)nxt.pn * tstep : cB;
        for (int t = 0; t < nt; t += 2) {
            const bool last = (t == nt - 2);
            const char* a1 = cA + (size_t)(t + 1) * kstep;
            const char* a2 = last ? nA : cA + (size_t)(t + 2) * kstep; const char* b2 = last ? nB : cB + (size_t)(t + 2) * kstep;
            const char* a3 = a2 + kstep; const char* b3 = b2 + kstep;
            if (last && has_next) S.a_ready(nxt);
            if constexpr (SP2) {
            PG8_LDB(B0, 0, 0); PG8_LDB(B1, 0, 1); PG8_SCHED; PG8_LDA(At, 0, 0); PG8_STAGE(PG8_SA(1, 1), a1 + hstep, voffA);
            PG8_WAIT_V(8); PG8_WAIT_L(0); PG8_BAR; PG8_MMA(0, 0, At, B0); PG8_MMA(0, 1, At, B1); PG8_BAR; PG8_SCHED;
            PG8_LDA(At, 0, 1); PG8_STAGE(PG8_SB(0, 0), b2, voffB); PG8_STAGE(PG8_SB(0, 1), b2 + hstep, voffB); PG8_STAGE(PG8_SA(0, 0), a2, voffA);
            PG8_WAIT_V(8); PG8_WAIT_L(0); PG8_BAR; PG8_MMA(1, 0, At, B0); PG8_MMA(1, 1, At, B1); PG8_BAR; PG8_SCHED;
            PG8_LDB(B0, 1, 0); PG8_LDB(B1, 1, 1); PG8_SCHED; PG8_LDA(At, 1, 0); PG8_STAGE(PG8_SA(0, 1), a2 + hstep, voffA);
            PG8_WAIT_V(8); PG8_WAIT_L(0); PG8_BAR; PG8_MMA(0, 0, At, B0); PG8_MMA(0, 1, At, B1); PG8_BAR; PG8_SCHED;
            PG8_LDA(At, 1, 1); PG8_STAGE(PG8_SB(1, 0), b3, voffB); PG8_STAGE(PG8_SB(1, 1), b3 + hstep, voffB); PG8_STAGE(PG8_SA(1, 0), a3, voffA);
            PG8_WAIT_V(8); PG8_WAIT_L(0); PG8_BAR; PG8_MMA(1, 0, At, B0); PG8_MMA(1, 1, At, B1); PG8_BAR; PG8_SCHED;
            } else {
            PG8_LDB(B0, 0, 0); PG8_SCHED; PG8_LDA(At, 0, 0); PG8_STAGE(PG8_SA(1, 1), a1 + hstep, voffA);
            PG8_WAIT_L(8); PG8_BAR; PG8_WAIT_L(0); PG8_MMA(0, 0, At, B0); PG8_BAR; PG8_SCHED;
            PG8_LDB(B1, 0, 1); PG8_STAGE(PG8_SB(0, 0), b2, voffB);
            PG8_BAR; PG8_WAIT_L(0); PG8_MMA(0, 1, At, B1); PG8_BAR;
            PG8_LDA(At, 0, 1); PG8_STAGE(PG8_SA(0, 0), a2, voffA);
            PG8_BAR; PG8_WAIT_L(0); PG8_MMA(1, 0, At, B0); PG8_BAR; PG8_SCHED;
            PG8_STAGE(PG8_SB(0, 1), b2 + hstep, voffB);
            PG8_WAIT_V(6); PG8_BAR; PG8_MMA(1, 1, At, B1); PG8_BAR;
            PG8_LDB(B0, 1, 0); PG8_SCHED; PG8_LDA(At, 1, 0); PG8_STAGE(PG8_SA(0, 1), a2 + hstep, voffA);
            PG8_WAIT_L(8); PG8_BAR; PG8_WAIT_L(0); PG8_MMA(0, 0, At, B0); PG8_BAR; PG8_SCHED;
            PG8_LDB(B1, 1, 1); PG8_STAGE(PG8_SB(1, 0), b3, voffB);
            PG8_BAR; PG8_WAIT_L(0); PG8_MMA(0, 1, At, B1); PG8_BAR;
            PG8_LDA(At, 1, 1); PG8_STAGE(PG8_SA(1, 0), a3, voffA);
            PG8_BAR; PG8_WAIT_L(0); PG8_MMA(1, 0, At, B0); PG8_BAR; PG8_SCHED;
            PG8_STAGE(PG8_SB(1, 1), b3 + hstep, voffB);
            PG8_WAIT_V(6); PG8_BAR; PG8_MMA(1, 1, At, B1); PG8_BAR;
            }
        }
        if constexpr (ALIGN_EPI) { if (wr == 0) PG8_BAR; }
        if constexpr (!Epi::AFTER_DRAIN) { E(acc, cur, wr, wc, fr, fq); S.done(cur); }
        if (!has_next) break;
#pragma unroll
        for (int a = 0; a < 2; ++a)
#pragma unroll
            for (int b = 0; b < 2; ++b)
#pragma unroll
                for (int m = 0; m < 4; ++m)
#pragma unroll
                    for (int n = 0; n < 2; ++n) acc[a][b][m][n] = (f32x4){0.f, 0.f, 0.f, 0.f};
        cur = nxt; cA = nA; cB = nB; ++ui;
        if constexpr (ALIGN_EPI) { if (wr == 1) PG8_BAR; }
    }
    PG8_WAIT_V(0);
    if constexpr (!ALIGN_EPI) { if (wr == 0) PG8_BAR; }
    PG8_BAR;
    if constexpr (Epi::AFTER_DRAIN) { E.fused(acc, cur, wr, wc, fr, fq, lds, wid, lane); S.done(cur); }
#undef PG8_SA
#undef PG8_SB
#undef PG8_STAGE
#undef PG8_LDA
#undef PG8_LDB
#undef PG8_MMA
#undef PG8_WAIT_V
#undef PG8_WAIT_L
#undef PG8_BAR
#undef PG8_SCHED
}
}
#define LAS __attribute__((address_space(3)))
typedef unsigned short bf16_t;
typedef unsigned v4u __attribute__((ext_vector_type(4)));
typedef unsigned v2u __attribute__((ext_vector_type(2)));
typedef short bf16x8_t __attribute__((ext_vector_type(8)));
typedef float f32x4 __attribute__((ext_vector_type(4)));

constexpr int TOK = 32768, DM = 1024, SEQ = 8192;
constexpr int BPROJ = 3328;
constexpr size_t MiB = 1ull << 20;
constexpr size_t WS_CTL = 0;
constexpr size_t WS_BAR = 512 * 1024;
constexpr size_t WS_DUMMY = 768 * 1024;
constexpr size_t WS_SCALE = 0;
constexpr size_t WS_WA_IN = 1 * MiB;
constexpr size_t WS_WA_OUT = 9 * MiB;
constexpr size_t WS_WB_IN = 13 * MiB;
constexpr size_t WS_WB_OUT = 20 * MiB;
constexpr size_t WS_WP = 22 * MiB;
constexpr size_t WS_H = 32 * MiB;
constexpr size_t WS_EID = 96 * MiB;
constexpr size_t WS_GATE = 112 * MiB;
constexpr size_t WS_TAB = 128 * MiB;
constexpr size_t WS_BIG = 192 * MiB;
constexpr size_t WS_GLR = WS_BIG + 305 * MiB;
constexpr size_t WS_WA_IN8 = WS_BIG + 309 * MiB;
constexpr size_t WS_WB_IN8 = WS_BIG + 313 * MiB;
constexpr size_t WS_WB_OUT8 = WS_BIG + 317 * MiB;
constexpr size_t WS_SB_OUT = 352 * 1024;
constexpr size_t WS_SA_IN = 288 * 1024;
constexpr size_t WS_SB_IN = 320 * 1024;
constexpr int LDS_BYTES = 147456;

struct Params { const float* in[21]; float* out; unsigned char* ws; };

__device__ __forceinline__ bf16_t f2bf(float f) { unsigned u = __float_as_uint(f); u += 0x7FFFu + ((u >> 16) & 1u); return (bf16_t)(u >> 16); }
typedef __bf16 bf16n2 __attribute__((ext_vector_type(2)));
__device__ __forceinline__ unsigned pk2(float lo, float hi) { typedef float f32n2 __attribute__((ext_vector_type(2))); const f32n2 v = {lo, hi}; return __builtin_bit_cast(unsigned, __builtin_convertvector(v, bf16n2)); }
__device__ __forceinline__ float bf2f(bf16_t b) { return __uint_as_float(((unsigned)b) << 16); }
__device__ __forceinline__ float gelu_exact(float x) { return 0.5f * x * (1.0f + erff(x * 0.70710678118654752f)); }
__device__ __forceinline__ float wave_sum(float v) {
#pragma unroll
  for (int o = 32; o > 0; o >>= 1) v += __shfl_xor(v, o);
  return v;
}

typedef __bf16 bf16x2_t __attribute__((ext_vector_type(2)));
__device__ __forceinline__ float dot2bf(unsigned a, unsigned b, float c) { return __builtin_amdgcn_fdot2_f32_bf16(__builtin_bit_cast(bf16x2_t, a), __builtin_bit_cast(bf16x2_t, b), c, false); }
__device__ __forceinline__ float wave_sum_dpp(float v) {
  int x;
  x = __builtin_amdgcn_mov_dpp(__float_as_int(v), 0xB1, 0xF, 0xF, true); v += __int_as_float(x);
  x = __builtin_amdgcn_mov_dpp(__float_as_int(v), 0x4E, 0xF, 0xF, true); v += __int_as_float(x);
  x = __builtin_amdgcn_mov_dpp(__float_as_int(v), 0x141, 0xF, 0xF, true); v += __int_as_float(x);
  x = __builtin_amdgcn_mov_dpp(__float_as_int(v), 0x140, 0xF, 0xF, true); v += __int_as_float(x);
  const int vi = __float_as_int(v);
  return (__int_as_float(__builtin_amdgcn_readlane(vi, 0)) + __int_as_float(__builtin_amdgcn_readlane(vi, 16))) +
         (__int_as_float(__builtin_amdgcn_readlane(vi, 32)) + __int_as_float(__builtin_amdgcn_readlane(vi, 48)));
}
__device__ __forceinline__ float gelu_as(float v) {
  const float av = fabsf(v), t = __builtin_amdgcn_rcpf(av * 0.2316418882f + 1.0f);
  float q = t * 0.5307027145f + (-0.7265760135f); q = q * t + 0.7107068705f; q = q * t + (-0.142248368f); q = q * t + 0.127414796f; q = q * t;
  const float e = __builtin_amdgcn_exp2f((v * v) * (-0.72134752044f));
  const float m = v * (q * e);
  return v < 0.f ? m : v - m;
}

__device__ __forceinline__ void fold_item(const Params& P, int it, int lane, LAS float* scr) {
  const int kk0 = (it & 63) * 16, half = (it >> 6) & 1, head = (it >> 7) & 7, layer = it >> 10;
  const float* kx = (half ? P.in[18] : P.in[17]) + (size_t)layer * 16384;
  const float* wq = P.in[16] + (size_t)layer * 1024 * 2048 + head * 256 + half * 128;
#pragma unroll
  for (int i = 0; i < 8; ++i) { const int e = i * 64 + lane, r = e >> 5, c4 = e & 31;
    const float4 v = *(const float4*)(wq + (size_t)(kk0 + r) * 2048 + c4 * 4);
    *(LAS f32x4*)(scr + r * 128 + c4 * 4) = (f32x4){v.x, v.y, v.z, v.w}; }
  asm volatile("s_waitcnt lgkmcnt(0)" ::: "memory");
  float a0[16], a1[16];
#pragma unroll
  for (int i = 0; i < 16; ++i) { a0[i] = 0.f; a1[i] = 0.f; }
#pragma unroll 2
  for (int d4 = 0; d4 < 32; ++d4) {
    const float4 x0 = *(const float4*)(kx + (size_t)lane * 128 + d4 * 4), x1 = *(const float4*)(kx + (size_t)(lane + 64) * 128 + d4 * 4);
#pragma unroll
    for (int kk = 0; kk < 16; ++kk) {
      const f32x4 b = *(const LAS f32x4*)(scr + kk * 128 + d4 * 4);
      a0[kk] += x0.x * b[0] + x0.y * b[1] + x0.z * b[2] + x0.w * b[3];
      a1[kk] += x1.x * b[0] + x1.y * b[1] + x1.z * b[2] + x1.w * b[3];
    }
  }
  asm volatile("s_waitcnt lgkmcnt(0)" ::: "memory");
  bf16_t* wt = (bf16_t*)(P.ws + WS_WP) + (size_t)layer * 2048 * 1024;
  bf16_t* r0 = wt + (size_t)(head * 256 + half * 128 + lane) * 1024 + kk0;
  bf16_t* r1 = r0 + (size_t)64 * 1024;
  v4u o;
  o.x = pk2(a0[0], a0[1]); o.y = pk2(a0[2], a0[3]); o.z = pk2(a0[4], a0[5]); o.w = pk2(a0[6], a0[7]); *(v4u*)r0 = o;
  o.x = pk2(a0[8], a0[9]); o.y = pk2(a0[10], a0[11]); o.z = pk2(a0[12], a0[13]); o.w = pk2(a0[14], a0[15]); *(v4u*)(r0 + 8) = o;
  o.x = pk2(a1[0], a1[1]); o.y = pk2(a1[2], a1[3]); o.z = pk2(a1[4], a1[5]); o.w = pk2(a1[6], a1[7]); *(v4u*)r1 = o;
  o.x = pk2(a1[8], a1[9]); o.y = pk2(a1[10], a1[11]); o.z = pk2(a1[12], a1[13]); o.w = pk2(a1[14], a1[15]); *(v4u*)(r1 + 8) = o;
}

__device__ __forceinline__ float wave_max_dpp(float v) {
  v = fmaxf(v, __int_as_float(__builtin_amdgcn_mov_dpp(__float_as_int(v), 0xB1, 0xF, 0xF, true)));
  v = fmaxf(v, __int_as_float(__builtin_amdgcn_mov_dpp(__float_as_int(v), 0x4E, 0xF, 0xF, true)));
  v = fmaxf(v, __int_as_float(__builtin_amdgcn_mov_dpp(__float_as_int(v), 0x141, 0xF, 0xF, true)));
  v = fmaxf(v, __int_as_float(__builtin_amdgcn_mov_dpp(__float_as_int(v), 0x140, 0xF, 0xF, true)));
  const int vi = __float_as_int(v);
  return fmaxf(fmaxf(__int_as_float(__builtin_amdgcn_readlane(vi, 0)), __int_as_float(__builtin_amdgcn_readlane(vi, 16))),
               fmaxf(__int_as_float(__builtin_amdgcn_readlane(vi, 32)), __int_as_float(__builtin_amdgcn_readlane(vi, 48))));
}
__device__ __forceinline__ int wave_isum_dpp(int v) {
  v += __builtin_amdgcn_mov_dpp(v, 0xB1, 0xF, 0xF, true);
  v += __builtin_amdgcn_mov_dpp(v, 0x4E, 0xF, 0xF, true);
  v += __builtin_amdgcn_mov_dpp(v, 0x141, 0xF, 0xF, true);
  v += __builtin_amdgcn_mov_dpp(v, 0x140, 0xF, 0xF, true);
  return (__builtin_amdgcn_readlane(v, 0) + __builtin_amdgcn_readlane(v, 16)) + (__builtin_amdgcn_readlane(v, 32) + __builtin_amdgcn_readlane(v, 48));
}
__device__ __forceinline__ unsigned q8(float x, float inv) { const int q = (int)rintf(x * inv); return (unsigned)(q < -127 ? -127 : (q > 127 ? 127 : q)) & 0xFFu; }
__device__ __forceinline__ void tabconv8_row(const Params& P, int r, const float4 (&v)[4], int lane) {
  const int row = r & 16383, tab = (r >> 14) & 1, layer = r >> 15;
  float am = 0.f;
#pragma unroll
  for (int i = 0; i < 4; ++i) am = fmaxf(am, fmaxf(fmaxf(fabsf(v[i].x), fabsf(v[i].y)), fmaxf(fabsf(v[i].z), fabsf(v[i].w))));
  am = wave_max_dpp(am);
  const float sc = am > 0.f ? am * (1.0f / 127.0f) : 1.0f, inv = 1.0f / sc;
  const unsigned off = 0u;
  v4u o; unsigned w[4];
#pragma unroll
  for (int i = 0; i < 4; ++i) w[i] = ((q8(v[i].x, inv) | (q8(v[i].y, inv) << 8) | (q8(v[i].z, inv) << 16) | (q8(v[i].w, inv) << 24)) ^ off);
  o.x = w[0]; o.y = w[1]; o.z = w[2]; o.w = w[3];
  *(v4u*)(P.ws + WS_TAB + (size_t)(layer * 2 + tab) * 16 * MiB + ((size_t)(lane >> 3) * 16384 + row) * 128 + (lane & 7) * 16) = o;
  if (lane == 0) ((float*)(P.ws + WS_SCALE))[(layer * 2 + tab) * 16384 + row] = sc;
}
__device__ __forceinline__ void tabconv8_load(const Params& P, int r, float4 (&v)[4], int lane) {
  const int row = r & 16383, tab = (r >> 14) & 1, layer = r >> 15;
  const float* src = P.in[19 + tab] + ((size_t)layer * 16384 + row) * 1024;
#pragma unroll
  for (int i = 0; i < 4; ++i) v[i] = tab ? *(const float4*)(src + lane * 16 + i * 4) : *(const float4*)(src + i * 256 + lane * 4);
}
__device__ __forceinline__ void phase_tabconv8(const Params& P) {
  const int lane = threadIdx.x & 63, wave = __builtin_amdgcn_readfirstlane(threadIdx.x >> 6);
  const int gw = blockIdx.x * 8 + wave, NGW = gridDim.x * 8;
  float4 a[4], b[4], c[4], d[4];
  for (int r = gw; r < 4 * 16384; r += 4 * NGW) {
    tabconv8_load(P, r, a, lane);
    if (r + NGW < 4 * 16384) tabconv8_load(P, r + NGW, b, lane);
    if (r + 2 * NGW < 4 * 16384) tabconv8_load(P, r + 2 * NGW, c, lane);
    if (r + 3 * NGW < 4 * 16384) tabconv8_load(P, r + 3 * NGW, d, lane);
    tabconv8_row(P, r, a, lane);
    if (r + NGW < 4 * 16384) tabconv8_row(P, r + NGW, b, lane);
    if (r + 2 * NGW < 4 * 16384) tabconv8_row(P, r + 2 * NGW, c, lane);
    if (r + 3 * NGW < 4 * 16384) tabconv8_row(P, r + 3 * NGW, d, lane);
  }
}

constexpr size_t WS_GSU = WS_H;
constexpr size_t WS_GSV = WS_GATE;
__device__ __forceinline__ unsigned enc_key(float s) { const unsigned b = __float_as_uint(s); return (b & 0x80000000u) ? ~b : (b | 0x80000000u); }
__device__ __forceinline__ float dec_key(unsigned u) { return __uint_as_float((u & 0x80000000u) ? (u & 0x7FFFFFFFu) : ~u); }
#define TK_CE(a, b) do { const unsigned _hi = (a) > (b) ? (a) : (b), _lo = (a) > (b) ? (b) : (a); (a) = _hi; (b) = _lo; } while (0)
__device__ __forceinline__ void sort16_desc(unsigned (&k)[16]) {
#pragma unroll
  for (int size = 2; size <= 16; size <<= 1)
#pragma unroll
    for (int stride = size >> 1; stride > 0; stride >>= 1)
#pragma unroll
      for (int i = 0; i < 16; ++i) { const int j = i ^ stride; if (j > i) { if ((i & size) == 0) TK_CE(k[i], k[j]); else TK_CE(k[j], k[i]); } }
}
__device__ __forceinline__ void merge16_desc(unsigned (&k)[16]) {
#pragma unroll
  for (int stride = 8; stride > 0; stride >>= 1)
#pragma unroll
    for (int i = 0; i < 16; ++i) { const int j = i ^ stride; if (j > i) TK_CE(k[i], k[j]); }
}
__device__ __forceinline__ void topmerge16(unsigned (&R)[16], const unsigned (&N)[16]) {
#pragma unroll
  for (int i = 0; i < 16; ++i) R[i] = R[i] > N[15 - i] ? R[i] : N[15 - i];
  merge16_desc(R);
}
__device__ __forceinline__ void topk_ld(const _Float16* wbase, int step, int lane, v4u (&g)[4]) {
#pragma unroll
  for (int i = 0; i < 4; ++i) g[i] = *(const v4u*)(wbase + (size_t)(i * 16 + (lane >> 2)) * 256 + step * 32 + (lane & 3) * 8);
}
__device__ __forceinline__ void topk_put(LAS unsigned char* tile, int lane, const v4u (&g)[4]) {
#pragma unroll
  for (int i = 0; i < 4; ++i) *(LAS v4u*)(tile + (i * 16 + (lane >> 2)) * 80 + (lane & 3) * 16) = g[i];
}
__device__ __forceinline__ void topk_group(LAS unsigned char* tile, int lane, int sub, int gcol, unsigned (&N)[16]) {
  typedef _Float16 h2 __attribute__((ext_vector_type(2)));
#pragma unroll
  for (int q = 0; q < 2; ++q) { const v4u v = *(const LAS v4u*)(tile + lane * 80 + sub * 32 + q * 16); const unsigned vv[4] = {v.x, v.y, v.z, v.w};
#pragma unroll
    for (int j = 0; j < 4; ++j) { const h2 hh = __builtin_bit_cast(h2, vv[j]);
      N[q * 8 + 2 * j + 0] = (enc_key((float)hh.x) & ~0x7Fu) | (unsigned)(127 - (gcol + q * 8 + 2 * j + 0));
      N[q * 8 + 2 * j + 1] = (enc_key((float)hh.y) & ~0x7Fu) | (unsigned)(127 - (gcol + q * 8 + 2 * j + 1)); } }
  sort16_desc(N);
}

__device__ __forceinline__ void phase_topk(const Params& P, LAS unsigned char* lds, int layer) {
  const _Float16* S = (const _Float16*)(P.ws + WS_BIG);
  int* EID = (int*)(P.ws + WS_EID); float* GSU = (float*)(P.ws + WS_GSU); float* GSV = (float*)(P.ws + WS_GSV);
  const float* scu = (const float*)(P.ws + WS_SCALE) + layer * 32768; const float* scv = scu + 16384;
  int lane = threadIdx.x & 63; const int wave = __builtin_amdgcn_readfirstlane(threadIdx.x >> 6);
  asm volatile("" : "+v"(lane));
  LAS unsigned char* my = lds + (wave * 64 + lane) * 36;
  LAS unsigned char* tile = lds + 20480 + wave * 10240;
  const int NT = gridDim.x * blockDim.x;
  for (int row = blockIdx.x * blockDim.x + wave * 64 + lane; row < TOK * 8; row += NT) {
    const _Float16* wbase = S + (size_t)(row - lane) * 256;
    unsigned R1[16], R2[16];
    v4u ld[4];
    topk_ld(wbase, 0, lane, ld);
#pragma unroll
    for (int st = 0; st < 8; ++st) {
      LAS unsigned char* tl = tile + (st & 1) * 5120;
      topk_put(tl, lane, ld);
      if (st + 1 < 8) topk_ld(wbase, st + 1, lane, ld);
#pragma unroll
      for (int sub = 0; sub < 2; ++sub) {
        const int gi = st * 2 + sub;
        unsigned N[16];
        topk_group(tl, lane, sub, (gi & 7) * 16, N);
        if (gi == 0) {
#pragma unroll
          for (int i = 0; i < 16; ++i) R1[i] = N[i];
        } else if (gi < 8) topmerge16(R1, N);
        else if (gi == 8) {
#pragma unroll
          for (int i = 0; i < 16; ++i) R2[i] = N[i];
        } else topmerge16(R2, N);
      }
    }
    float v1[16], v2[16];
#pragma unroll
    for (int i = 0; i < 16; ++i) { v1[i] = dec_key(R1[i] & ~0x7Fu); v2[i] = dec_key(R2[i] & ~0x7Fu); my[i] = (unsigned char)(127u - (R1[i] & 0x7Fu)); my[16 + i] = (unsigned char)(127u - (R2[i] & 0x7Fu)); }
    unsigned C[64];
    {
      int n = 0;
#pragma unroll
      for (int a = 0; a < 16; ++a)
#pragma unroll
        for (int b = 0; b < 16; ++b)
          if ((a + 1) * (b + 1) <= 16) { C[n] = (enc_key(v1[a] + v2[b]) & ~0xFFu) | (unsigned)(255 - (a * 16 + b)); ++n; }
#pragma unroll
      for (int i = 50; i < 64; ++i) C[i] = 0u;
    }
    unsigned R[16], N[16];
#pragma unroll
    for (int i = 0; i < 16; ++i) R[i] = C[i];
    sort16_desc(R);
#pragma unroll
    for (int g = 1; g < 4; ++g) {
#pragma unroll
      for (int i = 0; i < 16; ++i) N[i] = C[g * 16 + i];
      sort16_desc(N); topmerge16(R, N);
    }
    float ev[16]; int ei[16]; float sum = 0.f;
    const float mx = dec_key(R[0] & ~0xFFu);
#pragma unroll
    for (int i = 0; i < 16; ++i) {
      const unsigned pos = 255u - (R[i] & 0xFFu);
      ev[i] = __expf(dec_key(R[i] & ~0xFFu) - mx); sum += ev[i];
      ei[i] = (int)my[pos >> 4] * 128 + (int)my[16 + (pos & 15u)];
    }
    const float inv = 1.0f / sum;
#pragma unroll
    for (int q = 0; q < 4; ++q) {
      *(int4*)(EID + (size_t)row * 16 + q * 4) = make_int4(ei[q * 4], ei[q * 4 + 1], ei[q * 4 + 2], ei[q * 4 + 3]);
      *(float4*)(GSU + (size_t)row * 16 + q * 4) = make_float4(scu[ei[q * 4]], scu[ei[q * 4 + 1]], scu[ei[q * 4 + 2]], scu[ei[q * 4 + 3]]);
      *(float4*)(GSV + (size_t)row * 16 + q * 4) = make_float4(ev[q * 4] * inv * scv[ei[q * 4]], ev[q * 4 + 1] * inv * scv[ei[q * 4 + 1]], ev[q * 4 + 2] * inv * scv[ei[q * 4 + 2]], ev[q * 4 + 3] * inv * scv[ei[q * 4 + 3]]);
    }
  }
}

constexpr size_t WS_H8 = WS_BIG + 256 * MiB;
constexpr size_t WS_SH = WS_BIG + 288 * MiB;
constexpr size_t WS_W = WS_BIG + 289 * MiB;
constexpr size_t WS_WQ = WS_W;
constexpr size_t WS_SW = WS_W + 8 * MiB;
struct VsHdrLane { const unsigned char* base; int sh, mask; };
__device__ __forceinline__ VsHdrLane vs_hdr_lane(const Params& P, int lane) {
  VsHdrLane h;
  h.base = P.ws + (lane < 32 ? WS_EID + lane * 16 : lane < 40 ? WS_WQ + (lane - 32) * 16 : WS_SW);
  h.sh = lane < 32 ? 9 : lane < 40 ? 7 : 2; h.mask = lane < 40 ? -1 : ~3;
  return h;
}
__device__ __forceinline__ void vs_hdr_issue(const VsHdrLane& h, int tok, LAS unsigned char* slot) {
  const unsigned char* src = h.base + ((unsigned)(tok & h.mask) << h.sh);
  asm volatile("s_mov_b32 m0, %1\n\ts_nop 0\n\tglobal_load_lds_dwordx4 %0, off" :: "v"(src), "s"((unsigned)(size_t)slot) : "m0", "memory");
}
#define VS_BP(v, x) __builtin_amdgcn_ds_bpermute((lane ^ (x)) * 4, (v))
#define VS_PIN_ROWS(q) asm volatile("" : "+v"(q[0]), "+v"(q[1]), "+v"(q[2]), "+v"(q[3]))
#define VS_PIN_ACC(a) asm volatile("" : "+v"(a[0]), "+v"(a[1]), "+v"(a[2]), "+v"(a[3]), "+v"(a[4]), "+v"(a[5]), "+v"(a[6]), "+v"(a[7]), "+v"(a[8]), "+v"(a[9]), "+v"(a[10]), "+v"(a[11]), "+v"(a[12]), "+v"(a[13]), "+v"(a[14]), "+v"(a[15]))
__device__ __forceinline__ void vs_rows4(v4u (&vb)[4], const v4u& e, const unsigned char* VS, int p) {
  unsigned e0 = e.x, e1 = e.y, e2 = e.z, e3 = e.w;
  asm volatile("" : "+v"(e0), "+v"(e1), "+v"(e2), "+v"(e3));
  vb[0] = *(const v4u*)(VS + (e0 * 128u + p * 16)); vb[1] = *(const v4u*)(VS + (e1 * 128u + p * 16));
  vb[2] = *(const v4u*)(VS + (e2 * 128u + p * 16)); vb[3] = *(const v4u*)(VS + (e3 * 128u + p * 16));
}
__device__ __forceinline__ void vs_acc4(int (&acc)[16], const v4u& a, const v4u& b, const v4u& c, const v4u& d, unsigned wq) {
  const unsigned ra[4] = {a.x, a.y, a.z, a.w}, rb[4] = {b.x, b.y, b.z, b.w}, rc[4] = {c.x, c.y, c.z, c.w}, rd[4] = {d.x, d.y, d.z, d.w};
#pragma unroll
  for (int i = 0; i < 4; ++i) {
    const unsigned ablo = __builtin_amdgcn_perm(rb[i], ra[i], 0x05010400u), abhi = __builtin_amdgcn_perm(rb[i], ra[i], 0x07030602u);
    const unsigned cdlo = __builtin_amdgcn_perm(rd[i], rc[i], 0x05010400u), cdhi = __builtin_amdgcn_perm(rd[i], rc[i], 0x07030602u);
    acc[4 * i + 0] = __builtin_amdgcn_sdot4((int)__builtin_amdgcn_perm(cdlo, ablo, 0x05040100u), (int)wq, acc[4 * i + 0], false);
    acc[4 * i + 1] = __builtin_amdgcn_sdot4((int)__builtin_amdgcn_perm(cdlo, ablo, 0x07060302u), (int)wq, acc[4 * i + 1], false);
    acc[4 * i + 2] = __builtin_amdgcn_sdot4((int)__builtin_amdgcn_perm(cdhi, abhi, 0x05040100u), (int)wq, acc[4 * i + 2], false);
    acc[4 * i + 3] = __builtin_amdgcn_sdot4((int)__builtin_amdgcn_perm(cdhi, abhi, 0x07060302u), (int)wq, acc[4 * i + 3], false);
  }
}
#ifndef VS_VAR
#define VS_VAR 0
#endif
__device__ __forceinline__ void vs_xor4(int (&acc)[16], const v4u& a, const v4u& b, const v4u& c, const v4u& d) {
  acc[0] ^= (int)(a.x ^ a.y ^ a.z ^ a.w); acc[1] ^= (int)(b.x ^ b.y ^ b.z ^ b.w); acc[2] ^= (int)(c.x ^ c.y ^ c.z ^ c.w); acc[3] ^= (int)(d.x ^ d.y ^ d.z ^ d.w);
}
template <bool DRY>
__device__ __forceinline__ void vs_step(const Params& P, int tok, int pf_tok, int last, const unsigned char* VS, int x, int lane, const VsHdrLane& hl, LAS unsigned char* scur, LAS unsigned char* snxt, LAS unsigned char* snew,
                                        v4u (&q0)[4], v4u (&q1)[4], v4u (&q2)[4], v4u (&q3)[4]) {
  const int g = lane >> 3, p = lane & 7;
  const int tokc = tok < TOK ? tok : last;
  asm volatile("s_waitcnt vmcnt(17)" ::: "memory");
  const v4u wq = *(const LAS v4u*)(scur + 512 + g * 16);
  const float sw = *(const LAS float*)(scur + 640 + (tokc & 3) * 4);
  v4u e[4];
#pragma unroll
  for (int i = 0; i < 4; ++i) e[i] = *(const LAS v4u*)(snxt + g * 64 + i * 16);
  __builtin_amdgcn_sched_barrier(0);
  vs_hdr_issue(hl, pf_tok < TOK ? pf_tok : last, snew);
  __builtin_amdgcn_sched_barrier(0);
  float* op = (tok < TOK ? P.out + (size_t)tok * 1024 : (float*)(P.ws + WS_DUMMY)) + x * 128 + p * 16 + g * 2;
  const float2 xo = *(const float2*)op;
  int acc[16];
#pragma unroll
  for (int i = 0; i < 16; ++i) acc[i] = 0;
  __builtin_amdgcn_sched_barrier(0);
  VS_PIN_ROWS(q0);
  if (DRY && VS_VAR == 1) vs_xor4(acc, q0[0], q0[1], q0[2], q0[3]); else
  vs_acc4(acc, q0[0], q0[1], q0[2], q0[3], wq.x);
  VS_PIN_ACC(acc);
  __builtin_amdgcn_sched_barrier(0);
  if (!(DRY && VS_VAR == 2))
  vs_rows4(q0, e[0], VS, p);
  __builtin_amdgcn_sched_barrier(0);
  VS_PIN_ROWS(q1);
  if (DRY && VS_VAR == 1) vs_xor4(acc, q1[0], q1[1], q1[2], q1[3]); else
  vs_acc4(acc, q1[0], q1[1], q1[2], q1[3], wq.y);
  VS_PIN_ACC(acc);
  __builtin_amdgcn_sched_barrier(0);
  if (!(DRY && VS_VAR == 2))
  vs_rows4(q1, e[1], VS, p);
  __builtin_amdgcn_sched_barrier(0);
  VS_PIN_ROWS(q2);
  if (DRY && VS_VAR == 1) vs_xor4(acc, q2[0], q2[1], q2[2], q2[3]); else
  vs_acc4(acc, q2[0], q2[1], q2[2], q2[3], wq.z);
  VS_PIN_ACC(acc);
  __builtin_amdgcn_sched_barrier(0);
  if (!(DRY && VS_VAR == 2))
  vs_rows4(q2, e[2], VS, p);
  __builtin_amdgcn_sched_barrier(0);
  VS_PIN_ROWS(q3);
  if (DRY && VS_VAR == 1) vs_xor4(acc, q3[0], q3[1], q3[2], q3[3]); else
  vs_acc4(acc, q3[0], q3[1], q3[2], q3[3], wq.w);
  VS_PIN_ACC(acc);
  __builtin_amdgcn_sched_barrier(0);
  if (!(DRY && VS_VAR == 2))
  vs_rows4(q3, e[3], VS, p);
  __builtin_amdgcn_sched_barrier(0);
  const bool b5 = lane & 32, b4 = lane & 16, b3 = lane & 8;
  int r8[8], r4[4], r2[2];
#pragma unroll
  for (int i = 0; i < 8; ++i) { const int keep = b5 ? acc[8 + i] : acc[i], send = b5 ? acc[i] : acc[8 + i]; r8[i] = keep + VS_BP(send, 32); }
#pragma unroll
  for (int i = 0; i < 4; ++i) { const int keep = b4 ? r8[4 + i] : r8[i], send = b4 ? r8[i] : r8[4 + i]; r4[i] = keep + VS_BP(send, 16); }
#pragma unroll
  for (int i = 0; i < 2; ++i) { const int keep = b3 ? r4[2 + i] : r4[i], send = b3 ? r4[i] : r4[2 + i]; r2[i] = keep + VS_BP(send, 8); }
  float2 o; o.x = xo.x + (float)r2[0] * sw; o.y = xo.y + (float)r2[1] * sw;
  if (!DRY || o.x == 1234.5f) *(float2*)op = o;
}
template <bool DRY>
__device__ __forceinline__ void phase_vslice(const Params& P, LAS unsigned char* lds, int layer) {
  int lane = threadIdx.x & 63; const int wave = __builtin_amdgcn_readfirstlane(threadIdx.x >> 6);
  asm volatile("" : "+v"(lane));
  const int nsl = (gridDim.x & 7) == 0 ? 8 : 0;
  const int g = lane >> 3, p = lane & 7;
  const int wi = (nsl ? (blockIdx.x >> 3) : blockIdx.x) * 8 + wave, NW = (nsl ? (gridDim.x >> 3) : gridDim.x) * 8;
  const VsHdrLane hl = vs_hdr_lane(P, lane);
  LAS unsigned char* r0 = lds + wave * 3072; LAS unsigned char* r1 = r0 + 1024; LAS unsigned char* r2 = r0 + 2048;
  for (int xs = 0; xs < (nsl ? 1 : 8); ++xs) {
    const int x = nsl ? (blockIdx.x & 7) : xs;
    const unsigned char* VS = P.ws + WS_TAB + (size_t)(layer * 2 + 1) * 16 * MiB + (size_t)x * 2 * MiB;
    if (wi >= TOK) continue;
    v4u q0[4], q1[4], q2[4], q3[4];
    const int last = wi + ((TOK - 1 - wi) / NW) * NW;
    vs_hdr_issue(hl, wi, r0);
    vs_hdr_issue(hl, wi + NW < TOK ? wi + NW : last, r1);
    asm volatile("s_waitcnt vmcnt(0)" ::: "memory");
    {
      v4u e[4];
#pragma unroll
      for (int i = 0; i < 4; ++i) e[i] = *(const LAS v4u*)(r0 + g * 64 + i * 16);
      vs_rows4(q0, e[0], VS, p); vs_rows4(q1, e[1], VS, p); vs_rows4(q2, e[2], VS, p); vs_rows4(q3, e[3], VS, p);
    }
    for (int tok = wi; tok < TOK; tok += 3 * NW) {
      vs_step<DRY>(P, tok, tok + 2 * NW, last, VS, x, lane, hl, r0, r1, r2, q0, q1, q2, q3);
      vs_step<DRY>(P, tok + NW, tok + 3 * NW, last, VS, x, lane, hl, r1, r2, r0, q0, q1, q2, q3);
      vs_step<DRY>(P, tok + 2 * NW, tok + 4 * NW, last, VS, x, lane, hl, r2, r0, r1, q0, q1, q2, q3);
    }
    asm volatile("s_waitcnt vmcnt(0)" ::: "memory");
  }
}
__device__ __forceinline__ void phase_final_norm(const Params& P, const float* g) {
  const int lane = threadIdx.x & 63, wave = __builtin_amdgcn_readfirstlane(threadIdx.x >> 6);
  const int gw = blockIdx.x * 8 + wave, NGW = gridDim.x * 8;
  float4 gg[4];
#pragma unroll
  for (int i = 0; i < 4; ++i) gg[i] = *(const float4*)(g + i * 256 + lane * 4);
  for (int tok = gw; tok < TOK; tok += NGW) {
    float* xo = P.out + (size_t)tok * 1024;
    float4 x[4]; float ss = 0.f;
#pragma unroll
    for (int i = 0; i < 4; ++i) { x[i] = *(const float4*)(xo + i * 256 + lane * 4); ss += x[i].x * x[i].x + x[i].y * x[i].y + x[i].z * x[i].z + x[i].w * x[i].w; }
    ss = wave_sum_dpp(ss);
    const float rs = rsqrtf(ss * (1.0f / 1024.0f) + 1e-6f);
#pragma unroll
    for (int i = 0; i < 4; ++i) { float4 y; y.x = x[i].x * rs * gg[i].x; y.y = x[i].y * rs * gg[i].y; y.z = x[i].z * rs * gg[i].z; y.w = x[i].w * rs * gg[i].w; *(float4*)(xo + i * 256 + lane * 4) = y; }
  }
}

constexpr size_t WS_PART = WS_BIG + 128 * MiB;
__device__ __forceinline__ VsHdrLane us_hdr_lane(const Params& P, int lane, int x) {
  VsHdrLane h;
  h.base = P.ws + (lane < 32 ? WS_EID + lane * 16 : lane < 40 ? WS_H8 + x * 128 + (lane - 32) * 16 : WS_EID);
  h.sh = (lane >= 32 && lane < 40) ? 10 : 9; h.mask = -1;
  return h;
}
__device__ __forceinline__ void us_acc4(int& r0, int& r1, const v4u (&q)[4], const v4u& hq, int p, int it0) {
#pragma unroll
  for (int j = 0; j < 4; ++j) {
    const int it = it0 + j;
    int is = __builtin_amdgcn_sdot4((int)q[j].x, (int)hq.x, 0, false);
    is = __builtin_amdgcn_sdot4((int)q[j].y, (int)hq.y, is, false);
    is = __builtin_amdgcn_sdot4((int)q[j].z, (int)hq.z, is, false);
    is = __builtin_amdgcn_sdot4((int)q[j].w, (int)hq.w, is, false);
    is += __builtin_amdgcn_mov_dpp(is, 0xB1, 0xF, 0xF, true); is += __builtin_amdgcn_mov_dpp(is, 0x4E, 0xF, 0xF, true); is += __builtin_amdgcn_mov_dpp(is, 0x141, 0xF, 0xF, true);
    if (it < 8) r0 = (p == it) ? is : r0; else r1 = (p == it - 8) ? is : r1;
  }
}
template <bool DRY>
__device__ __forceinline__ void us_step(const Params& P, int tok, int pf_tok, int last, const unsigned char* US, int x, int lane, const VsHdrLane& hl, LAS unsigned char* scur, LAS unsigned char* snxt, LAS unsigned char* snew,
                                        v4u (&q0)[4], v4u (&q1)[4], v4u (&q2)[4], v4u (&q3)[4]) {
  const int g = lane >> 3, p = lane & 7;
  asm volatile("s_waitcnt vmcnt(16)" ::: "memory");
  const v4u hq = *(const LAS v4u*)(scur + 512 + p * 16);
  v4u e[4];
#pragma unroll
  for (int i = 0; i < 4; ++i) e[i] = *(const LAS v4u*)(snxt + g * 64 + i * 16);
  __builtin_amdgcn_sched_barrier(0);
  vs_hdr_issue(hl, pf_tok < TOK ? pf_tok : last, snew);
  __builtin_amdgcn_sched_barrier(0);
  int r0 = 0, r1 = 0;
#define US_PIN_R() asm volatile("" : "+v"(r0), "+v"(r1))
  VS_PIN_ROWS(q0); us_acc4(r0, r1, q0, hq, p, 0); US_PIN_R();
  __builtin_amdgcn_sched_barrier(0);
  vs_rows4(q0, e[0], US, p);
  __builtin_amdgcn_sched_barrier(0);
  VS_PIN_ROWS(q1); us_acc4(r0, r1, q1, hq, p, 4); US_PIN_R();
  __builtin_amdgcn_sched_barrier(0);
  vs_rows4(q1, e[1], US, p);
  __builtin_amdgcn_sched_barrier(0);
  VS_PIN_ROWS(q2); us_acc4(r0, r1, q2, hq, p, 8); US_PIN_R();
  __builtin_amdgcn_sched_barrier(0);
  vs_rows4(q2, e[2], US, p);
  __builtin_amdgcn_sched_barrier(0);
  VS_PIN_ROWS(q3); us_acc4(r0, r1, q3, hq, p, 12); US_PIN_R();
  __builtin_amdgcn_sched_barrier(0);
  vs_rows4(q3, e[3], US, p);
  __builtin_amdgcn_sched_barrier(0);
  _Float16* part = (tok < TOK ? (_Float16*)(P.ws + WS_PART) + ((size_t)x * TOK + tok) * 128 : (_Float16*)(P.ws + WS_DUMMY)) + g * 16 + p;
  if (!DRY || r0 == 0x7FFFFFFF) { part[0] = (_Float16)((float)r0 * 0.015625f); part[8] = (_Float16)((float)r1 * 0.015625f); }
}
template <bool DRY>
__device__ __forceinline__ void phase_uslice(const Params& P, LAS unsigned char* lds, int layer) {
  int lane = threadIdx.x & 63; const int wave = __builtin_amdgcn_readfirstlane(threadIdx.x >> 6);
  asm volatile("" : "+v"(lane));
  const int nsl = (gridDim.x & 7) == 0 ? 8 : 0;
  const int g = lane >> 3, p = lane & 7;
  const int wi = (nsl ? (blockIdx.x >> 3) : blockIdx.x) * 8 + wave, NW = (nsl ? (gridDim.x >> 3) : gridDim.x) * 8;
  LAS unsigned char* r0 = lds + wave * 3072; LAS unsigned char* r1 = r0 + 1024; LAS unsigned char* r2 = r0 + 2048;
  for (int xs = 0; xs < (nsl ? 1 : 8); ++xs) {
    const int x = nsl ? (blockIdx.x & 7) : xs;
    const unsigned char* US = P.ws + WS_TAB + (size_t)(layer * 2) * 16 * MiB + (size_t)x * 2 * MiB;
    if (wi >= TOK) continue;
    const VsHdrLane hl = us_hdr_lane(P, lane, x);
    v4u q0[4], q1[4], q2[4], q3[4];
    const int last = wi + ((TOK - 1 - wi) / NW) * NW;
    vs_hdr_issue(hl, wi, r0);
    vs_hdr_issue(hl, wi + NW < TOK ? wi + NW : last, r1);
    asm volatile("s_waitcnt vmcnt(0)" ::: "memory");
    {
      v4u e[4];
#pragma unroll
      for (int i = 0; i < 4; ++i) e[i] = *(const LAS v4u*)(r0 + g * 64 + i * 16);
      vs_rows4(q0, e[0], US, p); vs_rows4(q1, e[1], US, p); vs_rows4(q2, e[2], US, p); vs_rows4(q3, e[3], US, p);
    }
    for (int tok = wi; tok < TOK; tok += 3 * NW) {
      us_step<DRY>(P, tok, tok + 2 * NW, last, US, x, lane, hl, r0, r1, r2, q0, q1, q2, q3);
      us_step<DRY>(P, tok + NW, tok + 3 * NW, last, US, x, lane, hl, r1, r2, r0, q0, q1, q2, q3);
      us_step<DRY>(P, tok + 2 * NW, tok + 4 * NW, last, US, x, lane, hl, r2, r0, r1, q0, q1, q2, q3);
    }
    asm volatile("s_waitcnt vmcnt(0)" ::: "memory");
  }
}
__device__ __forceinline__ void phase_ureduce(const Params& P) {
  const _Float16* PART = (const _Float16*)(P.ws + WS_PART); const float* GSU = (const float*)(P.ws + WS_GSU); const float* GSV = (const float*)(P.ws + WS_GSV);
  const float* SH = (const float*)(P.ws + WS_SH); unsigned* WQ = (unsigned*)(P.ws + WS_WQ); float* SW = (float*)(P.ws + WS_SW);
  const int lane = threadIdx.x & 63;
  const size_t n4 = (size_t)TOK * 128 / 4, NT = (size_t)gridDim.x * blockDim.x;
  for (size_t i = (size_t)blockIdx.x * blockDim.x + threadIdx.x; i < n4; i += NT) {
    typedef _Float16 h4 __attribute__((ext_vector_type(4)));
    float s0 = 0.f, s1 = 0.f, s2 = 0.f, s3 = 0.f;
#pragma unroll
    for (int x = 0; x < 8; ++x) { const h4 t = *(const h4*)(PART + (size_t)x * TOK * 128 + i * 4); s0 += (float)t[0]; s1 += (float)t[1]; s2 += (float)t[2]; s3 += (float)t[3]; }
    s0 *= 64.f; s1 *= 64.f; s2 *= 64.f; s3 *= 64.f;
    const float4 su = *(const float4*)(GSU + i * 4), gv = *(const float4*)(GSV + i * 4);
    const float sh = SH[i >> 5];
    float4 w;
    w.x = gv.x * gelu_as(s0 * (su.x * sh)); w.y = gv.y * gelu_as(s1 * (su.y * sh));
    w.z = gv.z * gelu_as(s2 * (su.z * sh)); w.w = gv.w * gelu_as(s3 * (su.w * sh));
    float wm = fmaxf(fmaxf(fabsf(w.x), fabsf(w.y)), fmaxf(fabsf(w.z), fabsf(w.w)));
    wm = fmaxf(wm, __int_as_float(__builtin_amdgcn_mov_dpp(__float_as_int(wm), 0xB1, 0xF, 0xF, true)));
    wm = fmaxf(wm, __int_as_float(__builtin_amdgcn_mov_dpp(__float_as_int(wm), 0x4E, 0xF, 0xF, true)));
    wm = fmaxf(wm, __int_as_float(__builtin_amdgcn_mov_dpp(__float_as_int(wm), 0x141, 0xF, 0xF, true)));
    wm = fmaxf(wm, __int_as_float(__builtin_amdgcn_mov_dpp(__float_as_int(wm), 0x140, 0xF, 0xF, true)));
    wm = fmaxf(wm, __int_as_float(__builtin_amdgcn_ds_bpermute((lane ^ 16) * 4, __float_as_int(wm))));
    const float sw = wm > 0.f ? wm * (1.0f / 127.0f) : 1.0f, winv = 1.0f / sw;
    WQ[i] = q8(w.x, winv) | (q8(w.y, winv) << 8) | (q8(w.z, winv) << 16) | (q8(w.w, winv) << 24);
    if ((lane & 31) == 0) SW[i >> 5] = sw;
  }
}
constexpr int GA_PITCH = 136;
constexpr int GA_WL = 0;
constexpr int GA_VT = 34816;
constexpr int GA_ST = 34816 + 69632;
template <bool DRY>
__device__ __forceinline__ void phase_gate_a(const Params& P, LAS unsigned char* lds) {
  const int tid = threadIdx.x, lane = tid & 63, wave = __builtin_amdgcn_readfirstlane(tid >> 6);
  bf16_t* U = (bf16_t*)(P.ws + WS_BIG); const bf16_t* V = U + (size_t)TOK * 2048;
  const float* ln_g = P.in[6]; const float* ln_b = P.in[7]; const float* w_s = P.in[8]; const float* b_s = P.in[9];
  LAS bf16_t* Wl = (LAS bf16_t*)(lds + GA_WL); LAS bf16_t* vT = (LAS bf16_t*)(lds + GA_VT); LAS float* st = (LAS float*)(lds + GA_ST);
  for (int chunk = blockIdx.x; chunk < TOK / 128; chunk += gridDim.x) {
    const size_t T0 = (size_t)chunk * 128;
    for (int i = 0; i < 16; ++i) {
      const int t = wave * 16 + i;
      const bf16_t* vr = V + (T0 + t) * 2048;
      float x[32]; float s = 0.f;
#pragma unroll
      for (int j = 0; j < 4; ++j) { const v4u w = *(const v4u*)(vr + (j * 64 + lane) * 8); const unsigned ww[4] = {w.x, w.y, w.z, w.w};
#pragma unroll
        for (int q = 0; q < 4; ++q) { x[j * 8 + 2 * q] = __uint_as_float(ww[q] << 16); x[j * 8 + 2 * q + 1] = __uint_as_float(ww[q] & 0xFFFF0000u); s += x[j * 8 + 2 * q] + x[j * 8 + 2 * q + 1]; } }
      s = wave_sum_dpp(s); const float mu = s * (1.0f / 2048.0f);
      float q2 = 0.f;
#pragma unroll
      for (int j = 0; j < 32; ++j) { const float d = x[j] - mu; q2 += d * d; }
      q2 = wave_sum_dpp(q2);
      if (lane == 0) { st[2 * t] = mu; st[2 * t + 1] = rsqrtf(q2 * (1.0f / 2048.0f) + 1e-6f); }
    }
    __syncthreads();
    for (int g = 0; g < 8; ++g) {
      {
        const int t = tid >> 2, c0 = (tid & 3) * 32;
        const float* src = w_s + ((size_t)g * 128 + t) * 128 + c0;
#pragma unroll
        for (int q = 0; q < 4; ++q) {
          const float4 a = *(const float4*)(src + q * 8), b = *(const float4*)(src + q * 8 + 4);
          const int s0 = c0 + q * 8;
          v4u o;
          o.x = pk2(s0 + 0 <= t ? a.x : 0.f, s0 + 1 <= t ? a.y : 0.f); o.y = pk2(s0 + 2 <= t ? a.z : 0.f, s0 + 3 <= t ? a.w : 0.f);
          o.z = pk2(s0 + 4 <= t ? b.x : 0.f, s0 + 5 <= t ? b.y : 0.f); o.w = pk2(s0 + 6 <= t ? b.z : 0.f, s0 + 7 <= t ? b.w : 0.f);
          *(LAS v4u*)(Wl + t * GA_PITCH + s0) = o;
        }
      }
      {
        const int sh0 = (wave & 1) * 64 + (lane >> 2), cq = (wave >> 1) * 64 + (lane & 3) * 8;
#pragma unroll
        for (int jc = 0; jc < 2; ++jc) {
          const int c0 = cq + jc * 32;
          const float4 ga = *(const float4*)(ln_g + g * 256 + c0), gb = *(const float4*)(ln_g + g * 256 + c0 + 4), ba = *(const float4*)(ln_b + g * 256 + c0), bb = *(const float4*)(ln_b + g * 256 + c0 + 4);
          const float gg[8] = {ga.x, ga.y, ga.z, ga.w, gb.x, gb.y, gb.z, gb.w}, bv[8] = {ba.x, ba.y, ba.z, ba.w, bb.x, bb.y, bb.z, bb.w};
#pragma unroll
          for (int jr = 0; jr < 4; ++jr) {
            const int s = sh0 + jr * 16;
            const float mu = st[2 * s], rs = st[2 * s + 1];
            const v4u w = *(const v4u*)(V + (T0 + s) * 2048 + g * 256 + c0); const unsigned ww[4] = {w.x, w.y, w.z, w.w};
#pragma unroll
            for (int q = 0; q < 4; ++q) {
              const float y0 = (__uint_as_float(ww[q] << 16) - mu) * rs * gg[2 * q] + bv[2 * q];
              const float y1 = (__uint_as_float(ww[q] & 0xFFFF0000u) - mu) * rs * gg[2 * q + 1] + bv[2 * q + 1];
              vT[(c0 + 2 * q) * GA_PITCH + s] = f2bf(y0); vT[(c0 + 2 * q + 1) * GA_PITCH + s] = f2bf(y1);
            }
          }
        }
      }
      __syncthreads();
      f32x4 acc[2][8];
#pragma unroll
      for (int ci = 0; ci < 2; ++ci)
#pragma unroll
        for (int jt = 0; jt < 8; ++jt) acc[ci][jt] = (f32x4){0.f, 0.f, 0.f, 0.f};
      const int fr = lane & 15, fq = lane >> 4;
#pragma unroll
      for (int kb = 0; kb < 4; ++kb) {
        bf16x8_t a[2];
#pragma unroll
        for (int ci = 0; ci < 2; ++ci) a[ci] = *(const LAS bf16x8_t*)(vT + (wave * 32 + ci * 16 + fr) * GA_PITCH + kb * 32 + fq * 8);
#pragma unroll
        for (int jt = 0; jt < 8; ++jt) {
          if (kb <= (jt >> 1)) {
            const bf16x8_t b = *(const LAS bf16x8_t*)(Wl + (jt * 16 + fr) * GA_PITCH + kb * 32 + fq * 8);
#pragma unroll
            for (int ci = 0; ci < 2; ++ci) acc[ci][jt] = __builtin_amdgcn_mfma_f32_16x16x32_bf16(a[ci], b, acc[ci][jt], 0, 0, 0);
          }
        }
      }
#pragma unroll
      for (int jt = 0; jt < 8; ++jt) {
        const int t = jt * 16 + fr; const float bs = b_s[g * 128 + t];
#pragma unroll
        for (int ci = 0; ci < 2; ++ci) {
          bf16_t* up = U + (T0 + t) * 2048 + g * 256 + wave * 32 + ci * 16 + fq * 4;
          const v2u uu = *(const v2u*)up;
          v2u o;
          o.x = pk2(__uint_as_float(uu.x << 16) * (acc[ci][jt][0] + bs), __uint_as_float(uu.x & 0xFFFF0000u) * (acc[ci][jt][1] + bs));
          o.y = pk2(__uint_as_float(uu.y << 16) * (acc[ci][jt][2] + bs), __uint_as_float(uu.y & 0xFFFF0000u) * (acc[ci][jt][3] + bs));
          if (!DRY || acc[ci][jt][0] == 1234.5f) *(v2u*)up = o;
        }
      }
      __syncthreads();
    }
  }
}
constexpr size_t WS_PROJ = WS_BIG;
constexpr size_t WS_QT = WS_BIG + 208 * MiB;
constexpr size_t WS_KT = WS_BIG + 240 * MiB;
constexpr size_t WS_AM = WS_BIG + 272 * MiB;
constexpr size_t WS_DEC = WS_BIG + 288 * MiB;
constexpr size_t WS_O = WS_H;
__device__ __forceinline__ float row16_sum_dpp(float v) {
  int x;
  x = __builtin_amdgcn_mov_dpp(__float_as_int(v), 0xB1, 0xF, 0xF, true); v += __int_as_float(x);
  x = __builtin_amdgcn_mov_dpp(__float_as_int(v), 0x4E, 0xF, 0xF, true); v += __int_as_float(x);
  x = __builtin_amdgcn_mov_dpp(__float_as_int(v), 0x141, 0xF, 0xF, true); v += __int_as_float(x);
  x = __builtin_amdgcn_mov_dpp(__float_as_int(v), 0x140, 0xF, 0xF, true); v += __int_as_float(x);
  return v;
}

__device__ __forceinline__ void phase_gla_prep(const Params& P, LAS unsigned char* lds) {
  const int tid = threadIdx.x, lane = tid & 63, wave = __builtin_amdgcn_readfirstlane(tid >> 6);
  const int fr = lane & 15, fq = lane >> 4;
  const bf16_t* PROJ = (const bf16_t*)(P.ws + WS_PROJ);
  bf16_t* QT = (bf16_t*)(P.ws + WS_QT); bf16_t* KT = (bf16_t*)(P.ws + WS_KT); bf16_t* AM = (bf16_t*)(P.ws + WS_AM); float* DEC = (float*)(P.ws + WS_DEC);
  const float* w_g2 = P.in[12]; const float* b_g = P.in[13];
  LAS bf16_t* ql = (LAS bf16_t*)lds; LAS bf16_t* kl = (LAS bf16_t*)(lds + 17408); LAS float* tot = (LAS float*)(lds + 34816);
  const int kk = tid & 127, tq = wave >> 1;
  const float scale = 0.08838834764831845f;
  for (int item = blockIdx.x; item < 2048; item += gridDim.x) {
    const int h = item & 3; const size_t T0 = (size_t)(item >> 2) * 64;
    bf16_t qraw[16], kraw[16];
#pragma unroll
    for (int i = 0; i < 16; ++i) { const bf16_t* pr = PROJ + (T0 + tq * 16 + i) * BPROJ + h * 128 + kk; qraw[i] = pr[0]; kraw[i] = pr[512]; }
    float wg[16];
#pragma unroll
    for (int j = 0; j < 16; ++j) wg[j] = w_g2[j * 512 + h * 128 + kk];
    const float bg = b_g[h * 128 + kk];
    float G[16]; float run = 0.f;
#pragma unroll
    for (int i = 0; i < 16; ++i) {
      const float* gl = (const float*)(P.ws + WS_GLR) + (T0 + tq * 16 + i) * 16;
      const float4 g0 = *(const float4*)gl, g1 = *(const float4*)(gl + 4), g2 = *(const float4*)(gl + 8), g3 = *(const float4*)(gl + 12);
      const float gw[16] = {g0.x, g0.y, g0.z, g0.w, g1.x, g1.y, g1.z, g1.w, g2.x, g2.y, g2.z, g2.w, g3.x, g3.y, g3.z, g3.w};
      float a = bg;
#pragma unroll
      for (int j = 0; j < 16; ++j) a += gw[j] * wg[j];
      const float ls = fminf(a, 0.f) - log1pf(__expf(-fabsf(a)));
      run += ls * 0.0625f; G[i] = run;
    }
    tot[tq * 128 + kk] = run;
    __syncthreads();
    float off = 0.f, glast = 0.f;
#pragma unroll
    for (int q = 0; q < 4; ++q) { const float v = tot[q * 128 + kk]; off += (q < tq) ? v : 0.f; glast += v; }
    unsigned kh[8];
#pragma unroll
    for (int i = 0; i < 16; ++i) {
      const int t = tq * 16 + i; const float Gi = G[i] + off;
      const float qv = bf2f(qraw[i]) * scale * __expf(Gi);
      const float kv = bf2f(kraw[i]);
      const bf16_t qb = f2bf(qv);
      ql[t * 136 + kk] = qb; kl[t * 136 + kk] = f2bf(kv * __expf(-Gi));
      QT[((size_t)item * 64 + t) * 128 + kk] = qb;
      const unsigned khb = f2bf(kv * __expf(glast - Gi));
      if (i & 1) kh[i >> 1] |= khb << 16; else kh[i >> 1] = khb;
    }
    {
      bf16_t* kt = KT + ((size_t)item * 128 + kk) * 64 + tq * 16;
      v4u o; o.x = kh[0]; o.y = kh[1]; o.z = kh[2]; o.w = kh[3]; *(v4u*)kt = o;
      o.x = kh[4]; o.y = kh[5]; o.z = kh[6]; o.w = kh[7]; *(v4u*)(kt + 8) = o;
    }
    if (tq == 0) DEC[(size_t)item * 128 + kk] = __expf(glast);
    __syncthreads();
#pragma unroll
    for (int u = 0; u < 2; ++u) {
      const int tile = wave * 2 + u, si = tile >> 2, ti = tile & 3;
      f32x4 acc = (f32x4){0.f, 0.f, 0.f, 0.f};
      if (si <= ti) {
#pragma unroll
        for (int ks = 0; ks < 4; ++ks) {
          const bf16x8_t a = *(const LAS bf16x8_t*)(kl + (si * 16 + fr) * 136 + ks * 32 + fq * 8);
          const bf16x8_t b = *(const LAS bf16x8_t*)(ql + (ti * 16 + fr) * 136 + ks * 32 + fq * 8);
          acc = __builtin_amdgcn_mfma_f32_16x16x32_bf16(a, b, acc, 0, 0, 0);
        }
      }
      const int t = ti * 16 + fr, s0 = si * 16 + 4 * fq;
      v2u o;
      o.x = pk2(s0 + 0 <= t ? acc[0] : 0.f, s0 + 1 <= t ? acc[1] : 0.f);
      o.y = pk2(s0 + 2 <= t ? acc[2] : 0.f, s0 + 3 <= t ? acc[3] : 0.f);
      *(v2u*)(AM + ((size_t)item * 64 + t) * 64 + s0) = o;
    }
    __syncthreads();
  }
}

struct GlaFrag { bf16x8_t am[2], q[4], k[2]; f32x4 dec; v4u vr[2]; };
template <int ROLE>
__device__ __forceinline__ void gla_load(GlaFrag& F, const Params& P, int b, int h, int vs, int c, int wave, int lane) {
  const int fr = lane & 15, fq = lane >> 4;
  const size_t item = ((size_t)b * 128 + c) * 4 + h;
  const bf16_t* QT = (const bf16_t*)(P.ws + WS_QT); const bf16_t* KT = (const bf16_t*)(P.ws + WS_KT); const bf16_t* AM = (const bf16_t*)(P.ws + WS_AM); const float* DEC = (const float*)(P.ws + WS_DEC);
  if (ROLE == 0) {
    const bf16_t* ar = AM + (item * 64 + wave * 16 + fr) * 64 + fq * 8;
    F.am[0] = *(const bf16x8_t*)ar; F.am[1] = *(const bf16x8_t*)(ar + 32);
    const bf16_t* qr = QT + (item * 64 + wave * 16 + fr) * 128 + fq * 8;
#pragma unroll
    for (int kq = 0; kq < 4; ++kq) F.q[kq] = *(const bf16x8_t*)(qr + kq * 32);
  }
  const bf16_t* kr = KT + (item * 128 + wave * 16 + fr) * 64 + fq * 8;
  F.k[0] = *(const bf16x8_t*)kr; F.k[1] = *(const bf16x8_t*)(kr + 32);
  F.dec = *(const f32x4*)(DEC + item * 128 + wave * 16 + fq * 4);
  if (ROLE == 1) {
    const bf16_t* vp = (const bf16_t*)(P.ws + WS_PROJ) + ((size_t)b * SEQ + (size_t)c * 64 + lane) * BPROJ + 1024 + h * 256 + vs * 16;
    F.vr[0] = *(const v4u*)vp; F.vr[1] = *(const v4u*)(vp + 8);
  }
}
__device__ __forceinline__ void gla_write_vt(LAS bf16_t* vT, const GlaFrag& F, int lane) {
  const unsigned w[8] = {F.vr[0].x, F.vr[0].y, F.vr[0].z, F.vr[0].w, F.vr[1].x, F.vr[1].y, F.vr[1].z, F.vr[1].w};
#pragma unroll
  for (int i = 0; i < 8; ++i) { vT[(2 * i) * 72 + lane] = (bf16_t)(w[i] & 0xFFFFu); vT[(2 * i + 1) * 72 + lane] = (bf16_t)(w[i] >> 16); }
}
template <int ROLE, int MODE>
__device__ __forceinline__ void gla_step(const Params& P, const GlaFrag& cur, const GlaFrag& nxt, GlaFrag& pre, int b, int h, int vs, int c, int wave, int lane, LAS bf16_t* vT, LAS bf16_t* ST, LAS bf16_t* vTn, LAS bf16_t* STn, f32x4& S) {
  const int fr = lane & 15, fq = lane >> 4;
  bf16_t* O = (bf16_t*)(P.ws + WS_O);
  if (MODE != 2 && ROLE != 0) gla_load<ROLE>(pre, P, b, h, vs, c + 3 < 128 ? c + 3 : 127, wave, lane);
  const bf16x8_t v0 = *(const LAS bf16x8_t*)(vT + fr * 72 + fq * 8), v1 = *(const LAS bf16x8_t*)(vT + fr * 72 + 32 + fq * 8);
  if (ROLE == 0) {
    f32x4 o = (f32x4){0.f, 0.f, 0.f, 0.f};
    o = __builtin_amdgcn_mfma_f32_16x16x32_bf16(v0, cur.am[0], o, 0, 0, 0);
    o = __builtin_amdgcn_mfma_f32_16x16x32_bf16(v1, cur.am[1], o, 0, 0, 0);
#pragma unroll
    for (int kq = 0; kq < 4; ++kq) {
      const bf16x8_t s = *(const LAS bf16x8_t*)(ST + fr * 136 + kq * 32 + fq * 8);
      o = __builtin_amdgcn_mfma_f32_16x16x32_bf16(s, cur.q[kq], o, 0, 0, 0);
    }
    v2u ow; ow.x = pk2(o[0], o[1]); ow.y = pk2(o[2], o[3]);
    if (MODE == 0 || o[0] == 1234.5f) *(v2u*)(O + ((size_t)b * SEQ + (size_t)c * 64 + wave * 16 + fr) * 1024 + h * 256 + vs * 16 + fq * 4) = ow;
  }
  S = S * cur.dec;
  S = __builtin_amdgcn_mfma_f32_16x16x32_bf16(cur.k[0], v0, S, 0, 0, 0);
  S = __builtin_amdgcn_mfma_f32_16x16x32_bf16(cur.k[1], v1, S, 0, 0, 0);
  { v2u sw; sw.x = pk2(S[0], S[1]); sw.y = pk2(S[2], S[3]); *(LAS v2u*)(STn + fr * 136 + wave * 16 + fq * 4) = sw; }
  if (ROLE == 1 && c + 1 < 128) gla_write_vt(vTn, nxt, lane);
  if (MODE != 2 && ROLE == 0) gla_load<ROLE>(pre, P, b, h, vs, c + 3 < 128 ? c + 3 : 127, wave, lane);
  if (MODE != 1) __syncthreads();
}
template <int ROLE, int MODE>
__device__ __forceinline__ void gla_scan_role(const Params& P, LAS unsigned char* lds, int wave, int lane) {
  const int fr = lane & 15, fq = lane >> 4;
  LAS bf16_t* vT0 = (LAS bf16_t*)lds;
  LAS bf16_t* ST0 = (LAS bf16_t*)(lds + 2304);
  LAS bf16_t* vT1 = (LAS bf16_t*)(lds + 6656);
  LAS bf16_t* ST1 = (LAS bf16_t*)(lds + 8960);
  for (int wid = blockIdx.x; wid < 256; wid += gridDim.x) {
    const int xcd = wid & 7, jj = wid >> 3, pair = xcd * 2 + (jj >> 4), vs = jj & 15, b = pair >> 2, h = pair & 3;
    f32x4 S = (f32x4){0.f, 0.f, 0.f, 0.f};
    GlaFrag f0, f1, f2, f3;
    gla_load<ROLE>(f0, P, b, h, vs, 0, wave, lane);
    gla_load<ROLE>(f1, P, b, h, vs, 1, wave, lane);
    gla_load<ROLE>(f2, P, b, h, vs, 2, wave, lane);
    __syncthreads();
    *(LAS v2u*)(ST0 + fr * 136 + wave * 16 + fq * 4) = (v2u){0u, 0u};
    if (ROLE == 1) gla_write_vt(vT0, f0, lane);
    __syncthreads();
    for (int c = 0; c < 128; c += 4) {
      gla_step<ROLE, MODE>(P, f0, f1, f3, b, h, vs, c, wave, lane, vT0, ST0, vT1, ST1, S);
      gla_step<ROLE, MODE>(P, f1, f2, f0, b, h, vs, c + 1, wave, lane, vT1, ST1, vT0, ST0, S);
      gla_step<ROLE, MODE>(P, f2, f3, f1, b, h, vs, c + 2, wave, lane, vT0, ST0, vT1, ST1, S);
      gla_step<ROLE, MODE>(P, f3, f0, f2, b, h, vs, c + 3, wave, lane, vT1, ST1, vT0, ST0, S);
    }
  }
}
template <int MODE = 0>
__device__ __forceinline__ void phase_gla_scan(const Params& P, LAS unsigned char* lds) {
  const int lane = threadIdx.x & 63, wave = __builtin_amdgcn_readfirstlane(threadIdx.x >> 6);
  if (wave < 4) gla_scan_role<0, MODE>(P, lds, wave, lane);
  else if (wave == 4) gla_scan_role<1, MODE>(P, lds, wave, lane);
  else gla_scan_role<2, MODE>(P, lds, wave, lane);
}

struct PostIn { v4u o0, o1, r0, r1; };
__device__ __forceinline__ void gla_post_load(PostIn& x, const Params& P, int tok, int lane) {
  const bf16_t* O = (const bf16_t*)(P.ws + WS_O); const bf16_t* PROJ = (const bf16_t*)(P.ws + WS_PROJ);
  x.o0 = *(const v4u*)(O + (size_t)tok * 1024 + lane * 16); x.o1 = *(const v4u*)(O + (size_t)tok * 1024 + lane * 16 + 8);
  x.r0 = *(const v4u*)(PROJ + (size_t)tok * BPROJ + 2048 + lane * 16); x.r1 = *(const v4u*)(PROJ + (size_t)tok * BPROJ + 2048 + lane * 16 + 8);
}
__device__ __forceinline__ void gla_post_row(const PostIn& in, const Params& P, int tok, int lane, const float (&gn)[16]) {
  const unsigned ow[8] = {in.o0.x, in.o0.y, in.o0.z, in.o0.w, in.o1.x, in.o1.y, in.o1.z, in.o1.w}, rw[8] = {in.r0.x, in.r0.y, in.r0.z, in.r0.w, in.r1.x, in.r1.y, in.r1.z, in.r1.w};
  float x[16], r[16]; float ss = 0.f;
#pragma unroll
  for (int i = 0; i < 8; ++i) { x[2 * i] = __uint_as_float(ow[i] << 16); x[2 * i + 1] = __uint_as_float(ow[i] & 0xFFFF0000u); r[2 * i] = __uint_as_float(rw[i] << 16); r[2 * i + 1] = __uint_as_float(rw[i] & 0xFFFF0000u);
    ss += x[2 * i] * x[2 * i] + x[2 * i + 1] * x[2 * i + 1]; }
  ss = row16_sum_dpp(ss);
  const float rs = rsqrtf(ss * (1.0f / 256.0f) + 1e-6f);
  float y[16];
#pragma unroll
  for (int i = 0; i < 16; ++i) { const float sl = r[i] * __builtin_amdgcn_rcpf(1.0f + __expf(-r[i])); y[i] = x[i] * rs * gn[i] * sl; }
  float am = 0.f;
#pragma unroll
  for (int i = 0; i < 16; ++i) am = fmaxf(am, fabsf(y[i]));
  am = wave_max_dpp(am);
  const float sc = am > 0.f ? am * (1.0f / 127.0f) : 1.0f, inv = 1.0f / sc;
  v4u q;
  q.x = q8(y[0], inv) | (q8(y[1], inv) << 8) | (q8(y[2], inv) << 16) | (q8(y[3], inv) << 24);
  q.y = q8(y[4], inv) | (q8(y[5], inv) << 8) | (q8(y[6], inv) << 16) | (q8(y[7], inv) << 24);
  q.z = q8(y[8], inv) | (q8(y[9], inv) << 8) | (q8(y[10], inv) << 16) | (q8(y[11], inv) << 24);
  q.w = q8(y[12], inv) | (q8(y[13], inv) << 8) | (q8(y[14], inv) << 16) | (q8(y[15], inv) << 24);
  *(v4u*)(P.ws + WS_H8 + (size_t)tok * 1024 + lane * 16) = q;
  if (lane == 0) ((float*)(P.ws + WS_SH))[tok] = sc;
}
__device__ __forceinline__ void phase_gla_post(const Params& P) {
  const int lane = threadIdx.x & 63, wave = __builtin_amdgcn_readfirstlane(threadIdx.x >> 6);
  const int gw = blockIdx.x * 8 + wave, NGW = gridDim.x * 8;
  const float* ng = P.in[14] + (lane & 15) * 16;
  float gn[16];
#pragma unroll
  for (int q = 0; q < 4; ++q) { const float4 g4 = *(const float4*)(ng + q * 4); gn[q * 4] = g4.x; gn[q * 4 + 1] = g4.y; gn[q * 4 + 2] = g4.z; gn[q * 4 + 3] = g4.w; }
  PostIn a, b, c, d;
  for (int tok = gw; tok < TOK; tok += 4 * NGW) {
    const bool vb = tok + NGW < TOK, vc = tok + 2 * NGW < TOK, vd = tok + 3 * NGW < TOK;
    gla_post_load(a, P, tok, lane);
    if (vb) gla_post_load(b, P, tok + NGW, lane);
    if (vc) gla_post_load(c, P, tok + 2 * NGW, lane);
    if (vd) gla_post_load(d, P, tok + 3 * NGW, lane);
    gla_post_row(a, P, tok, lane, gn);
    if (vb) gla_post_row(b, P, tok + NGW, lane, gn);
    if (vc) gla_post_row(c, P, tok + 2 * NGW, lane, gn);
    if (vd) gla_post_row(d, P, tok + 3 * NGW, lane, gn);
  }
}
__device__ __forceinline__ void transpose_item(const float* W, int K, int N, bf16_t* WT, LAS float* scr, int item, int nblk, int lane) {
  const int kb = item / nblk, nb = item % nblk, k0 = 64 * kb, n0 = 32 * nb;
  const int nn = n0 + (lane & 31);
#pragma unroll 8
  for (int i = 0; i < 32; ++i) { const int kk = 2 * i + (lane >> 5); scr[kk * 33 + (lane & 31)] = (nn < N) ? W[(size_t)(k0 + kk) * N + nn] : 0.f; }
  asm volatile("s_waitcnt lgkmcnt(0)" ::: "memory");
  const int c = lane & 7;
#pragma unroll
  for (int j = 0; j < 4; ++j) { const int n = (lane >> 3) + 8 * j; const LAS float* s = scr + (8 * c) * 33 + n;
    v4u o; o.x = pk2(s[0 * 33], s[1 * 33]); o.y = pk2(s[2 * 33], s[3 * 33]); o.z = pk2(s[4 * 33], s[5 * 33]); o.w = pk2(s[6 * 33], s[7 * 33]);
    *(v4u*)(WT + (size_t)(n0 + n) * K + k0 + 8 * c) = o; }
  asm volatile("s_waitcnt lgkmcnt(0)" ::: "memory");
}

__device__ __forceinline__ void phase_prep(const Params& P, LAS unsigned char* lds) {
  const int lane = threadIdx.x & 63, wave = __builtin_amdgcn_readfirstlane(threadIdx.x >> 6);
  LAS float* scr = (LAS float*)(lds + wave * 16384);
  const int gw = blockIdx.x * 8 + wave, NGW = gridDim.x * 8;
  unsigned char* ws = P.ws;
  constexpr int I_AIN = (1024 / 64) * (4096 / 32), I_AOUT = (2048 / 64) * (1024 / 32), I_BIN = (1024 / 64) * (BPROJ / 32), I_BOUT = (1024 / 64) * (1024 / 32), I_FOLD = 2048;
  constexpr int NITEMS = I_AIN + I_AOUT + I_BIN + I_BOUT + I_FOLD;
  for (int it = gw; it < NITEMS; it += NGW) {
    int r = it;
    if (r < I_AIN) { transpose_item(P.in[4], 1024, 4096, (bf16_t*)(ws + WS_WA_IN), scr, r, 4096 / 32, lane); continue; } r -= I_AIN;
    if (r < I_AOUT) { transpose_item(P.in[10], 2048, 1024, (bf16_t*)(ws + WS_WA_OUT), scr, r, 1024 / 32, lane); continue; } r -= I_AOUT;
    if (r < I_BIN) { transpose_item(P.in[11], 1024, 3088, (bf16_t*)(ws + WS_WB_IN), scr, r, BPROJ / 32, lane); continue; } r -= I_BIN;
    if (r < I_BOUT) { transpose_item(P.in[15], 1024, 1024, (bf16_t*)(ws + WS_WB_OUT), scr, r, 1024 / 32, lane); continue; } r -= I_BOUT;
    fold_item(P, r, lane, scr);
  }
}

template <int MODE>
__device__ __forceinline__ void phase_gemm(const Params& P, LAS unsigned char* lds, int layer) {
  unsigned char* ws = P.ws;
  const bf16_t* H = (const bf16_t*)(ws + WS_H);
  if constexpr (MODE == 0) {
    pg8::Gemm g{(const bf16_t*)(ws + WS_H8), (const bf16_t*)(ws + WS_WA_IN8), TOK, 4096, 512}; pg8::StaticOrder S; S.init(TOK, 4096, gridDim.x, blockIdx.x);
    pg8::EpiBf16I8<1> E{(bf16_t*)(ws + WS_BIG), 2048, P.in[5], 2048, (size_t)TOK * 2048, (const float*)(ws + WS_SH), (const float*)(ws + WS_SA_IN)};
    pg8::gemm_phase<pg8::EpiBf16I8<1>, pg8::StaticOrder, true, true, true>(lds, g, S, E);
  } else if constexpr (MODE == 1) {
    pg8::Gemm g{(const bf16_t*)(ws + WS_BIG), (const bf16_t*)(ws + WS_WA_OUT), TOK, 1024, 2048}; pg8::StaticOrder S; S.init(TOK, 1024, gridDim.x, blockIdx.x);
    pg8::EpiResF32 E{P.out, P.in[0], 1024};
    pg8::gemm_phase<pg8::EpiResF32, pg8::StaticOrder, true, true>(lds, g, S, E);
  } else if constexpr (MODE == 2) {
    pg8::Gemm g{H, (const bf16_t*)(ws + WS_WP) + (size_t)layer * 2048 * 1024, TOK, 2048, 1024}; pg8::StaticOrder S; S.init(TOK, 2048, gridDim.x, blockIdx.x);
    pg8::EpiF16 E{(_Float16*)(ws + WS_BIG), 2048};
    pg8::gemm_phase<pg8::EpiF16, pg8::StaticOrder, true, true>(lds, g, S, E);
  } else if constexpr (MODE == 3) {
    pg8::Gemm g{(const bf16_t*)(ws + WS_H8), (const bf16_t*)(ws + WS_WB_IN8), TOK, 3072, 512}; pg8::StaticOrder S; S.init(TOK, 3072, gridDim.x, blockIdx.x);
    pg8::EpiBf16I8<0> E{(bf16_t*)(ws + WS_BIG), BPROJ, nullptr, 0, 0, (const float*)(ws + WS_SH), (const float*)(ws + WS_SB_IN)};
    pg8::gemm_phase<pg8::EpiBf16I8<0>, pg8::StaticOrder, true, true, true>(lds, g, S, E);
  } else {
    pg8::Gemm g{(const bf16_t*)(ws + WS_H8), (const bf16_t*)(ws + WS_WB_OUT8), TOK, 1024, 512}; pg8::StaticOrder S; S.init(TOK, 1024, gridDim.x, blockIdx.x);
    pg8::EpiResF32I8 E{P.out, P.out, (const float*)(ws + WS_SH), (const float*)(ws + WS_SB_OUT), 1024};
    pg8::gemm_phase<pg8::EpiResF32I8, pg8::StaticOrder, true, true, true>(lds, g, S, E);
  }
}

#define RLX_AGENT __ATOMIC_RELAXED, __HIP_MEMORY_SCOPE_AGENT
#define XB_TMO      128
#define XB_XCNT(j)  (256  + 64 * (j))
#define XB_XSUB(j)  (1280 + 64 * (j))
#define XB_XGEN(j)  (2304 + 64 * (j))
#define XB_TOP      3328
#define XB_TOPGEN   3392
#define XCD_BAR_WORDS 3456
#define XB_SPIN_CAP (1u << 18)

__device__ __forceinline__ unsigned xb_ld(unsigned* p)              { return __hip_atomic_load(p, __ATOMIC_RELAXED, __HIP_MEMORY_SCOPE_AGENT); }
__device__ __forceinline__ unsigned xb_add(unsigned* p, unsigned v) { return __hip_atomic_fetch_add(p, v, __ATOMIC_RELAXED, __HIP_MEMORY_SCOPE_AGENT); }
__device__ __forceinline__ unsigned xb_xcc_id() { return (unsigned)__builtin_amdgcn_s_getreg((3 << 11) | 20) & 0xFu; }
#define XB_SPIN(cond, bar) do { unsigned _sp = 0; while (cond) { __builtin_amdgcn_s_sleep(1); \
    if ((++_sp & 255u) == 0u) { if (xb_ld(&(bar)[XB_TMO])) break; if (_sp > XB_SPIN_CAP) { atomicAdd(&(bar)[XB_TMO], 1u); break; } } } } while (0)

struct XcdBarrier {
    unsigned* bar; unsigned x;
    volatile LAS unsigned* st;
};

__device__ __forceinline__ XcdBarrier xcd_barrier_post(unsigned* bar, volatile LAS unsigned* st) {
    XcdBarrier b; b.bar = bar; b.x = xb_xcc_id(); b.st = st;
    if (threadIdx.x == 0) (void)xb_add(&bar[XB_XCNT(b.x)], 1u);
    return b;
}
__device__ __forceinline__ void xcd_barrier_complete(unsigned* bar, unsigned x, unsigned& nloc, unsigned& nx) {
    const unsigned G = gridDim.x * gridDim.y * gridDim.z;
    unsigned sum, cnt, mine, sp = 0u;
    for (;;) {
        sum = 0u; cnt = 0u; mine = 0u;
#pragma unroll
        for (unsigned j = 0; j < 16; ++j) { const unsigned c = xb_ld(&bar[XB_XCNT(j)]); sum += c; cnt += (c > 0u) ? 1u : 0u; mine = (j == x) ? c : mine; }
        if (sum == G) break;
        __builtin_amdgcn_s_sleep(1);
        if ((++sp & 255u) == 0u) { if (xb_ld(&bar[XB_TMO])) break; if (sp > XB_SPIN_CAP) { atomicAdd(&bar[XB_TMO], 1u); break; } }
    }
    nloc = mine > 0u ? mine : 1u; nx = cnt > 0u ? cnt : 1u;
}

__device__ __forceinline__ void xcd_barrier(const XcdBarrier& b) {
    asm volatile("s_waitcnt vmcnt(0)" ::: "memory");
    __syncthreads();
    if (threadIdx.x == 0) {
        unsigned* bar = b.bar;
        __builtin_amdgcn_s_waitcnt(0);
        unsigned nloc = b.st[0], nx = b.st[1];
        if (nloc == 0u) { xcd_barrier_complete(bar, b.x, nloc, nx); b.st[0] = nloc; b.st[1] = nx; }
        const unsigned old = xb_add(&bar[XB_XSUB(b.x)], 1u);
        const unsigned gen = old / nloc;
        if (old + 1u == (gen + 1u) * nloc) {
            __builtin_amdgcn_fence(__ATOMIC_RELEASE, "agent");
            asm volatile("s_waitcnt vmcnt(0)" ::: "memory");
            const unsigned og = xb_add(&bar[XB_TOP], 1u);
            const unsigned tg = og / nx;
            if (og + 1u == (tg + 1u) * nx) xb_add(&bar[XB_TOPGEN], 1u);
            else XB_SPIN(xb_ld(&bar[XB_TOPGEN]) == tg, bar);
            __builtin_amdgcn_fence(__ATOMIC_ACQUIRE, "agent");
            xb_add(&bar[XB_XGEN(b.x)], 1u);
            asm volatile("s_waitcnt vmcnt(0)" ::: "memory");
        } else {
            XB_SPIN(xb_ld(&bar[XB_XGEN(b.x)]) == gen, bar);
            __builtin_amdgcn_fence(__ATOMIC_ACQUIRE, "agent");
            asm volatile("s_waitcnt vmcnt(0)" ::: "memory");
        }
    }
    __syncthreads();
}


__device__ __forceinline__ void phase_glr(const Params& P) {
  typedef int i32x4_t __attribute__((ext_vector_type(4)));
  const int lane = threadIdx.x & 63, wave = __builtin_amdgcn_readfirstlane(threadIdx.x >> 6), fr = lane & 15, fq = lane >> 4;
  const unsigned char* H8 = P.ws + WS_H8; const unsigned char* WT = P.ws + WS_WB_IN8 + (size_t)3072 * 1024;
  const float* SH = (const float*)(P.ws + WS_SH); const float* SB = (const float*)(P.ws + WS_SB_IN) + 3072;
  float* GLR = (float*)(P.ws + WS_GLR);
  for (int job = blockIdx.x * 8 + wave; job < TOK / 16; job += gridDim.x * 8) {
    const unsigned char* ar = H8 + ((size_t)job * 16 + fr) * 1024 + fq * 16; const unsigned char* br = WT + (size_t)fr * 1024 + fq * 16;
    i32x4_t acc = (i32x4_t){0, 0, 0, 0};
#pragma unroll 8
    for (int ks = 0; ks < 16; ++ks) acc = __builtin_amdgcn_mfma_i32_16x16x64_i8(*(const i32x4_t*)(ar + ks * 64), *(const i32x4_t*)(br + ks * 64), acc, 0, 0, 0);
    const float sb = SB[fr];
#pragma unroll
    for (int r = 0; r < 4; ++r) { const size_t tk = (size_t)job * 16 + 4 * fq + r; GLR[tk * 16 + fr] = (float)acc[r] * (SH[tk] * sb); }
  }
}

template <bool EMIT8, bool WRITE_H = true>
__device__ __forceinline__ void rmsnorm_row(const Params& P, int tok, float4 (&x)[4], const float4 (&gg)[4], int lane) {
  bf16_t* H = (bf16_t*)(P.ws + WS_H);
  float ss = 0.f;
#pragma unroll
  for (int i = 0; i < 4; ++i) ss += x[i].x * x[i].x + x[i].y * x[i].y + x[i].z * x[i].z + x[i].w * x[i].w;
  ss = wave_sum_dpp(ss);
  const float rs = rsqrtf(ss * (1.0f / 1024.0f) + 1e-6f);
  float am = 0.f; unsigned hb[8];
#pragma unroll
  for (int i = 0; i < 4; ++i) {
    x[i].x *= rs * gg[i].x; x[i].y *= rs * gg[i].y; x[i].z *= rs * gg[i].z; x[i].w *= rs * gg[i].w;
    hb[2 * i] = pk2(x[i].x, x[i].y); hb[2 * i + 1] = pk2(x[i].z, x[i].w);
    if (WRITE_H) { v2u o; o.x = hb[2 * i]; o.y = hb[2 * i + 1]; *(v2u*)(H + (size_t)tok * 1024 + i * 256 + lane * 4) = o; }
  }
  if (EMIT8) {
    float hv[16];
#pragma unroll
    for (int i = 0; i < 8; ++i) { hv[2 * i] = __uint_as_float(hb[i] << 16); hv[2 * i + 1] = __uint_as_float(hb[i] & 0xFFFF0000u); am = fmaxf(am, fmaxf(fabsf(hv[2 * i]), fabsf(hv[2 * i + 1]))); }
    am = wave_max_dpp(am);
    const float sh = am > 0.f ? am * (1.0f / 127.0f) : 1.0f, hinv = 1.0f / sh;
    v4u q;
    q.x = q8(hv[0], hinv) | (q8(hv[1], hinv) << 8) | (q8(hv[2], hinv) << 16) | (q8(hv[3], hinv) << 24);
    q.y = q8(hv[4], hinv) | (q8(hv[5], hinv) << 8) | (q8(hv[6], hinv) << 16) | (q8(hv[7], hinv) << 24);
    q.z = q8(hv[8], hinv) | (q8(hv[9], hinv) << 8) | (q8(hv[10], hinv) << 16) | (q8(hv[11], hinv) << 24);
    q.w = q8(hv[12], hinv) | (q8(hv[13], hinv) << 8) | (q8(hv[14], hinv) << 16) | (q8(hv[15], hinv) << 24);
    *(v4u*)(P.ws + WS_H8 + (size_t)tok * 1024 + lane * 16) = q;
    if (lane == 0) ((float*)(P.ws + WS_SH))[tok] = sh;
  }
}
template <bool EMIT8, bool WRITE_H = true>
__device__ __forceinline__ void phase_rmsnorm(const Params& P, const float* src, const float* g) {
  const int lane = threadIdx.x & 63, wave = __builtin_amdgcn_readfirstlane(threadIdx.x >> 6);
  const int gw = blockIdx.x * 8 + wave, NGW = gridDim.x * 8;
  float4 gg[4];
#pragma unroll
  for (int i = 0; i < 4; ++i) gg[i] = *(const float4*)(g + i * 256 + lane * 4);
  float4 xa[4], xb[4], xc[4], xd[4];
  for (int tok = gw; tok < TOK; tok += 4 * NGW) {
    const bool vb = tok + NGW < TOK, vc = tok + 2 * NGW < TOK, vd = tok + 3 * NGW < TOK;
#pragma unroll
    for (int i = 0; i < 4; ++i) xa[i] = *(const float4*)(src + (size_t)tok * 1024 + i * 256 + lane * 4);
    if (vb) {
#pragma unroll
      for (int i = 0; i < 4; ++i) xb[i] = *(const float4*)(src + (size_t)(tok + NGW) * 1024 + i * 256 + lane * 4); }
    if (vc) {
#pragma unroll
      for (int i = 0; i < 4; ++i) xc[i] = *(const float4*)(src + (size_t)(tok + 2 * NGW) * 1024 + i * 256 + lane * 4); }
    if (vd) {
#pragma unroll
      for (int i = 0; i < 4; ++i) xd[i] = *(const float4*)(src + (size_t)(tok + 3 * NGW) * 1024 + i * 256 + lane * 4); }
    rmsnorm_row<EMIT8, WRITE_H>(P, tok, xa, gg, lane);
    if (vb) rmsnorm_row<EMIT8, WRITE_H>(P, tok + NGW, xb, gg, lane);
    if (vc) rmsnorm_row<EMIT8, WRITE_H>(P, tok + 2 * NGW, xc, gg, lane);
    if (vd) rmsnorm_row<EMIT8, WRITE_H>(P, tok + 3 * NGW, xd, gg, lane);
  }
}

__device__ __forceinline__ void w8_rows(const Params& P, const bf16_t* src0, unsigned char* dst0, float* sc0, int rows, int lane, int gw, int NGW) {
  for (int r = gw; r < rows; r += NGW) {
    const bf16_t* src = src0 + (size_t)r * 1024;
    float hv[16]; float am = 0.f;
#pragma unroll
    for (int i = 0; i < 4; ++i) { const v2u w = *(const v2u*)(src + i * 256 + lane * 4);
      hv[4 * i] = __uint_as_float(w.x << 16); hv[4 * i + 1] = __uint_as_float(w.x & 0xFFFF0000u); hv[4 * i + 2] = __uint_as_float(w.y << 16); hv[4 * i + 3] = __uint_as_float(w.y & 0xFFFF0000u);
      am = fmaxf(am, fmaxf(fmaxf(fabsf(hv[4 * i]), fabsf(hv[4 * i + 1])), fmaxf(fabsf(hv[4 * i + 2]), fabsf(hv[4 * i + 3])))); }
    am = wave_max_dpp(am);
    const float sc = am > 0.f ? am * (1.0f / 127.0f) : 1.0f, inv = 1.0f / sc;
    v4u q;
    q.x = q8(hv[0], inv) | (q8(hv[1], inv) << 8) | (q8(hv[2], inv) << 16) | (q8(hv[3], inv) << 24);
    q.y = q8(hv[4], inv) | (q8(hv[5], inv) << 8) | (q8(hv[6], inv) << 16) | (q8(hv[7], inv) << 24);
    q.z = q8(hv[8], inv) | (q8(hv[9], inv) << 8) | (q8(hv[10], inv) << 16) | (q8(hv[11], inv) << 24);
    q.w = q8(hv[12], inv) | (q8(hv[13], inv) << 8) | (q8(hv[14], inv) << 16) | (q8(hv[15], inv) << 24);
    *(v4u*)(dst0 + (size_t)r * 1024 + lane * 16) = q;
    if (lane == 0) sc0[r] = sc;
  }
}
__device__ __forceinline__ void phase_w8(const Params& P) {
  const int lane = threadIdx.x & 63, wave = __builtin_amdgcn_readfirstlane(threadIdx.x >> 6);
  const int gw = blockIdx.x * 8 + wave, NGW = gridDim.x * 8;
  w8_rows(P, (const bf16_t*)(P.ws + WS_WA_IN), P.ws + WS_WA_IN8, (float*)(P.ws + WS_SA_IN), 4096, lane, gw, NGW);
  w8_rows(P, (const bf16_t*)(P.ws + WS_WB_IN), P.ws + WS_WB_IN8, (float*)(P.ws + WS_SB_IN), BPROJ, lane, gw, NGW);
  for (int r = gw; r < 1024; r += NGW) {
    const bf16_t* src = (const bf16_t*)(P.ws + WS_WB_OUT) + (size_t)r * 1024 + lane * 16;
    const v4u w0 = *(const v4u*)src, w1 = *(const v4u*)(src + 8); const unsigned ww[8] = {w0.x, w0.y, w0.z, w0.w, w1.x, w1.y, w1.z, w1.w};
    float hv[16]; float am = 0.f;
#pragma unroll
    for (int i = 0; i < 8; ++i) { hv[2 * i] = __uint_as_float(ww[i] << 16); hv[2 * i + 1] = __uint_as_float(ww[i] & 0xFFFF0000u); am = fmaxf(am, fmaxf(fabsf(hv[2 * i]), fabsf(hv[2 * i + 1]))); }
    am = wave_max_dpp(am);
    const float sc = am > 0.f ? am * (1.0f / 127.0f) : 1.0f, inv = 1.0f / sc;
    v4u q;
    q.x = q8(hv[0], inv) | (q8(hv[1], inv) << 8) | (q8(hv[2], inv) << 16) | (q8(hv[3], inv) << 24);
    q.y = q8(hv[4], inv) | (q8(hv[5], inv) << 8) | (q8(hv[6], inv) << 16) | (q8(hv[7], inv) << 24);
    q.z = q8(hv[8], inv) | (q8(hv[9], inv) << 8) | (q8(hv[10], inv) << 16) | (q8(hv[11], inv) << 24);
    q.w = q8(hv[12], inv) | (q8(hv[13], inv) << 8) | (q8(hv[14], inv) << 16) | (q8(hv[15], inv) << 24);
    *(v4u*)(P.ws + WS_WB_OUT8 + (size_t)r * 1024 + lane * 16) = q;
    if (lane == 0) ((float*)(P.ws + WS_SB_OUT))[r] = sc;
  }
}

#ifndef PROBE
#define PROBE 0
#endif
__global__ void __launch_bounds__(512, 2) mega_fwd(Params P) {
  extern __shared__ __attribute__((aligned(16))) unsigned char lds_raw[];
  LAS unsigned char* lds = (LAS unsigned char*)lds_raw;
  cg::grid_group grid = cg::this_grid();
  volatile LAS unsigned* bst = (volatile LAS unsigned*)(lds + 131072 + 64);
  if (threadIdx.x == 0) { bst[0] = 0u; bst[1] = 0u; }
  __syncthreads();
  const XcdBarrier bar = xcd_barrier_post((unsigned*)(P.ws + WS_BAR), bst);
#define SEAM() do { xcd_barrier(bar); } while (0)
#if PROBE & 32
  phase_prep(P, lds); phase_tabconv8(P); phase_rmsnorm<true, false>(P, P.in[0], P.in[1]);
#endif
  phase_prep(P, lds); phase_tabconv8(P); phase_rmsnorm<true, false>(P, P.in[0], P.in[1]);
  grid.sync();
#if PROBE & 8
  phase_gemm<0>(P, lds, 0);
#endif
  phase_w8(P);
  SEAM();
  phase_gemm<0>(P, lds, 0);
  SEAM();
#if PROBE & 262144
  SEAM(); SEAM(); SEAM(); SEAM(); SEAM(); SEAM(); SEAM(); SEAM(); SEAM(); SEAM();
#endif
#if PROBE & 4
  phase_gate_a<true>(P, lds);
#endif
  phase_gate_a<false>(P, lds);
  SEAM();
#if PROBE & 8
  phase_gemm<1>(P, lds, 0);
#endif
  phase_gemm<1>(P, lds, 0);
  SEAM();
#if PROBE & 65536
  phase_rmsnorm<true>(P, P.out, P.in[2]);
#endif
  phase_rmsnorm<true>(P, P.out, P.in[2]);
  SEAM();
#if PROBE & 8
  phase_gemm<2>(P, lds, 0);
#endif
  phase_gemm<2>(P, lds, 0);
  SEAM();
#if PROBE & 16
  phase_topk(P, lds, 0);
#endif
  phase_topk(P, lds, 0);
  SEAM();
  phase_uslice<false>(P, lds, 0);
  SEAM();
  phase_ureduce(P);
  SEAM();
#if PROBE & 1
  phase_vslice<true>(P, lds, 0); SEAM();
#endif
#if PROBE & 256
  phase_uslice<true>(P, lds, 0); SEAM();
#endif
  phase_vslice<false>(P, lds, 0);
  SEAM();
  phase_rmsnorm<true, false>(P, P.out, P.in[1] + 1024);
  SEAM();
#if PROBE & 8
  phase_gemm<3>(P, lds, 0);
#endif
  phase_gemm<3>(P, lds, 0); phase_glr(P);
  SEAM();
#if PROBE & 4098
  phase_gla_prep(P, lds);
#endif
  phase_gla_prep(P, lds);
  SEAM();
#if PROBE & 8194
  phase_gla_scan<3>(P, lds); __syncthreads();
#endif
#if PROBE & 16384
  phase_gla_scan<1>(P, lds); __syncthreads();
#endif
#if PROBE & 32768
  phase_gla_scan<2>(P, lds); __syncthreads();
#endif
  phase_gla_scan(P, lds);
  SEAM();
#if PROBE & 64
  phase_gla_post(P);
#endif
  phase_gla_post(P);
  SEAM();
  phase_gemm<4>(P, lds, 0);
  SEAM();
#if PROBE & 65536
  phase_rmsnorm<true>(P, P.out, P.in[2] + 1024);
#endif
  phase_rmsnorm<true>(P, P.out, P.in[2] + 1024);
  SEAM();
#if PROBE & 131072
  phase_gemm<2>(P, lds, 1);
#endif
  phase_gemm<2>(P, lds, 1);
  SEAM();
#if PROBE & 16
  phase_topk(P, lds, 1);
#endif
  phase_topk(P, lds, 1);
  SEAM();
  phase_uslice<false>(P, lds, 1);
  SEAM();
  phase_ureduce(P);
  SEAM();
#if PROBE & 1
  phase_vslice<true>(P, lds, 1); SEAM();
#endif
  phase_vslice<false>(P, lds, 1);
  SEAM();
  phase_final_norm(P, P.in[3]);
#undef SEAM
}

extern "C" void kernel_launch(void* const* d_in, const int* in_sizes, int n_in, void* d_out, int out_size, void* d_ws, size_t ws_size, hipStream_t stream) {
  static int grid = 0;
  if (grid == 0) {
    int dev = 0, cus = 0, per_cu = 0;
    if (hipGetDevice(&dev) != hipSuccess || hipDeviceGetAttribute(&cus, hipDeviceAttributeMultiprocessorCount, dev) != hipSuccess) { fprintf(stderr, "kernel_launch: device query failed\n"); grid = -1; return; }
    if (hipFuncSetAttribute((const void*)mega_fwd, hipFuncAttributeMaxDynamicSharedMemorySize, LDS_BYTES) != hipSuccess) { fprintf(stderr, "kernel_launch: hipFuncSetAttribute failed\n"); grid = -1; return; }
    if (hipOccupancyMaxActiveBlocksPerMultiprocessor(&per_cu, (const void*)mega_fwd, 512, LDS_BYTES) != hipSuccess || per_cu < 1) { fprintf(stderr, "kernel_launch: occupancy query gave %d\n", per_cu); grid = -1; return; }
    grid = cus * per_cu;
    if (grid > 256) grid = 256;
    fprintf(stderr, "kernel_launch: cus %d per_cu %d grid %d ws %zu\n", cus, per_cu, grid, ws_size);
  }
  if (grid < 0) return;
  (void)hipMemsetAsync((char*)d_ws + WS_BAR, 0, XCD_BAR_WORDS * 4, stream);
  Params P{};
  for (int i = 0; i < 21; ++i) P.in[i] = (const float*)d_in[i];
  P.out = (float*)d_out; P.ws = (unsigned char*)d_ws;
  void* args[] = {&P};
  hipError_t e = hipLaunchCooperativeKernel((const void*)mega_fwd, dim3(grid), dim3(512), args, LDS_BYTES, stream);
  if (e != hipSuccess) fprintf(stderr, "kernel_launch: cooperative launch failed: %s (grid %d)\n", hipGetErrorString(e), grid);
}
```

```cpp
#include <hip/hip_runtime.h>
#include <cstdio>
#include <cstdint>
#include <hip/hip_cooperative_groups.h>
namespace cg = cooperative_groups;
#define PROBE 0
#define VS_VAR 0
namespace pg8 {
#define PG8_LAS __attribute__((address_space(3)))
typedef unsigned short bf16_t;
typedef short bf16x8 __attribute__((ext_vector_type(8)));
typedef float f32x4 __attribute__((ext_vector_type(4)));
typedef unsigned u32x4 __attribute__((ext_vector_type(4)));
constexpr int BM = 256, BK = 64, HALF = 128, HTB = HALF * BK * 2  , STAGE_BYTES = 8 * HTB, NXCD = 8, WGM = 8;

__host__ __device__ __forceinline__ int lds_byte(int r, int c) { const int st = (r >> 4) * 2 + (c >> 5), rr = r & 15, cc = c & 31, ob = rr * 64 + cc * 2; return st * 1024 + (ob ^ (((ob >> 9) & 1) << 5)); }
__host__ __device__ __forceinline__ void stage_rc(int b, int& R, int& C) { const int st = b / 1024, sb = b % 1024, swz = sb ^ (((sb >> 9) & 1) << 5); R = (st >> 1) * 16 + swz / 64; C = (st & 1) * 32 + (swz % 64) / 2; }
__host__ __device__ __forceinline__ int perm32(int rho) { const int n = rho >> 4, i = rho & 15; return 8 * (i >> 2) + 4 * n + (i & 3); }

struct Unit { int pm, pn; };
struct Gemm { const bf16_t* A; const bf16_t* Bt; int M, N, K; };

struct StaticOrder {
    int nM, nN, nwg, G, c;
    __host__ __device__ void init(int M, int N, int G_, int c_) { nM = M / BM; nN = N / BM; nwg = nM * nN; G = G_; c = c_; }
    __host__ __device__ bool next(int i, Unit& u) const {
        const long L = (long)i * G + c; if (L >= nwg) return false;
        int wgid = (int)L; { const int q = nwg / NXCD, r = nwg % NXCD, xcd = wgid % NXCD, off = wgid / NXCD; wgid = (xcd < r ? xcd * (q + 1) : r * (q + 1) + (xcd - r) * q) + off; }
        const int nig = WGM * nN, gid = wgid / nig, fm = gid * WGM, gsz = (nM - fm) < WGM ? (nM - fm) : WGM;
        u.pm = fm + ((wgid % nig) % gsz); u.pn = (wgid % nig) / gsz; return true;
    }
    __device__ __forceinline__ void a_ready(const Unit&) const {}
    __device__ __forceinline__ void done(const Unit&) const {}
};

__device__ __forceinline__ unsigned cvt_pk_bf16(float lo, float hi) { unsigned r; asm volatile("v_cvt_pk_bf16_f32 %0, %1, %2" : "=v"(r) : "v"(lo), "v"(hi)); return r; }
typedef float f32x2 __attribute__((ext_vector_type(2)));
__device__ __forceinline__ f32x2 gelu_pk(f32x2 v) {
    const f32x2 av = __builtin_elementwise_abs(v), d = av * 0.2316418882f + 1.0f;
    f32x2 t; t.x = __builtin_amdgcn_rcpf(d.x); t.y = __builtin_amdgcn_rcpf(d.y);
    f32x2 q = t * 0.5307027145f + (-0.7265760135f); q = q * t + 0.7107068705f; q = q * t + (-0.142248368f); q = q * t + 0.127414796f; q = q * t;
    const f32x2 s = (v * v) * (-0.72134752044f);
    f32x2 e; e.x = __builtin_amdgcn_exp2f(s.x); e.y = __builtin_amdgcn_exp2f(s.y);
    const f32x2 m = v * (q * e), r = v - m;
    f32x2 o; o.x = v.x < 0.f ? m.x : r.x; o.y = v.y < 0.f ? m.y : r.y; return o;
}

template <int ACT  > struct EpiBf16 {
    static constexpr bool PERM = true, AFTER_DRAIN = false; static_assert(ACT == 0 || ACT == 1, "EpiBf16: ACT is 0 (none) or 1 (gelu_pk)");
    bf16_t* O; int ldc; const float* bias; int split_cols; size_t split_stride; float scale0;
    __device__ __forceinline__ void operator()(const f32x4 (&acc)[2][2][4][2], const Unit& u, int wr, int wc, int fr, int fq) const {
        const int row0 = u.pm * BM + wr * 64 + fr; int colt = u.pn * BM; bf16_t* base = O;
        float sc = 1.f; if (split_cols) { const int t = colt / split_cols; base += (size_t)t * split_stride; colt -= t * split_cols; if (t == 0) sc = scale0; }
        const int col0 = colt + wc * 32 + 8 * fq, bcol0 = u.pn * BM + wc * 32 + 8 * fq;
        f32x4 bv[2][2];
#pragma unroll
        for (int bj = 0; bj < 2; ++bj)
#pragma unroll
            for (int n = 0; n < 2; ++n) bv[bj][n] = bias ? *(const f32x4*)(bias + bcol0 + bj * HALF + 4 * n) : (f32x4){0.f, 0.f, 0.f, 0.f};
#pragma unroll
        for (int ai = 0; ai < 2; ++ai)
#pragma unroll
            for (int m = 0; m < 4; ++m) { bf16_t* rowp = base + (size_t)(row0 + ai * HALF + m * 16) * ldc + col0;
#pragma unroll
                for (int bj = 0; bj < 2; ++bj) { f32x4 v0 = acc[ai][bj][m][0] + bv[bj][0], v1 = acc[ai][bj][m][1] + bv[bj][1];
                    if (ACT == 1) { f32x2 a = gelu_pk((f32x2){v0[0], v0[1]}), b = gelu_pk((f32x2){v0[2], v0[3]}), c = gelu_pk((f32x2){v1[0], v1[1]}), d = gelu_pk((f32x2){v1[2], v1[3]});
                        v0 = (f32x4){a.x, a.y, b.x, b.y}; v1 = (f32x4){c.x, c.y, d.x, d.y}; }
                    v0 = v0 * sc; v1 = v1 * sc; u32x4 w; w.x = cvt_pk_bf16(v0[0], v0[1]); w.y = cvt_pk_bf16(v0[2], v0[3]); w.z = cvt_pk_bf16(v1[0], v1[1]); w.w = cvt_pk_bf16(v1[2], v1[3]);
                    *(u32x4*)(rowp + bj * HALF) = w; } }
    }
};

struct EpiResF32 {
    static constexpr bool PERM = false, AFTER_DRAIN = false;
    float* C; const float* R; int ldc;
    __device__ __forceinline__ void operator()(const f32x4 (&acc)[2][2][4][2], const Unit& u, int wr, int wc, int fr, int fq) const {
        const int row0 = u.pm * BM + wr * 64 + fr, col0 = u.pn * BM + wc * 32 + 4 * fq;
#pragma unroll
        for (int ai = 0; ai < 2; ++ai)
#pragma unroll
            for (int m = 0; m < 4; ++m) { const size_t off = (size_t)(row0 + ai * HALF + m * 16) * ldc + col0;
#pragma unroll
                for (int bj = 0; bj < 2; ++bj)
#pragma unroll
                    for (int n = 0; n < 2; ++n) { f32x4 v = acc[ai][bj][m][n]; if (R) v = v + *(const f32x4*)(R + off + bj * HALF + n * 16); *(f32x4*)(C + off + bj * HALF + n * 16) = v; } }
    }
};
typedef int i32x4 __attribute__((ext_vector_type(4)));
template <bool INT8> __device__ __forceinline__ f32x4 pg8_mma(bf16x8 a, bf16x8 b, f32x4 c) {
    if constexpr (INT8) return __builtin_bit_cast(f32x4, __builtin_amdgcn_mfma_i32_16x16x64_i8(__builtin_bit_cast(i32x4, a), __builtin_bit_cast(i32x4, b), __builtin_bit_cast(i32x4, c), 0, 0, 0));
    else return __builtin_amdgcn_mfma_f32_16x16x32_bf16(a, b, c, 0, 0, 0);
}
template <int ACT> struct EpiBf16I8 {
    static constexpr bool PERM = true, AFTER_DRAIN = false;
    bf16_t* O; int ldc; const float* bias; int split_cols; size_t split_stride; const float* sa; const float* sb;
    __device__ __forceinline__ void operator()(const f32x4 (&acc)[2][2][4][2], const Unit& u, int wr, int wc, int fr, int fq) const {
        const int row0 = u.pm * BM + wr * 64 + fr; int colt = u.pn * BM; bf16_t* base = O;
        if (split_cols) { const int t = colt / split_cols; base += (size_t)t * split_stride; colt -= t * split_cols; }
        const int col0 = colt + wc * 32 + 8 * fq, bcol0 = u.pn * BM + wc * 32 + 8 * fq;
        f32x4 bv[2][2], cs[2][2];
#pragma unroll
        for (int bj = 0; bj < 2; ++bj)
#pragma unroll
            for (int n = 0; n < 2; ++n) { bv[bj][n] = bias ? *(const f32x4*)(bias + bcol0 + bj * HALF + 4 * n) : (f32x4){0.f, 0.f, 0.f, 0.f}; cs[bj][n] = *(const f32x4*)(sb + bcol0 + bj * HALF + 4 * n); }
#pragma unroll
        for (int ai = 0; ai < 2; ++ai)
#pragma unroll
            for (int m = 0; m < 4; ++m) { const int row = row0 + ai * HALF + m * 16; const float ra = sa[row]; bf16_t* rowp = base + (size_t)row * ldc + col0;
#pragma unroll
                for (int bj = 0; bj < 2; ++bj) { const i32x4 i0 = __builtin_bit_cast(i32x4, acc[ai][bj][m][0]), i1 = __builtin_bit_cast(i32x4, acc[ai][bj][m][1]);
                    f32x4 v0, v1;
#pragma unroll
                    for (int j = 0; j < 4; ++j) { v0[j] = (float)i0[j] * (ra * cs[bj][0][j]) + bv[bj][0][j]; v1[j] = (float)i1[j] * (ra * cs[bj][1][j]) + bv[bj][1][j]; }
                    if (ACT == 1) { f32x2 a = gelu_pk((f32x2){v0[0], v0[1]}), b = gelu_pk((f32x2){v0[2], v0[3]}), c = gelu_pk((f32x2){v1[0], v1[1]}), d = gelu_pk((f32x2){v1[2], v1[3]});
                        v0 = (f32x4){a.x, a.y, b.x, b.y}; v1 = (f32x4){c.x, c.y, d.x, d.y}; }
                    u32x4 w; w.x = cvt_pk_bf16(v0[0], v0[1]); w.y = cvt_pk_bf16(v0[2], v0[3]); w.z = cvt_pk_bf16(v1[0], v1[1]); w.w = cvt_pk_bf16(v1[2], v1[3]);
                    *(u32x4*)(rowp + bj * HALF) = w; } }
    }
};
struct EpiResF32I8 {
    static constexpr bool PERM = false, AFTER_DRAIN = false;
    float* C; const float* R; const float* sa; const float* sb; int ldc;
    __device__ __forceinline__ void operator()(const f32x4 (&acc)[2][2][4][2], const Unit& u, int wr, int wc, int fr, int fq) const {
        const int row0 = u.pm * BM + wr * 64 + fr, col0 = u.pn * BM + wc * 32 + 4 * fq;
        f32x4 cs[2][2];
#pragma unroll
        for (int bj = 0; bj < 2; ++bj)
#pragma unroll
            for (int n = 0; n < 2; ++n) cs[bj][n] = *(const f32x4*)(sb + col0 + bj * HALF + n * 16);
#pragma unroll
        for (int ai = 0; ai < 2; ++ai)
#pragma unroll
            for (int m = 0; m < 4; ++m) { const int row = row0 + ai * HALF + m * 16; const float ra = sa[row]; const size_t off = (size_t)row * ldc + col0;
#pragma unroll
                for (int bj = 0; bj < 2; ++bj)
#pragma unroll
                    for (int n = 0; n < 2; ++n) { const i32x4 iv = __builtin_bit_cast(i32x4, acc[ai][bj][m][n]); f32x4 v = *(const f32x4*)(R + off + bj * HALF + n * 16);
#pragma unroll
                        for (int j = 0; j < 4; ++j) v[j] += (float)iv[j] * (ra * cs[bj][n][j]);
                        *(f32x4*)(C + off + bj * HALF + n * 16) = v; } }
    }
};
struct EpiResBf16 {
    static constexpr bool PERM = true, AFTER_DRAIN = false;
    bf16_t* O; const float* R; int ldc;
    __device__ __forceinline__ void operator()(const f32x4 (&acc)[2][2][4][2], const Unit& u, int wr, int wc, int fr, int fq) const {
        const int row0 = u.pm * BM + wr * 64 + fr, col0 = u.pn * BM + wc * 32 + 8 * fq;
#pragma unroll
        for (int ai = 0; ai < 2; ++ai)
#pragma unroll
            for (int m = 0; m < 4; ++m) { const size_t off = (size_t)(row0 + ai * HALF + m * 16) * ldc + col0;
#pragma unroll
                for (int bj = 0; bj < 2; ++bj) { const f32x4 v0 = acc[ai][bj][m][0] + *(const f32x4*)(R + off + bj * HALF), v1 = acc[ai][bj][m][1] + *(const f32x4*)(R + off + bj * HALF + 4);
                    u32x4 w; w.x = cvt_pk_bf16(v0[0], v0[1]); w.y = cvt_pk_bf16(v0[2], v0[3]); w.z = cvt_pk_bf16(v1[0], v1[1]); w.w = cvt_pk_bf16(v1[2], v1[3]);
                    *(u32x4*)(O + off + bj * HALF) = w; } }
    }
};
struct EpiResBf16I8 {
    static constexpr bool PERM = true, AFTER_DRAIN = false;
    bf16_t* O; const float* sa; const float* sb; int ldc;
    __device__ __forceinline__ void operator()(const f32x4 (&acc)[2][2][4][2], const Unit& u, int wr, int wc, int fr, int fq) const {
        const int row0 = u.pm * BM + wr * 64 + fr, col0 = u.pn * BM + wc * 32 + 8 * fq;
        f32x4 cs[2][2];
#pragma unroll
        for (int bj = 0; bj < 2; ++bj)
#pragma unroll
            for (int n = 0; n < 2; ++n) cs[bj][n] = *(const f32x4*)(sb + col0 + bj * HALF + 4 * n);
#pragma unroll
        for (int ai = 0; ai < 2; ++ai)
#pragma unroll
            for (int m = 0; m < 4; ++m) { const int row = row0 + ai * HALF + m * 16; const float ra = sa[row]; const size_t off = (size_t)row * ldc + col0;
#pragma unroll
                for (int bj = 0; bj < 2; ++bj) { const i32x4 i0 = __builtin_bit_cast(i32x4, acc[ai][bj][m][0]), i1 = __builtin_bit_cast(i32x4, acc[ai][bj][m][1]);
                    const u32x4 r = *(const u32x4*)(O + off + bj * HALF);
                    const float r0[4] = {__uint_as_float(r.x << 16), __uint_as_float(r.x & 0xFFFF0000u), __uint_as_float(r.y << 16), __uint_as_float(r.y & 0xFFFF0000u)};
                    const float r1[4] = {__uint_as_float(r.z << 16), __uint_as_float(r.z & 0xFFFF0000u), __uint_as_float(r.w << 16), __uint_as_float(r.w & 0xFFFF0000u)};
                    f32x4 v0, v1;
#pragma unroll
                    for (int j = 0; j < 4; ++j) { v0[j] = r0[j] + (float)i0[j] * (ra * cs[bj][0][j]); v1[j] = r1[j] + (float)i1[j] * (ra * cs[bj][1][j]); }
                    u32x4 w; w.x = cvt_pk_bf16(v0[0], v0[1]); w.y = cvt_pk_bf16(v0[2], v0[3]); w.z = cvt_pk_bf16(v1[0], v1[1]); w.w = cvt_pk_bf16(v1[2], v1[3]);
                    *(u32x4*)(O + off + bj * HALF) = w; } }
    }
};
struct EpiF16 {
    static constexpr bool PERM = true, AFTER_DRAIN = false;
    _Float16* O; int ldc;
    __device__ __forceinline__ void operator()(const f32x4 (&acc)[2][2][4][2], const Unit& u, int wr, int wc, int fr, int fq) const {
        typedef _Float16 h2 __attribute__((ext_vector_type(2)));
        const int row0 = u.pm * BM + wr * 64 + fr, col0 = u.pn * BM + wc * 32 + 8 * fq;
#pragma unroll
        for (int ai = 0; ai < 2; ++ai)
#pragma unroll
            for (int m = 0; m < 4; ++m) { _Float16* rowp = O + (size_t)(row0 + ai * HALF + m * 16) * ldc + col0;
#pragma unroll
                for (int bj = 0; bj < 2; ++bj) { const f32x4 v0 = acc[ai][bj][m][0], v1 = acc[ai][bj][m][1];
                    u32x4 w;
                    w.x = __builtin_bit_cast(unsigned, (h2){(_Float16)v0[0], (_Float16)v0[1]}); w.y = __builtin_bit_cast(unsigned, (h2){(_Float16)v0[2], (_Float16)v0[3]});
                    w.z = __builtin_bit_cast(unsigned, (h2){(_Float16)v1[0], (_Float16)v1[1]}); w.w = __builtin_bit_cast(unsigned, (h2){(_Float16)v1[2], (_Float16)v1[3]});
                    *(u32x4*)(rowp + bj * HALF) = w; } }
    }
};
template <class Epi, class Sched, bool ALIGN_EPI = false, bool SP2 = false, bool INT8 = false>
__device__ __forceinline__ void gemm_phase(PG8_LAS unsigned char* lds, const Gemm g, const Sched& S, const Epi& E) {
    int tid = threadIdx.x; asm volatile("" : "+v"(tid));
    const int wid = __builtin_amdgcn_readfirstlane(tid >> 6), lane = tid & 63, wr = wid >> 2, wc = wid & 3, fr = lane & 15, fq = lane >> 4;
    const int K = g.K, nt = K / BK;
    unsigned voffA[2], voffB[2];
#pragma unroll
    for (int i = 0; i < 2; ++i) { int R, C; stage_rc(tid * 16 + i * 8192, R, C); const int Rb = Epi::PERM ? ((R & ~31) + perm32(R & 31)) : R;
        voffA[i] = (unsigned)(R * K + C) * 2u; voffB[i] = (unsigned)(Rb * K + C) * 2u; }
    const size_t kstep = (size_t)(BK * 2);
    const size_t hstep = (size_t)HALF * K * 2;
    const size_t tstep = 2 * hstep;
    const unsigned ldsw = (unsigned)wid * 1024u;
    const int aoff = lds_byte(wr * 64 + fr, fq * 8), boff = lds_byte(wc * 32 + fr, fq * 8);
#define PG8_SA(b, h) (((b) * 2 + (h)) * HTB)
#define PG8_SB(b, h) ((4 + (b) * 2 + (h)) * HTB)
#define PG8_STAGE(bufoff, gbase, voff) do { _Pragma("unroll") for (int _i = 0; _i < 2; ++_i) \
        __builtin_amdgcn_global_load_lds((const unsigned*)((const char*)(gbase) + (voff)[_i]), (PG8_LAS unsigned*)(lds + (bufoff) + ldsw + _i * 8192), 16, 0, 0); } while (0)
#define PG8_LDA(dst, b, h) do { _Pragma("unroll") for (int m = 0; m < 4; ++m) _Pragma("unroll") for (int k = 0; k < 2; ++k) dst[m][k] = *(const PG8_LAS bf16x8*)(lds + PG8_SA(b, h) + aoff + m * 2048 + k * 1024); } while (0)
#define PG8_LDB(dst, b, h) do { _Pragma("unroll") for (int n = 0; n < 2; ++n) _Pragma("unroll") for (int k = 0; k < 2; ++k) dst[n][k] = *(const PG8_LAS bf16x8*)(lds + PG8_SB(b, h) + boff + n * 2048 + k * 1024); } while (0)
#define PG8_MMA(ai, bj, At, Bt) do { __builtin_amdgcn_s_setprio(1); _Pragma("unroll") for (int m = 0; m < 4; ++m) _Pragma("unroll") for (int n = 0; n < 2; ++n) _Pragma("unroll") for (int k = 0; k < 2; ++k) \
        acc[ai][bj][m][n] = pg8_mma<INT8>(Bt[n][k], At[m][k], acc[ai][bj][m][n]); __builtin_amdgcn_s_setprio(0); } while (0)
#define PG8_WAIT_V(n) asm volatile("s_waitcnt vmcnt(" #n ")" ::: "memory")
#define PG8_WAIT_L(n) asm volatile("s_waitcnt lgkmcnt(" #n ")" ::: "memory")
#define PG8_BAR __builtin_amdgcn_s_barrier()
#define PG8_SCHED __builtin_amdgcn_sched_barrier(0)
    Unit cur, nxt; int ui = 0;
    if (!S.next(0, cur)) return;
    f32x4 acc[2][2][4][2];
#pragma unroll
    for (int a = 0; a < 2; ++a)
#pragma unroll
        for (int b = 0; b < 2; ++b)
#pragma unroll
            for (int m = 0; m < 4; ++m)
#pragma unroll
                for (int n = 0; n < 2; ++n) acc[a][b][m][n] = (f32x4){0.f, 0.f, 0.f, 0.f};
    bf16x8 At[4][2], B0[2][2], B1[2][2];
    const char* cA = (const char*)g.A + (size_t)cur.pm * tstep; const char* cB = (const char*)g.Bt + (size_t)cur.pn * tstep;
    S.a_ready(cur);
    if constexpr (SP2) {
        PG8_STAGE(PG8_SB(0, 0), cB, voffB); PG8_STAGE(PG8_SB(0, 1), cB + hstep, voffB); PG8_STAGE(PG8_SA(0, 0), cA, voffA); PG8_STAGE(PG8_SA(0, 1), cA + hstep, voffA);
        if (wr == 1) PG8_BAR;
        PG8_WAIT_V(2); PG8_BAR;
        PG8_STAGE(PG8_SB(1, 0), cB + kstep, voffB); PG8_STAGE(PG8_SA(1, 0), cA + kstep, voffA); PG8_STAGE(PG8_SB(1, 1), cB + hstep + kstep, voffB);
        PG8_WAIT_V(6); PG8_BAR;
    } else {
        PG8_STAGE(PG8_SB(0, 0), cB, voffB); PG8_STAGE(PG8_SA(0, 0), cA, voffA); PG8_STAGE(PG8_SB(0, 1), cB + hstep, voffB); PG8_STAGE(PG8_SA(0, 1), cA + hstep, voffA);
        if (wr == 1) PG8_BAR;
        PG8_WAIT_V(4); PG8_BAR;
        PG8_STAGE(PG8_SB(1, 0), cB + kstep, voffB); PG8_STAGE(PG8_SA(1, 0), cA + kstep, voffA); PG8_STAGE(PG8_SB(1, 1), cB + hstep + kstep, voffB);
        PG8_WAIT_V(6); PG8_BAR;
    }
    for (;;) {
        const bool has_next = S.next(ui + 1, nxt);
        const char* nA = has_next ? (const char*)g.A + (size_t)nxt.pm * tstep : cA; const char* nB = has_next ? (const char*)g.Bt + (size_t)nxt.pn * tstep : cB;
        for (int t = 0; t < nt; t += 2) {
            const bool last = (t == nt - 2);
            const char* a1 = cA + (size_t)(t + 1) * kstep;
            const char* a2 = last ? nA : cA + (size_t)(t + 2) * kstep; const char* b2 = last ? nB : cB + (size_t)(t + 2) * kstep;
            const char* a3 = a2 + kstep; const char* b3 = b2 + kstep;
            if (last && has_next) S.a_ready(nxt);
            if constexpr (SP2) {
            PG8_LDB(B0, 0, 0); PG8_LDB(B1, 0, 1); PG8_SCHED; PG8_LDA(At, 0, 0); PG8_STAGE(PG8_SA(1, 1), a1 + hstep, voffA);
            PG8_WAIT_V(8); PG8_WAIT_L(0); PG8_BAR; PG8_MMA(0, 0, At, B0); PG8_MMA(0, 1, At, B1); PG8_BAR; PG8_SCHED;
            PG8_LDA(At, 0, 1); PG8_STAGE(PG8_SB(0, 0), b2, voffB); PG8_STAGE(PG8_SB(0, 1), b2 + hstep, voffB); PG8_STAGE(PG8_SA(0, 0), a2, voffA);
            PG8_WAIT_V(8); PG8_WAIT_L(0); PG8_BAR; PG8_MMA(1, 0, At, B0); PG8_MMA(1, 1, At, B1); PG8_BAR; PG8_SCHED;
            PG8_LDB(B0, 1, 0); PG8_LDB(B1, 1, 1); PG8_SCHED; PG8_LDA(At, 1, 0); PG8_STAGE(PG8_SA(0, 1), a2 + hstep, voffA);
            PG8_WAIT_V(8); PG8_WAIT_L(0); PG8_BAR; PG8_MMA(0, 0, At, B0); PG8_MMA(0, 1, At, B1); PG8_BAR; PG8_SCHED;
            PG8_LDA(At, 1, 1); PG8_STAGE(PG8_SB(1, 0), b3, voffB); PG8_STAGE(PG8_SB(1, 1), b3 + hstep, voffB); PG8_STAGE(PG8_SA(1, 0), a3, voffA);
            PG8_WAIT_V(8); PG8_WAIT_L(0); PG8_BAR; PG8_MMA(1, 0, At, B0); PG8_MMA(1, 1, At, B1); PG8_BAR; PG8_SCHED;
            } else {
            PG8_LDB(B0, 0, 0); PG8_SCHED; PG8_LDA(At, 0, 0); PG8_STAGE(PG8_SA(1, 1), a1 + hstep, voffA);
            PG8_WAIT_L(8); PG8_BAR; PG8_WAIT_L(0); PG8_MMA(0, 0, At, B0); PG8_BAR; PG8_SCHED;
            PG8_LDB(B1, 0, 1); PG8_STAGE(PG8_SB(0, 0), b2, voffB);
            PG8_BAR; PG8_WAIT_L(0); PG8_MMA(0, 1, At, B1); PG8_BAR;
            PG8_LDA(At, 0, 1); PG8_STAGE(PG8_SA(0, 0), a2, voffA);
            PG8_BAR; PG8_WAIT_L(0); PG8_MMA(1, 0, At, B0); PG8_BAR; PG8_SCHED;
            PG8_STAGE(PG8_SB(0, 1), b2 + hstep, voffB);
            PG8_WAIT_V(6); PG8_BAR; PG8_MMA(1, 1, At, B1); PG8_BAR;
            PG8_LDB(B0, 1, 0); PG8_SCHED; PG8_LDA(At, 1, 0); PG8_STAGE(PG8_SA(0, 1), a2 + hstep, voffA);
            PG8_WAIT_L(8); PG8_BAR; PG8_WAIT_L(0); PG8_MMA(0, 0, At, B0); PG8_BAR; PG8_SCHED;
            PG8_LDB(B1, 1, 1); PG8_STAGE(PG8_SB(1, 0), b3, voffB);
            PG8_BAR; PG8_WAIT_L(0); PG8_MMA(0, 1, At, B1); PG8_BAR;
            PG8_LDA(At, 1, 1); PG8_STAGE(PG8_SA(1, 0), a3, voffA);
            PG8_BAR; PG8_WAIT_L(0); PG8_MMA(1, 0, At, B0); PG8_BAR; PG8_SCHED;
            PG8_STAGE(PG8_SB(1, 1), b3 + hstep, voffB);
            PG8_WAIT_V(6); PG8_BAR; PG8_MMA(1, 1, At, B1); PG8_BAR;
            }
        }
        if constexpr (ALIGN_EPI) { if (wr == 0) PG8_BAR; }
        if constexpr (!Epi::AFTER_DRAIN) { E(acc, cur, wr, wc, fr, fq); S.done(cur); }
        if (!has_next) break;
#pragma unroll
        for (int a = 0; a < 2; ++a)
#pragma unroll
            for (int b = 0; b < 2; ++b)
#pragma unroll
                for (int m = 0; m < 4; ++m)
#pragma unroll
                    for (int n = 0; n < 2; ++n) acc[a][b][m][n] = (f32x4){0.f, 0.f, 0.f, 0.f};
        cur = nxt; cA = nA; cB = nB; ++ui;
        if constexpr (ALIGN_EPI) { if (wr == 1) PG8_BAR; }
    }
    PG8_WAIT_V(0);
    if constexpr (!ALIGN_EPI) { if (wr == 0) PG8_BAR; }
    PG8_BAR;
    if constexpr (Epi::AFTER_DRAIN) { E.fused(acc, cur, wr, wc, fr, fq, lds, wid, lane); S.done(cur); }
#undef PG8_SA
#undef PG8_SB
#undef PG8_STAGE
#undef PG8_LDA
#undef PG8_LDB
#undef PG8_MMA
#undef PG8_WAIT_V
#undef PG8_WAIT_L
#undef PG8_BAR
#undef PG8_SCHED
}
}
#define LAS __attribute__((address_space(3)))
typedef unsigned short bf16_t;
typedef unsigned v4u __attribute__((ext_vector_type(4)));
typedef unsigned v2u __attribute__((ext_vector_type(2)));
typedef short bf16x8_t __attribute__((ext_vector_type(8)));
typedef float f32x4 __attribute__((ext_vector_type(4)));

constexpr int TOK = 32768, DM = 1024, SEQ = 8192;
constexpr int BPROJ = 3328;
constexpr size_t MiB = 1ull << 20;
constexpr size_t WS_CTL = 0;
constexpr size_t WS_BAR = 512 * 1024;
constexpr size_t WS_DUMMY = 768 * 1024;
constexpr size_t WS_SCALE = 0;
constexpr size_t WS_WA_IN = 1 * MiB;
constexpr size_t WS_WA_OUT = 9 * MiB;
constexpr size_t WS_WB_IN = 13 * MiB;
constexpr size_t WS_WB_OUT = 20 * MiB;
constexpr size_t WS_WP = 22 * MiB;
constexpr size_t WS_H = 32 * MiB;
constexpr size_t WS_EID = 96 * MiB;
constexpr size_t WS_GATE = 112 * MiB;
constexpr size_t WS_TAB = 128 * MiB;
constexpr size_t WS_BIG = 192 * MiB;
constexpr size_t WS_GLR = WS_BIG + 305 * MiB;
constexpr size_t WS_WA_IN8 = WS_BIG + 309 * MiB;
constexpr size_t WS_WB_IN8 = WS_BIG + 313 * MiB;
constexpr size_t WS_WB_OUT8 = WS_BIG + 317 * MiB;
constexpr size_t WS_SB_OUT = 352 * 1024;
constexpr size_t WS_SA_IN = 288 * 1024;
constexpr size_t WS_SB_IN = 320 * 1024;
constexpr int LDS_BYTES = 147456;

struct Params { const float* in[21]; float* out; unsigned char* ws; };

__device__ __forceinline__ bf16_t f2bf(float f) { unsigned u = __float_as_uint(f); u += 0x7FFFu + ((u >> 16) & 1u); return (bf16_t)(u >> 16); }
typedef __bf16 bf16n2 __attribute__((ext_vector_type(2)));
__device__ __forceinline__ unsigned pk2(float lo, float hi) { typedef float f32n2 __attribute__((ext_vector_type(2))); const f32n2 v = {lo, hi}; return __builtin_bit_cast(unsigned, __builtin_convertvector(v, bf16n2)); }
__device__ __forceinline__ float bf2f(bf16_t b) { return __uint_as_float(((unsigned)b) << 16); }
__device__ __forceinline__ float gelu_exact(float x) { return 0.5f * x * (1.0f + erff(x * 0.70710678118654752f)); }
__device__ __forceinline__ float wave_sum(float v) {
#pragma unroll
  for (int o = 32; o > 0; o >>= 1) v += __shfl_xor(v, o);
  return v;
}

typedef __bf16 bf16x2_t __attribute__((ext_vector_type(2)));
__device__ __forceinline__ float dot2bf(unsigned a, unsigned b, float c) { return __builtin_amdgcn_fdot2_f32_bf16(__builtin_bit_cast(bf16x2_t, a), __builtin_bit_cast(bf16x2_t, b), c, false); }
__device__ __forceinline__ float wave_sum_dpp(float v) {
  int x;
  x = __builtin_amdgcn_mov_dpp(__float_as_int(v), 0xB1, 0xF, 0xF, true); v += __int_as_float(x);
  x = __builtin_amdgcn_mov_dpp(__float_as_int(v), 0x4E, 0xF, 0xF, true); v += __int_as_float(x);
  x = __builtin_amdgcn_mov_dpp(__float_as_int(v), 0x141, 0xF, 0xF, true); v += __int_as_float(x);
  x = __builtin_amdgcn_mov_dpp(__float_as_int(v), 0x140, 0xF, 0xF, true); v += __int_as_float(x);
  const int vi = __float_as_int(v);
  return (__int_as_float(__builtin_amdgcn_readlane(vi, 0)) + __int_as_float(__builtin_amdgcn_readlane(vi, 16))) +
         (__int_as_float(__builtin_amdgcn_readlane(vi, 32)) + __int_as_float(__builtin_amdgcn_readlane(vi, 48)));
}
__device__ __forceinline__ float gelu_as(float v) {
  const float av = fabsf(v), t = __builtin_amdgcn_rcpf(av * 0.2316418882f + 1.0f);
  float q = t * 0.5307027145f + (-0.7265760135f); q = q * t + 0.7107068705f; q = q * t + (-0.142248368f); q = q * t + 0.127414796f; q = q * t;
  const float e = __builtin_amdgcn_exp2f((v * v) * (-0.72134752044f));
  const float m = v * (q * e);
  return v < 0.f ? m : v - m;
}

__device__ __forceinline__ void fold_item(const Params& P, int it, int lane, LAS float* scr) {
  const int kk0 = (it & 63) * 16, half = (it >> 6) & 1, head = (it >> 7) & 7, layer = it >> 10;
  const float* kx = (half ? P.in[18] : P.in[17]) + (size_t)layer * 16384;
  const float* wq = P.in[16] + (size_t)layer * 1024 * 2048 + head * 256 + half * 128;
#pragma unroll
  for (int i = 0; i < 8; ++i) { const int e = i * 64 + lane, r = e >> 5, c4 = e & 31;
    const float4 v = *(const float4*)(wq + (size_t)(kk0 + r) * 2048 + c4 * 4);
    *(LAS f32x4*)(scr + r * 128 + c4 * 4) = (f32x4){v.x, v.y, v.z, v.w}; }
  asm volatile("s_waitcnt lgkmcnt(0)" ::: "memory");
  float a0[16], a1[16];
#pragma unroll
  for (int i = 0; i < 16; ++i) { a0[i] = 0.f; a1[i] = 0.f; }
#pragma unroll 2
  for (int d4 = 0; d4 < 32; ++d4) {
    const float4 x0 = *(const float4*)(kx + (size_t)lane * 128 + d4 * 4), x1 = *(const float4*)(kx + (size_t)(lane + 64) * 128 + d4 * 4);
#pragma unroll
    for (int kk = 0; kk < 16; ++kk) {
      const f32x4 b = *(const LAS f32x4*)(scr + kk * 128 + d4 * 4);
      a0[kk] += x0.x * b[0] + x0.y * b[1] + x0.z * b[2] + x0.w * b[3];
      a1[kk] += x1.x * b[0] + x1.y * b[1] + x1.z * b[2] + x1.w * b[3];
    }
  }
  asm volatile("s_waitcnt lgkmcnt(0)" ::: "memory");
  bf16_t* wt = (bf16_t*)(P.ws + WS_WP) + (size_t)layer * 2048 * 1024;
  bf16_t* r0 = wt + (size_t)(head * 256 + half * 128 + lane) * 1024 + kk0;
  bf16_t* r1 = r0 + (size_t)64 * 1024;
  v4u o;
  o.x = pk2(a0[0], a0[1]); o.y = pk2(a0[2], a0[3]); o.z = pk2(a0[4], a0[5]); o.w = pk2(a0[6], a0[7]); *(v4u*)r0 = o;
  o.x = pk2(a0[8], a0[9]); o.y = pk2(a0[10], a0[11]); o.z = pk2(a0[12], a0[13]); o.w = pk2(a0[14], a0[15]); *(v4u*)(r0 + 8) = o;
  o.x = pk2(a1[0], a1[1]); o.y = pk2(a1[2], a1[3]); o.z = pk2(a1[4], a1[5]); o.w = pk2(a1[6], a1[7]); *(v4u*)r1 = o;
  o.x = pk2(a1[8], a1[9]); o.y = pk2(a1[10], a1[11]); o.z = pk2(a1[12], a1[13]); o.w = pk2(a1[14], a1[15]); *(v4u*)(r1 + 8) = o;
}

__device__ __forceinline__ float wave_max_dpp(float v) {
  v = fmaxf(v, __int_as_float(__builtin_amdgcn_mov_dpp(__float_as_int(v), 0xB1, 0xF, 0xF, true)));
  v = fmaxf(v, __int_as_float(__builtin_amdgcn_mov_dpp(__float_as_int(v), 0x4E, 0xF, 0xF, true)));
  v = fmaxf(v, __int_as_float(__builtin_amdgcn_mov_dpp(__float_as_int(v), 0x141, 0xF, 0xF, true)));
  v = fmaxf(v, __int_as_float(__builtin_amdgcn_mov_dpp(__float_as_int(v), 0x140, 0xF, 0xF, true)));
  const int vi = __float_as_int(v);
  return fmaxf(fmaxf(__int_as_float(__builtin_amdgcn_readlane(vi, 0)), __int_as_float(__builtin_amdgcn_readlane(vi, 16))),
               fmaxf(__int_as_float(__builtin_amdgcn_readlane(vi, 32)), __int_as_float(__builtin_amdgcn_readlane(vi, 48))));
}
__device__ __forceinline__ int wave_isum_dpp(int v) {
  v += __builtin_amdgcn_mov_dpp(v, 0xB1, 0xF, 0xF, true);
  v += __builtin_amdgcn_mov_dpp(v, 0x4E, 0xF, 0xF, true);
  v += __builtin_amdgcn_mov_dpp(v, 0x141, 0xF, 0xF, true);
  v += __builtin_amdgcn_mov_dpp(v, 0x140, 0xF, 0xF, true);
  return (__builtin_amdgcn_readlane(v, 0) + __builtin_amdgcn_readlane(v, 16)) + (__builtin_amdgcn_readlane(v, 32) + __builtin_amdgcn_readlane(v, 48));
}
__device__ __forceinline__ unsigned q8(float x, float inv) { const int q = (int)rintf(x * inv); return (unsigned)(q < -127 ? -127 : (q > 127 ? 127 : q)) & 0xFFu; }
__device__ __forceinline__ void tabconv8_row(const Params& P, int r, const float4 (&v)[4], int lane) {
  const int row = r & 16383, tab = (r >> 14) & 1, layer = r >> 15;
  float am = 0.f;
#pragma unroll
  for (int i = 0; i < 4; ++i) am = fmaxf(am, fmaxf(fmaxf(fabsf(v[i].x), fabsf(v[i].y)), fmaxf(fabsf(v[i].z), fabsf(v[i].w))));
  am = wave_max_dpp(am);
  const float sc = am > 0.f ? am * (1.0f / 127.0f) : 1.0f, inv = 1.0f / sc;
  const unsigned off = 0u;
  v4u o; unsigned w[4];
#pragma unroll
  for (int i = 0; i < 4; ++i) w[i] = ((q8(v[i].x, inv) | (q8(v[i].y, inv) << 8) | (q8(v[i].z, inv) << 16) | (q8(v[i].w, inv) << 24)) ^ off);
  o.x = w[0]; o.y = w[1]; o.z = w[2]; o.w = w[3];
  *(v4u*)(P.ws + WS_TAB + (size_t)(layer * 2 + tab) * 16 * MiB + ((size_t)(lane >> 3) * 16384 + row) * 128 + (lane & 7) * 16) = o;
  if (lane == 0) ((float*)(P.ws + WS_SCALE))[(layer * 2 + tab) * 16384 + row] = sc;
}
__device__ __forceinline__ void tabconv8_load(const Params& P, int r, float4 (&v)[4], int lane) {
  const int row = r & 16383, tab = (r >> 14) & 1, layer = r >> 15;
  const float* src = P.in[19 + tab] + ((size_t)layer * 16384 + row) * 1024;
#pragma unroll
  for (int i = 0; i < 4; ++i) v[i] = tab ? *(const float4*)(src + lane * 16 + i * 4) : *(const float4*)(src + i * 256 + lane * 4);
}
__device__ __forceinline__ void phase_tabconv8(const Params& P) {
  const int lane = threadIdx.x & 63, wave = __builtin_amdgcn_readfirstlane(threadIdx.x >> 6);
  const int gw = blockIdx.x * 8 + wave, NGW = gridDim.x * 8;
  float4 a[4], b[4], c[4], d[4];
  for (int r = gw; r < 4 * 16384; r += 4 * NGW) {
    tabconv8_load(P, r, a, lane);
    if (r + NGW < 4 * 16384) tabconv8_load(P, r + NGW, b, lane);
    if (r + 2 * NGW < 4 * 16384) tabconv8_load(P, r + 2 * NGW, c, lane);
    if (r + 3 * NGW < 4 * 16384) tabconv8_load(P, r + 3 * NGW, d, lane);
    tabconv8_row(P, r, a, lane);
    if (r + NGW < 4 * 16384) tabconv8_row(P, r + NGW, b, lane);
    if (r + 2 * NGW < 4 * 16384) tabconv8_row(P, r + 2 * NGW, c, lane);
    if (r + 3 * NGW < 4 * 16384) tabconv8_row(P, r + 3 * NGW, d, lane);
  }
}

constexpr size_t WS_GSU = WS_H;
constexpr size_t WS_GSV = WS_GATE;
__device__ __forceinline__ unsigned enc_key(float s) { const unsigned b = __float_as_uint(s); return (b & 0x80000000u) ? ~b : (b | 0x80000000u); }
__device__ __forceinline__ float dec_key(unsigned u) { return __uint_as_float((u & 0x80000000u) ? (u & 0x7FFFFFFFu) : ~u); }
#define TK_CE(a, b) do { const unsigned _hi = (a) > (b) ? (a) : (b), _lo = (a) > (b) ? (b) : (a); (a) = _hi; (b) = _lo; } while (0)
__device__ __forceinline__ void sort16_desc(unsigned (&k)[16]) {
#pragma unroll
  for (int size = 2; size <= 16; size <<= 1)
#pragma unroll
    for (int stride = size >> 1; stride > 0; stride >>= 1)
#pragma unroll
      for (int i = 0; i < 16; ++i) { const int j = i ^ stride; if (j > i) { if ((i & size) == 0) TK_CE(k[i], k[j]); else TK_CE(k[j], k[i]); } }
}
__device__ __forceinline__ void merge16_desc(unsigned (&k)[16]) {
#pragma unroll
  for (int stride = 8; stride > 0; stride >>= 1)
#pragma unroll
    for (int i = 0; i < 16; ++i) { const int j = i ^ stride; if (j > i) TK_CE(k[i], k[j]); }
}
__device__ __forceinline__ void topmerge16(unsigned (&R)[16], const unsigned (&N)[16]) {
#pragma unroll
  for (int i = 0; i < 16; ++i) R[i] = R[i] > N[15 - i] ? R[i] : N[15 - i];
  merge16_desc(R);
}
__device__ __forceinline__ void topk_ld(const _Float16* wbase, int step, int lane, v4u (&g)[4]) {
#pragma unroll
  for (int i = 0; i < 4; ++i) g[i] = *(const v4u*)(wbase + (size_t)(i * 16 + (lane >> 2)) * 256 + step * 32 + (lane & 3) * 8);
}
__device__ __forceinline__ void topk_put(LAS unsigned char* tile, int lane, const v4u (&g)[4]) {
#pragma unroll
  for (int i = 0; i < 4; ++i) *(LAS v4u*)(tile + (i * 16 + (lane >> 2)) * 80 + (lane & 3) * 16) = g[i];
}
__device__ __forceinline__ void topk_group(LAS unsigned char* tile, int lane, int sub, int gcol, unsigned (&N)[16]) {
  typedef _Float16 h2 __attribute__((ext_vector_type(2)));
#pragma unroll
  for (int q = 0; q < 2; ++q) { const v4u v = *(const LAS v4u*)(tile + lane * 80 + sub * 32 + q * 16); const unsigned vv[4] = {v.x, v.y, v.z, v.w};
#pragma unroll
    for (int j = 0; j < 4; ++j) { const h2 hh = __builtin_bit_cast(h2, vv[j]);
      N[q * 8 + 2 * j + 0] = (enc_key((float)hh.x) & ~0x7Fu) | (unsigned)(127 - (gcol + q * 8 + 2 * j + 0));
      N[q * 8 + 2 * j + 1] = (enc_key((float)hh.y) & ~0x7Fu) | (unsigned)(127 - (gcol + q * 8 + 2 * j + 1)); } }
  sort16_desc(N);
}

__device__ __forceinline__ void phase_topk(const Params& P, LAS unsigned char* lds, int layer) {
  const _Float16* S = (const _Float16*)(P.ws + WS_BIG);
  int* EID = (int*)(P.ws + WS_EID); float* GSU = (float*)(P.ws + WS_GSU); float* GSV = (float*)(P.ws + WS_GSV);
  const float* scu = (const float*)(P.ws + WS_SCALE) + layer * 32768; const float* scv = scu + 16384;
  int lane = threadIdx.x & 63; const int wave = __builtin_amdgcn_readfirstlane(threadIdx.x >> 6);
  asm volatile("" : "+v"(lane));
  LAS unsigned char* my = lds + (wave * 64 + lane) * 36;
  LAS unsigned char* tile = lds + 20480 + wave * 10240;
  const int NT = gridDim.x * blockDim.x;
  for (int row = blockIdx.x * blockDim.x + wave * 64 + lane; row < TOK * 8; row += NT) {
    const _Float16* wbase = S + (size_t)(row - lane) * 256;
    unsigned R1[16], R2[16];
    v4u ld[4];
    topk_ld(wbase, 0, lane, ld);
#pragma unroll
    for (int st = 0; st < 8; ++st) {
      LAS unsigned char* tl = tile + (st & 1) * 5120;
      topk_put(tl, lane, ld);
      if (st + 1 < 8) topk_ld(wbase, st + 1, lane, ld);
#pragma unroll
      for (int sub = 0; sub < 2; ++sub) {
        const int gi = st * 2 + sub;
        unsigned N[16];
        topk_group(tl, lane, sub, (gi & 7) * 16, N);
        if (gi == 0) {
#pragma unroll
          for (int i = 0; i < 16; ++i) R1[i] = N[i];
        } else if (gi < 8) topmerge16(R1, N);
        else if (gi == 8) {
#pragma unroll
          for (int i = 0; i < 16; ++i) R2[i] = N[i];
        } else topmerge16(R2, N);
      }
    }
    float v1[16], v2[16];
#pragma unroll
    for (int i = 0; i < 16; ++i) { v1[i] = dec_key(R1[i] & ~0x7Fu); v2[i] = dec_key(R2[i] & ~0x7Fu); my[i] = (unsigned char)(127u - (R1[i] & 0x7Fu)); my[16 + i] = (unsigned char)(127u - (R2[i] & 0x7Fu)); }
    unsigned C[64];
    {
      int n = 0;
#pragma unroll
      for (int a = 0; a < 16; ++a)
#pragma unroll
        for (int b = 0; b < 16; ++b)
          if ((a + 1) * (b + 1) <= 16) { C[n] = (enc_key(v1[a] + v2[b]) & ~0xFFu) | (unsigned)(255 - (a * 16 + b)); ++n; }
#pragma unroll
      for (int i = 50; i < 64; ++i) C[i] = 0u;
    }
    unsigned R[16], N[16];
#pragma unroll
    for (int i = 0; i < 16; ++i) R[i] = C[i];
    sort16_desc(R);
#pragma unroll
    for (int g = 1; g < 4; ++g) {
#pragma unroll
      for (int i = 0; i < 16; ++i) N[i] = C[g * 16 + i];
      sort16_desc(N); topmerge16(R, N);
    }
    float ev[16]; int ei[16]; float sum = 0.f;
    const float mx = dec_key(R[0] & ~0xFFu);
#pragma unroll
    for (int i = 0; i < 16; ++i) {
      const unsigned pos = 255u - (R[i] & 0xFFu);
      ev[i] = __expf(dec_key(R[i] & ~0xFFu) - mx); sum += ev[i];
      ei[i] = (int)my[pos >> 4] * 128 + (int)my[16 + (pos & 15u)];
    }
    const float inv = 1.0f / sum;
#pragma unroll
    for (int q = 0; q < 4; ++q) {
      *(int4*)(EID + (size_t)row * 16 + q * 4) = make_int4(ei[q * 4], ei[q * 4 + 1], ei[q * 4 + 2], ei[q * 4 + 3]);
      *(float4*)(GSU + (size_t)row * 16 + q * 4) = make_float4(scu[ei[q * 4]], scu[ei[q * 4 + 1]], scu[ei[q * 4 + 2]], scu[ei[q * 4 + 3]]);
      *(float4*)(GSV + (size_t)row * 16 + q * 4) = make_float4(ev[q * 4] * inv * scv[ei[q * 4]], ev[q * 4 + 1] * inv * scv[ei[q * 4 + 1]], ev[q * 4 + 2] * inv * scv[ei[q * 4 + 2]], ev[q * 4 + 3] * inv * scv[ei[q * 4 + 3]]);
    }
  }
}

constexpr size_t WS_H8 = WS_BIG + 256 * MiB;
constexpr size_t WS_SH = WS_BIG + 288 * MiB;
constexpr size_t WS_W = WS_BIG + 289 * MiB;
constexpr size_t WS_WQ = WS_W;
constexpr size_t WS_SW = WS_W + 8 * MiB;
constexpr size_t WS_RFIN = WS_BIG;
struct VsHdrLane { const unsigned char* base; int sh, mask; };
__device__ __forceinline__ VsHdrLane vs_hdr_lane(const Params& P, int lane) {
  VsHdrLane h;
  h.base = P.ws + (lane < 32 ? WS_EID + lane * 16 : lane < 40 ? WS_WQ + (lane - 32) * 16 : WS_SW);
  h.sh = lane < 32 ? 9 : lane < 40 ? 7 : 2; h.mask = lane < 40 ? -1 : ~3;
  return h;
}
__device__ __forceinline__ void vs_hdr_issue(const VsHdrLane& h, int tok, LAS unsigned char* slot) {
  const unsigned char* src = h.base + ((unsigned)(tok & h.mask) << h.sh);
  asm volatile("s_mov_b32 m0, %1\n\ts_nop 0\n\tglobal_load_lds_dwordx4 %0, off" :: "v"(src), "s"((unsigned)(size_t)slot) : "m0", "memory");
}
#define VS_BP(v, x) __builtin_amdgcn_ds_bpermute((lane ^ (x)) * 4, (v))
#define VS_PIN_ROWS(q) asm volatile("" : "+v"(q[0]), "+v"(q[1]), "+v"(q[2]), "+v"(q[3]))
#define VS_PIN_ACC(a) asm volatile("" : "+v"(a[0]), "+v"(a[1]), "+v"(a[2]), "+v"(a[3]), "+v"(a[4]), "+v"(a[5]), "+v"(a[6]), "+v"(a[7]), "+v"(a[8]), "+v"(a[9]), "+v"(a[10]), "+v"(a[11]), "+v"(a[12]), "+v"(a[13]), "+v"(a[14]), "+v"(a[15]))
__device__ __forceinline__ void vs_rows4(v4u (&vb)[4], const v4u& e, const unsigned char* VS, int p) {
  unsigned e0 = e.x, e1 = e.y, e2 = e.z, e3 = e.w;
  asm volatile("" : "+v"(e0), "+v"(e1), "+v"(e2), "+v"(e3));
  vb[0] = *(const v4u*)(VS + (e0 * 128u + p * 16)); vb[1] = *(const v4u*)(VS + (e1 * 128u + p * 16));
  vb[2] = *(const v4u*)(VS + (e2 * 128u + p * 16)); vb[3] = *(const v4u*)(VS + (e3 * 128u + p * 16));
}
__device__ __forceinline__ void vs_acc4(int (&acc)[16], const v4u& a, const v4u& b, const v4u& c, const v4u& d, unsigned wq) {
  const unsigned ra[4] = {a.x, a.y, a.z, a.w}, rb[4] = {b.x, b.y, b.z, b.w}, rc[4] = {c.x, c.y, c.z, c.w}, rd[4] = {d.x, d.y, d.z, d.w};
#pragma unroll
  for (int i = 0; i < 4; ++i) {
    const unsigned ablo = __builtin_amdgcn_perm(rb[i], ra[i], 0x05010400u), abhi = __builtin_amdgcn_perm(rb[i], ra[i], 0x07030602u);
    const unsigned cdlo = __builtin_amdgcn_perm(rd[i], rc[i], 0x05010400u), cdhi = __builtin_amdgcn_perm(rd[i], rc[i], 0x07030602u);
    acc[4 * i + 0] = __builtin_amdgcn_sdot4((int)__builtin_amdgcn_perm(cdlo, ablo, 0x05040100u), (int)wq, acc[4 * i + 0], false);
    acc[4 * i + 1] = __builtin_amdgcn_sdot4((int)__builtin_amdgcn_perm(cdlo, ablo, 0x07060302u), (int)wq, acc[4 * i + 1], false);
    acc[4 * i + 2] = __builtin_amdgcn_sdot4((int)__builtin_amdgcn_perm(cdhi, abhi, 0x05040100u), (int)wq, acc[4 * i + 2], false);
    acc[4 * i + 3] = __builtin_amdgcn_sdot4((int)__builtin_amdgcn_perm(cdhi, abhi, 0x07060302u), (int)wq, acc[4 * i + 3], false);
  }
}
#ifndef VS_VAR
#define VS_VAR 0
#endif
__device__ __forceinline__ void vs_xor4(int (&acc)[16], const v4u& a, const v4u& b, const v4u& c, const v4u& d) {
  acc[0] ^= (int)(a.x ^ a.y ^ a.z ^ a.w); acc[1] ^= (int)(b.x ^ b.y ^ b.z ^ b.w); acc[2] ^= (int)(c.x ^ c.y ^ c.z ^ c.w); acc[3] ^= (int)(d.x ^ d.y ^ d.z ^ d.w);
}
template <bool DRY>
__device__ __forceinline__ void vs_step(const Params& P, bf16_t* dst, int tok, int pf_tok, int last, const unsigned char* VS, int x, int lane, const VsHdrLane& hl, LAS unsigned char* scur, LAS unsigned char* snxt, LAS unsigned char* snew,
                                        v4u (&q0)[4], v4u (&q1)[4], v4u (&q2)[4], v4u (&q3)[4]) {
  const int g = lane >> 3, p = lane & 7;
  const int tokc = tok < TOK ? tok : last;
  asm volatile("s_waitcnt vmcnt(17)" ::: "memory");
  const v4u wq = *(const LAS v4u*)(scur + 512 + g * 16);
  const float sw = *(const LAS float*)(scur + 640 + (tokc & 3) * 4);
  v4u e[4];
#pragma unroll
  for (int i = 0; i < 4; ++i) e[i] = *(const LAS v4u*)(snxt + g * 64 + i * 16);
  __builtin_amdgcn_sched_barrier(0);
  vs_hdr_issue(hl, pf_tok < TOK ? pf_tok : last, snew);
  __builtin_amdgcn_sched_barrier(0);
  const size_t oo = (size_t)tok * 1024 + x * 128 + p * 16 + g * 2;
  const unsigned xw = *(const unsigned*)((tok < TOK ? (const bf16_t*)P.out + oo : (const bf16_t*)(P.ws + WS_DUMMY)));
  float2 xo; xo.x = __uint_as_float(xw << 16); xo.y = __uint_as_float(xw & 0xFFFF0000u);
  int acc[16];
#pragma unroll
  for (int i = 0; i < 16; ++i) acc[i] = 0;
  __builtin_amdgcn_sched_barrier(0);
  VS_PIN_ROWS(q0);
  if (DRY && VS_VAR == 1) vs_xor4(acc, q0[0], q0[1], q0[2], q0[3]); else
  vs_acc4(acc, q0[0], q0[1], q0[2], q0[3], wq.x);
  VS_PIN_ACC(acc);
  __builtin_amdgcn_sched_barrier(0);
  if (!(DRY && VS_VAR == 2))
  vs_rows4(q0, e[0], VS, p);
  __builtin_amdgcn_sched_barrier(0);
  VS_PIN_ROWS(q1);
  if (DRY && VS_VAR == 1) vs_xor4(acc, q1[0], q1[1], q1[2], q1[3]); else
  vs_acc4(acc, q1[0], q1[1], q1[2], q1[3], wq.y);
  VS_PIN_ACC(acc);
  __builtin_amdgcn_sched_barrier(0);
  if (!(DRY && VS_VAR == 2))
  vs_rows4(q1, e[1], VS, p);
  __builtin_amdgcn_sched_barrier(0);
  VS_PIN_ROWS(q2);
  if (DRY && VS_VAR == 1) vs_xor4(acc, q2[0], q2[1], q2[2], q2[3]); else
  vs_acc4(acc, q2[0], q2[1], q2[2], q2[3], wq.z);
  VS_PIN_ACC(acc);
  __builtin_amdgcn_sched_barrier(0);
  if (!(DRY && VS_VAR == 2))
  vs_rows4(q2, e[2], VS, p);
  __builtin_amdgcn_sched_barrier(0);
  VS_PIN_ROWS(q3);
  if (DRY && VS_VAR == 1) vs_xor4(acc, q3[0], q3[1], q3[2], q3[3]); else
  vs_acc4(acc, q3[0], q3[1], q3[2], q3[3], wq.w);
  VS_PIN_ACC(acc);
  __builtin_amdgcn_sched_barrier(0);
  if (!(DRY && VS_VAR == 2))
  vs_rows4(q3, e[3], VS, p);
  __builtin_amdgcn_sched_barrier(0);
  const bool b5 = lane & 32, b4 = lane & 16, b3 = lane & 8;
  int r8[8], r4[4], r2[2];
#pragma unroll
  for (int i = 0; i < 8; ++i) { const int keep = b5 ? acc[8 + i] : acc[i], send = b5 ? acc[i] : acc[8 + i]; r8[i] = keep + VS_BP(send, 32); }
#pragma unroll
  for (int i = 0; i < 4; ++i) { const int keep = b4 ? r8[4 + i] : r8[i], send = b4 ? r8[i] : r8[4 + i]; r4[i] = keep + VS_BP(send, 16); }
#pragma unroll
  for (int i = 0; i < 2; ++i) { const int keep = b3 ? r4[2 + i] : r4[i], send = b3 ? r4[i] : r4[2 + i]; r2[i] = keep + VS_BP(send, 8); }
  float2 o; o.x = xo.x + (float)r2[0] * sw; o.y = xo.y + (float)r2[1] * sw;
  unsigned* op = (unsigned*)(tok < TOK ? dst + oo : (bf16_t*)(P.ws + WS_DUMMY));
  if (!DRY || o.x == 1234.5f) *op = pk2(o.x, o.y);
}
template <bool DRY>
__device__ __forceinline__ void phase_vslice(const Params& P, LAS unsigned char* lds, int layer) {
  int lane = threadIdx.x & 63; const int wave = __builtin_amdgcn_readfirstlane(threadIdx.x >> 6);
  asm volatile("" : "+v"(lane));
  const int nsl = (gridDim.x & 7) == 0 ? 8 : 0;
  const int g = lane >> 3, p = lane & 7;
  const int wi = (nsl ? (blockIdx.x >> 3) : blockIdx.x) * 8 + wave, NW = (nsl ? (gridDim.x >> 3) : gridDim.x) * 8;
  const VsHdrLane hl = vs_hdr_lane(P, lane);
  LAS unsigned char* r0 = lds + wave * 3072; LAS unsigned char* r1 = r0 + 1024; LAS unsigned char* r2 = r0 + 2048;
  bf16_t* dst = layer == 1 ? (bf16_t*)(P.ws + WS_RFIN) : (bf16_t*)P.out;
  for (int xs = 0; xs < (nsl ? 1 : 8); ++xs) {
    const int x = nsl ? (blockIdx.x & 7) : xs;
    const unsigned char* VS = P.ws + WS_TAB + (size_t)(layer * 2 + 1) * 16 * MiB + (size_t)x * 2 * MiB;
    if (wi >= TOK) continue;
    v4u q0[4], q1[4], q2[4], q3[4];
    const int last = wi + ((TOK - 1 - wi) / NW) * NW;
    vs_hdr_issue(hl, wi, r0);
    vs_hdr_issue(hl, wi + NW < TOK ? wi + NW : last, r1);
    asm volatile("s_waitcnt vmcnt(0)" ::: "memory");
    {
      v4u e[4];
#pragma unroll
      for (int i = 0; i < 4; ++i) e[i] = *(const LAS v4u*)(r0 + g * 64 + i * 16);
      vs_rows4(q0, e[0], VS, p); vs_rows4(q1, e[1], VS, p); vs_rows4(q2, e[2], VS, p); vs_rows4(q3, e[3], VS, p);
    }
    for (int tok = wi; tok < TOK; tok += 3 * NW) {
      vs_step<DRY>(P, dst, tok, tok + 2 * NW, last, VS, x, lane, hl, r0, r1, r2, q0, q1, q2, q3);
      vs_step<DRY>(P, dst, tok + NW, tok + 3 * NW, last, VS, x, lane, hl, r1, r2, r0, q0, q1, q2, q3);
      vs_step<DRY>(P, dst, tok + 2 * NW, tok + 4 * NW, last, VS, x, lane, hl, r2, r0, r1, q0, q1, q2, q3);
    }
    asm volatile("s_waitcnt vmcnt(0)" ::: "memory");
  }
}
__device__ __forceinline__ void phase_final_norm(const Params& P, const float* g) {
  const int lane = threadIdx.x & 63, wave = __builtin_amdgcn_readfirstlane(threadIdx.x >> 6);
  const int gw = blockIdx.x * 8 + wave, NGW = gridDim.x * 8;
  float4 gg[4];
#pragma unroll
  for (int i = 0; i < 4; ++i) gg[i] = *(const float4*)(g + i * 256 + lane * 4);
  const bf16_t* R = (const bf16_t*)(P.ws + WS_RFIN);
  for (int tok = gw; tok < TOK; tok += NGW) {
    float* xo = P.out + (size_t)tok * 1024;
    float4 x[4]; float ss = 0.f;
#pragma unroll
    for (int i = 0; i < 4; ++i) { const v2u w = *(const v2u*)(R + (size_t)tok * 1024 + i * 256 + lane * 4);
      x[i].x = __uint_as_float(w.x << 16); x[i].y = __uint_as_float(w.x & 0xFFFF0000u); x[i].z = __uint_as_float(w.y << 16); x[i].w = __uint_as_float(w.y & 0xFFFF0000u);
      ss += x[i].x * x[i].x + x[i].y * x[i].y + x[i].z * x[i].z + x[i].w * x[i].w; }
    ss = wave_sum_dpp(ss);
    const float rs = rsqrtf(ss * (1.0f / 1024.0f) + 1e-6f);
#pragma unroll
    for (int i = 0; i < 4; ++i) { float4 y; y.x = x[i].x * rs * gg[i].x; y.y = x[i].y * rs * gg[i].y; y.z = x[i].z * rs * gg[i].z; y.w = x[i].w * rs * gg[i].w; *(float4*)(xo + i * 256 + lane * 4) = y; }
  }
}

constexpr size_t WS_PART = WS_BIG + 128 * MiB;
__device__ __forceinline__ VsHdrLane us_hdr_lane(const Params& P, int lane, int x) {
  VsHdrLane h;
  h.base = P.ws + (lane < 32 ? WS_EID + lane * 16 : lane < 40 ? WS_H8 + x * 128 + (lane - 32) * 16 : WS_EID);
  h.sh = (lane >= 32 && lane < 40) ? 10 : 9; h.mask = -1;
  return h;
}
__device__ __forceinline__ void us_acc4(int& r0, int& r1, const v4u (&q)[4], const v4u& hq, int p, int it0) {
#pragma unroll
  for (int j = 0; j < 4; ++j) {
    const int it = it0 + j;
    int is = __builtin_amdgcn_sdot4((int)q[j].x, (int)hq.x, 0, false);
    is = __builtin_amdgcn_sdot4((int)q[j].y, (int)hq.y, is, false);
    is = __builtin_amdgcn_sdot4((int)q[j].z, (int)hq.z, is, false);
    is = __builtin_amdgcn_sdot4((int)q[j].w, (int)hq.w, is, false);
    is += __builtin_amdgcn_mov_dpp(is, 0xB1, 0xF, 0xF, true); is += __builtin_amdgcn_mov_dpp(is, 0x4E, 0xF, 0xF, true); is += __builtin_amdgcn_mov_dpp(is, 0x141, 0xF, 0xF, true);
    if (it < 8) r0 = (p == it) ? is : r0; else r1 = (p == it - 8) ? is : r1;
  }
}
template <bool DRY>
__device__ __forceinline__ void us_step(const Params& P, int tok, int pf_tok, int last, const unsigned char* US, int x, int lane, const VsHdrLane& hl, LAS unsigned char* scur, LAS unsigned char* snxt, LAS unsigned char* snew,
                                        v4u (&q0)[4], v4u (&q1)[4], v4u (&q2)[4], v4u (&q3)[4]) {
  const int g = lane >> 3, p = lane & 7;
  asm volatile("s_waitcnt vmcnt(16)" ::: "memory");
  const v4u hq = *(const LAS v4u*)(scur + 512 + p * 16);
  v4u e[4];
#pragma unroll
  for (int i = 0; i < 4; ++i) e[i] = *(const LAS v4u*)(snxt + g * 64 + i * 16);
  __builtin_amdgcn_sched_barrier(0);
  vs_hdr_issue(hl, pf_tok < TOK ? pf_tok : last, snew);
  __builtin_amdgcn_sched_barrier(0);
  int r0 = 0, r1 = 0;
#define US_PIN_R() asm volatile("" : "+v"(r0), "+v"(r1))
  VS_PIN_ROWS(q0); us_acc4(r0, r1, q0, hq, p, 0); US_PIN_R();
  __builtin_amdgcn_sched_barrier(0);
  vs_rows4(q0, e[0], US, p);
  __builtin_amdgcn_sched_barrier(0);
  VS_PIN_ROWS(q1); us_acc4(r0, r1, q1, hq, p, 4); US_PIN_R();
  __builtin_amdgcn_sched_barrier(0);
  vs_rows4(q1, e[1], US, p);
  __builtin_amdgcn_sched_barrier(0);
  VS_PIN_ROWS(q2); us_acc4(r0, r1, q2, hq, p, 8); US_PIN_R();
  __builtin_amdgcn_sched_barrier(0);
  vs_rows4(q2, e[2], US, p);
  __builtin_amdgcn_sched_barrier(0);
  VS_PIN_ROWS(q3); us_acc4(r0, r1, q3, hq, p, 12); US_PIN_R();
  __builtin_amdgcn_sched_barrier(0);
  vs_rows4(q3, e[3], US, p);
  __builtin_amdgcn_sched_barrier(0);
  _Float16* part = (tok < TOK ? (_Float16*)(P.ws + WS_PART) + ((size_t)x * TOK + tok) * 128 : (_Float16*)(P.ws + WS_DUMMY)) + g * 16 + p;
  if (!DRY || r0 == 0x7FFFFFFF) { part[0] = (_Float16)((float)r0 * 0.015625f); part[8] = (_Float16)((float)r1 * 0.015625f); }
}
template <bool DRY>
__device__ __forceinline__ void phase_uslice(const Params& P, LAS unsigned char* lds, int layer) {
  int lane = threadIdx.x & 63; const int wave = __builtin_amdgcn_readfirstlane(threadIdx.x >> 6);
  asm volatile("" : "+v"(lane));
  const int nsl = (gridDim.x & 7) == 0 ? 8 : 0;
  const int g = lane >> 3, p = lane & 7;
  const int wi = (nsl ? (blockIdx.x >> 3) : blockIdx.x) * 8 + wave, NW = (nsl ? (gridDim.x >> 3) : gridDim.x) * 8;
  LAS unsigned char* r0 = lds + wave * 3072; LAS unsigned char* r1 = r0 + 1024; LAS unsigned char* r2 = r0 + 2048;
  for (int xs = 0; xs < (nsl ? 1 : 8); ++xs) {
    const int x = nsl ? (blockIdx.x & 7) : xs;
    const unsigned char* US = P.ws + WS_TAB + (size_t)(layer * 2) * 16 * MiB + (size_t)x * 2 * MiB;
    if (wi >= TOK) continue;
    const VsHdrLane hl = us_hdr_lane(P, lane, x);
    v4u q0[4], q1[4], q2[4], q3[4];
    const int last = wi + ((TOK - 1 - wi) / NW) * NW;
    vs_hdr_issue(hl, wi, r0);
    vs_hdr_issue(hl, wi + NW < TOK ? wi + NW : last, r1);
    asm volatile("s_waitcnt vmcnt(0)" ::: "memory");
    {
      v4u e[4];
#pragma unroll
      for (int i = 0; i < 4; ++i) e[i] = *(const LAS v4u*)(r0 + g * 64 + i * 16);
      vs_rows4(q0, e[0], US, p); vs_rows4(q1, e[1], US, p); vs_rows4(q2, e[2], US, p); vs_rows4(q3, e[3], US, p);
    }
    for (int tok = wi; tok < TOK; tok += 3 * NW) {
      us_step<DRY>(P, tok, tok + 2 * NW, last, US, x, lane, hl, r0, r1, r2, q0, q1, q2, q3);
      us_step<DRY>(P, tok + NW, tok + 3 * NW, last, US, x, lane, hl, r1, r2, r0, q0, q1, q2, q3);
      us_step<DRY>(P, tok + 2 * NW, tok + 4 * NW, last, US, x, lane, hl, r2, r0, r1, q0, q1, q2, q3);
    }
    asm volatile("s_waitcnt vmcnt(0)" ::: "memory");
  }
}
__device__ __forceinline__ void phase_ureduce(const Params& P) {
  const _Float16* PART = (const _Float16*)(P.ws + WS_PART); const float* GSU = (const float*)(P.ws + WS_GSU); const float* GSV = (const float*)(P.ws + WS_GSV);
  const float* SH = (const float*)(P.ws + WS_SH); unsigned* WQ = (unsigned*)(P.ws + WS_WQ); float* SW = (float*)(P.ws + WS_SW);
  const int lane = threadIdx.x & 63;
  const size_t n4 = (size_t)TOK * 128 / 4, NT = (size_t)gridDim.x * blockDim.x;
  for (size_t i = (size_t)blockIdx.x * blockDim.x + threadIdx.x; i < n4; i += NT) {
    typedef _Float16 h4 __attribute__((ext_vector_type(4)));
    float s0 = 0.f, s1 = 0.f, s2 = 0.f, s3 = 0.f;
#pragma unroll
    for (int x = 0; x < 8; ++x) { const h4 t = *(const h4*)(PART + (size_t)x * TOK * 128 + i * 4); s0 += (float)t[0]; s1 += (float)t[1]; s2 += (float)t[2]; s3 += (float)t[3]; }
    s0 *= 64.f; s1 *= 64.f; s2 *= 64.f; s3 *= 64.f;
    const float4 su = *(const float4*)(GSU + i * 4), gv = *(const float4*)(GSV + i * 4);
    const float sh = SH[i >> 5];
    float4 w;
    w.x = gv.x * gelu_as(s0 * (su.x * sh)); w.y = gv.y * gelu_as(s1 * (su.y * sh));
    w.z = gv.z * gelu_as(s2 * (su.z * sh)); w.w = gv.w * gelu_as(s3 * (su.w * sh));
    float wm = fmaxf(fmaxf(fabsf(w.x), fabsf(w.y)), fmaxf(fabsf(w.z), fabsf(w.w)));
    wm = fmaxf(wm, __int_as_float(__builtin_amdgcn_mov_dpp(__float_as_int(wm), 0xB1, 0xF, 0xF, true)));
    wm = fmaxf(wm, __int_as_float(__builtin_amdgcn_mov_dpp(__float_as_int(wm), 0x4E, 0xF, 0xF, true)));
    wm = fmaxf(wm, __int_as_float(__builtin_amdgcn_mov_dpp(__float_as_int(wm), 0x141, 0xF, 0xF, true)));
    wm = fmaxf(wm, __int_as_float(__builtin_amdgcn_mov_dpp(__float_as_int(wm), 0x140, 0xF, 0xF, true)));
    wm = fmaxf(wm, __int_as_float(__builtin_amdgcn_ds_bpermute((lane ^ 16) * 4, __float_as_int(wm))));
    const float sw = wm > 0.f ? wm * (1.0f / 127.0f) : 1.0f, winv = 1.0f / sw;
    WQ[i] = q8(w.x, winv) | (q8(w.y, winv) << 8) | (q8(w.z, winv) << 16) | (q8(w.w, winv) << 24);
    if ((lane & 31) == 0) SW[i >> 5] = sw;
  }
}
constexpr int GA_PITCH = 136;
constexpr int GA_WL = 0;
constexpr int GA_VT = 34816;
constexpr int GA_ST = 34816 + 69632;
template <bool DRY>
__device__ __forceinline__ void phase_gate_a(const Params& P, LAS unsigned char* lds) {
  const int tid = threadIdx.x, lane = tid & 63, wave = __builtin_amdgcn_readfirstlane(tid >> 6);
  bf16_t* U = (bf16_t*)(P.ws + WS_BIG); const bf16_t* V = U + (size_t)TOK * 2048;
  const float* ln_g = P.in[6]; const float* ln_b = P.in[7]; const float* w_s = P.in[8]; const float* b_s = P.in[9];
  LAS bf16_t* Wl = (LAS bf16_t*)(lds + GA_WL); LAS bf16_t* vT = (LAS bf16_t*)(lds + GA_VT); LAS float* st = (LAS float*)(lds + GA_ST);
  for (int chunk = blockIdx.x; chunk < TOK / 128; chunk += gridDim.x) {
    const size_t T0 = (size_t)chunk * 128;
    for (int i = 0; i < 16; ++i) {
      const int t = wave * 16 + i;
      const bf16_t* vr = V + (T0 + t) * 2048;
      float x[32]; float s = 0.f;
#pragma unroll
      for (int j = 0; j < 4; ++j) { const v4u w = *(const v4u*)(vr + (j * 64 + lane) * 8); const unsigned ww[4] = {w.x, w.y, w.z, w.w};
#pragma unroll
        for (int q = 0; q < 4; ++q) { x[j * 8 + 2 * q] = __uint_as_float(ww[q] << 16); x[j * 8 + 2 * q + 1] = __uint_as_float(ww[q] & 0xFFFF0000u); s += x[j * 8 + 2 * q] + x[j * 8 + 2 * q + 1]; } }
      s = wave_sum_dpp(s); const float mu = s * (1.0f / 2048.0f);
      float q2 = 0.f;
#pragma unroll
      for (int j = 0; j < 32; ++j) { const float d = x[j] - mu; q2 += d * d; }
      q2 = wave_sum_dpp(q2);
      if (lane == 0) { st[2 * t] = mu; st[2 * t + 1] = rsqrtf(q2 * (1.0f / 2048.0f) + 1e-6f); }
    }
    __syncthreads();
    for (int g = 0; g < 8; ++g) {
      {
        const int t = tid >> 2, c0 = (tid & 3) * 32;
        const float* src = w_s + ((size_t)g * 128 + t) * 128 + c0;
#pragma unroll
        for (int q = 0; q < 4; ++q) {
          const float4 a = *(const float4*)(src + q * 8), b = *(const float4*)(src + q * 8 + 4);
          const int s0 = c0 + q * 8;
          v4u o;
          o.x = pk2(s0 + 0 <= t ? a.x : 0.f, s0 + 1 <= t ? a.y : 0.f); o.y = pk2(s0 + 2 <= t ? a.z : 0.f, s0 + 3 <= t ? a.w : 0.f);
          o.z = pk2(s0 + 4 <= t ? b.x : 0.f, s0 + 5 <= t ? b.y : 0.f); o.w = pk2(s0 + 6 <= t ? b.z : 0.f, s0 + 7 <= t ? b.w : 0.f);
          *(LAS v4u*)(Wl + t * GA_PITCH + s0) = o;
        }
      }
      {
        const int sh0 = (wave & 1) * 64 + (lane >> 2), cq = (wave >> 1) * 64 + (lane & 3) * 8;
#pragma unroll
        for (int jc = 0; jc < 2; ++jc) {
          const int c0 = cq + jc * 32;
          const float4 ga = *(const float4*)(ln_g + g * 256 + c0), gb = *(const float4*)(ln_g + g * 256 + c0 + 4), ba = *(const float4*)(ln_b + g * 256 + c0), bb = *(const float4*)(ln_b + g * 256 + c0 + 4);
          const float gg[8] = {ga.x, ga.y, ga.z, ga.w, gb.x, gb.y, gb.z, gb.w}, bv[8] = {ba.x, ba.y, ba.z, ba.w, bb.x, bb.y, bb.z, bb.w};
#pragma unroll
          for (int jr = 0; jr < 4; ++jr) {
            const int s = sh0 + jr * 16;
            const float mu = st[2 * s], rs = st[2 * s + 1];
            const v4u w = *(const v4u*)(V + (T0 + s) * 2048 + g * 256 + c0); const unsigned ww[4] = {w.x, w.y, w.z, w.w};
#pragma unroll
            for (int q = 0; q < 4; ++q) {
              const float y0 = (__uint_as_float(ww[q] << 16) - mu) * rs * gg[2 * q] + bv[2 * q];
              const float y1 = (__uint_as_float(ww[q] & 0xFFFF0000u) - mu) * rs * gg[2 * q + 1] + bv[2 * q + 1];
              vT[(c0 + 2 * q) * GA_PITCH + s] = f2bf(y0); vT[(c0 + 2 * q + 1) * GA_PITCH + s] = f2bf(y1);
            }
          }
        }
      }
      __syncthreads();
      f32x4 acc[2][8];
#pragma unroll
      for (int ci = 0; ci < 2; ++ci)
#pragma unroll
        for (int jt = 0; jt < 8; ++jt) acc[ci][jt] = (f32x4){0.f, 0.f, 0.f, 0.f};
      const int fr = lane & 15, fq = lane >> 4;
#pragma unroll
      for (int kb = 0; kb < 4; ++kb) {
        bf16x8_t a[2];
#pragma unroll
        for (int ci = 0; ci < 2; ++ci) a[ci] = *(const LAS bf16x8_t*)(vT + (wave * 32 + ci * 16 + fr) * GA_PITCH + kb * 32 + fq * 8);
#pragma unroll
        for (int jt = 0; jt < 8; ++jt) {
          if (kb <= (jt >> 1)) {
            const bf16x8_t b = *(const LAS bf16x8_t*)(Wl + (jt * 16 + fr) * GA_PITCH + kb * 32 + fq * 8);
#pragma unroll
            for (int ci = 0; ci < 2; ++ci) acc[ci][jt] = __builtin_amdgcn_mfma_f32_16x16x32_bf16(a[ci], b, acc[ci][jt], 0, 0, 0);
          }
        }
      }
#pragma unroll
      for (int jt = 0; jt < 8; ++jt) {
        const int t = jt * 16 + fr; const float bs = b_s[g * 128 + t];
#pragma unroll
        for (int ci = 0; ci < 2; ++ci) {
          bf16_t* up = U + (T0 + t) * 2048 + g * 256 + wave * 32 + ci * 16 + fq * 4;
          const v2u uu = *(const v2u*)up;
          v2u o;
          o.x = pk2(__uint_as_float(uu.x << 16) * (acc[ci][jt][0] + bs), __uint_as_float(uu.x & 0xFFFF0000u) * (acc[ci][jt][1] + bs));
          o.y = pk2(__uint_as_float(uu.y << 16) * (acc[ci][jt][2] + bs), __uint_as_float(uu.y & 0xFFFF0000u) * (acc[ci][jt][3] + bs));
          if (!DRY || acc[ci][jt][0] == 1234.5f) *(v2u*)up = o;
        }
      }
      __syncthreads();
    }
  }
}
constexpr size_t WS_PROJ = WS_BIG;
constexpr size_t WS_QT = WS_BIG + 208 * MiB;
constexpr size_t WS_KT = WS_BIG + 240 * MiB;
constexpr size_t WS_AM = WS_BIG + 272 * MiB;
constexpr size_t WS_DEC = WS_BIG + 288 * MiB;
constexpr size_t WS_O = WS_H;
__device__ __forceinline__ float row16_sum_dpp(float v) {
  int x;
  x = __builtin_amdgcn_mov_dpp(__float_as_int(v), 0xB1, 0xF, 0xF, true); v += __int_as_float(x);
  x = __builtin_amdgcn_mov_dpp(__float_as_int(v), 0x4E, 0xF, 0xF, true); v += __int_as_float(x);
  x = __builtin_amdgcn_mov_dpp(__float_as_int(v), 0x141, 0xF, 0xF, true); v += __int_as_float(x);
  x = __builtin_amdgcn_mov_dpp(__float_as_int(v), 0x140, 0xF, 0xF, true); v += __int_as_float(x);
  return v;
}

__device__ __forceinline__ void phase_gla_prep(const Params& P, LAS unsigned char* lds) {
  const int tid = threadIdx.x, lane = tid & 63, wave = __builtin_amdgcn_readfirstlane(tid >> 6);
  const int fr = lane & 15, fq = lane >> 4;
  const bf16_t* PROJ = (const bf16_t*)(P.ws + WS_PROJ);
  bf16_t* QT = (bf16_t*)(P.ws + WS_QT); bf16_t* KT = (bf16_t*)(P.ws + WS_KT); bf16_t* AM = (bf16_t*)(P.ws + WS_AM); float* DEC = (float*)(P.ws + WS_DEC);
  const float* w_g2 = P.in[12]; const float* b_g = P.in[13];
  LAS bf16_t* ql = (LAS bf16_t*)lds; LAS bf16_t* kl = (LAS bf16_t*)(lds + 17408); LAS float* tot = (LAS float*)(lds + 34816);
  const int kk = tid & 127, tq = wave >> 1;
  const float scale = 0.08838834764831845f;
  for (int item = blockIdx.x; item < 2048; item += gridDim.x) {
    const int h = item & 3; const size_t T0 = (size_t)(item >> 2) * 64;
    bf16_t qraw[16], kraw[16];
#pragma unroll
    for (int i = 0; i < 16; ++i) { const bf16_t* pr = PROJ + (T0 + tq * 16 + i) * BPROJ + h * 128 + kk; qraw[i] = pr[0]; kraw[i] = pr[512]; }
    float wg[16];
#pragma unroll
    for (int j = 0; j < 16; ++j) wg[j] = w_g2[j * 512 + h * 128 + kk];
    const float bg = b_g[h * 128 + kk];
    float G[16]; float run = 0.f;
#pragma unroll
    for (int i = 0; i < 16; ++i) {
      const float* gl = (const float*)(P.ws + WS_GLR) + (T0 + tq * 16 + i) * 16;
      const float4 g0 = *(const float4*)gl, g1 = *(const float4*)(gl + 4), g2 = *(const float4*)(gl + 8), g3 = *(const float4*)(gl + 12);
      const float gw[16] = {g0.x, g0.y, g0.z, g0.w, g1.x, g1.y, g1.z, g1.w, g2.x, g2.y, g2.z, g2.w, g3.x, g3.y, g3.z, g3.w};
      float a = bg;
#pragma unroll
      for (int j = 0; j < 16; ++j) a += gw[j] * wg[j];
      const float ls = fminf(a, 0.f) - log1pf(__expf(-fabsf(a)));
      run += ls * 0.0625f; G[i] = run;
    }
    tot[tq * 128 + kk] = run;
    __syncthreads();
    float off = 0.f, glast = 0.f;
#pragma unroll
    for (int q = 0; q < 4; ++q) { const float v = tot[q * 128 + kk]; off += (q < tq) ? v : 0.f; glast += v; }
    unsigned kh[8];
#pragma unroll
    for (int i = 0; i < 16; ++i) {
      const int t = tq * 16 + i; const float Gi = G[i] + off;
      const float qv = bf2f(qraw[i]) * scale * __expf(Gi);
      const float kv = bf2f(kraw[i]);
      const bf16_t qb = f2bf(qv);
      ql[t * 136 + kk] = qb; kl[t * 136 + kk] = f2bf(kv * __expf(-Gi));
      QT[((size_t)item * 64 + t) * 128 + kk] = qb;
      const unsigned khb = f2bf(kv * __expf(glast - Gi));
      if (i & 1) kh[i >> 1] |= khb << 16; else kh[i >> 1] = khb;
    }
    {
      bf16_t* kt = KT + ((size_t)item * 128 + kk) * 64 + tq * 16;
      v4u o; o.x = kh[0]; o.y = kh[1]; o.z = kh[2]; o.w = kh[3]; *(v4u*)kt = o;
      o.x = kh[4]; o.y = kh[5]; o.z = kh[6]; o.w = kh[7]; *(v4u*)(kt + 8) = o;
    }
    if (tq == 0) DEC[(size_t)item * 128 + kk] = __expf(glast);
    __syncthreads();
#pragma unroll
    for (int u = 0; u < 2; ++u) {
      const int tile = wave * 2 + u, si = tile >> 2, ti = tile & 3;
      f32x4 acc = (f32x4){0.f, 0.f, 0.f, 0.f};
      if (si <= ti) {
#pragma unroll
        for (int ks = 0; ks < 4; ++ks) {
          const bf16x8_t a = *(const LAS bf16x8_t*)(kl + (si * 16 + fr) * 136 + ks * 32 + fq * 8);
          const bf16x8_t b = *(const LAS bf16x8_t*)(ql + (ti * 16 + fr) * 136 + ks * 32 + fq * 8);
          acc = __builtin_amdgcn_mfma_f32_16x16x32_bf16(a, b, acc, 0, 0, 0);
        }
      }
      const int t = ti * 16 + fr, s0 = si * 16 + 4 * fq;
      v2u o;
      o.x = pk2(s0 + 0 <= t ? acc[0] : 0.f, s0 + 1 <= t ? acc[1] : 0.f);
      o.y = pk2(s0 + 2 <= t ? acc[2] : 0.f, s0 + 3 <= t ? acc[3] : 0.f);
      *(v2u*)(AM + ((size_t)item * 64 + t) * 64 + s0) = o;
    }
    __syncthreads();
  }
}

struct GlaFrag { bf16x8_t am[2], q[4], k[2]; f32x4 dec; v4u vr[2]; };
template <int ROLE>
__device__ __forceinline__ void gla_load(GlaFrag& F, const Params& P, int b, int h, int vs, int c, int wave, int lane) {
  const int fr = lane & 15, fq = lane >> 4;
  const size_t item = ((size_t)b * 128 + c) * 4 + h;
  const bf16_t* QT = (const bf16_t*)(P.ws + WS_QT); const bf16_t* KT = (const bf16_t*)(P.ws + WS_KT); const bf16_t* AM = (const bf16_t*)(P.ws + WS_AM); const float* DEC = (const float*)(P.ws + WS_DEC);
  if (ROLE == 0) {
    const bf16_t* ar = AM + (item * 64 + wave * 16 + fr) * 64 + fq * 8;
    F.am[0] = *(const bf16x8_t*)ar; F.am[1] = *(const bf16x8_t*)(ar + 32);
    const bf16_t* qr = QT + (item * 64 + wave * 16 + fr) * 128 + fq * 8;
#pragma unroll
    for (int kq = 0; kq < 4; ++kq) F.q[kq] = *(const bf16x8_t*)(qr + kq * 32);
  }
  const bf16_t* kr = KT + (item * 128 + wave * 16 + fr) * 64 + fq * 8;
  F.k[0] = *(const bf16x8_t*)kr; F.k[1] = *(const bf16x8_t*)(kr + 32);
  F.dec = *(const f32x4*)(DEC + item * 128 + wave * 16 + fq * 4);
  if (ROLE == 1) {
    const bf16_t* vp = (const bf16_t*)(P.ws + WS_PROJ) + ((size_t)b * SEQ + (size_t)c * 64 + lane) * BPROJ + 1024 + h * 256 + vs * 16;
    F.vr[0] = *(const v4u*)vp; F.vr[1] = *(const v4u*)(vp + 8);
  }
}
__device__ __forceinline__ void gla_write_vt(LAS bf16_t* vT, const GlaFrag& F, int lane) {
  const unsigned w[8] = {F.vr[0].x, F.vr[0].y, F.vr[0].z, F.vr[0].w, F.vr[1].x, F.vr[1].y, F.vr[1].z, F.vr[1].w};
#pragma unroll
  for (int i = 0; i < 8; ++i) { vT[(2 * i) * 72 + lane] = (bf16_t)(w[i] & 0xFFFFu); vT[(2 * i + 1) * 72 + lane] = (bf16_t)(w[i] >> 16); }
}
template <int ROLE, int MODE>
__device__ __forceinline__ void gla_step(const Params& P, const GlaFrag& cur, const GlaFrag& nxt, GlaFrag& pre, int b, int h, int vs, int c, int wave, int lane, LAS bf16_t* vT, LAS bf16_t* ST, LAS bf16_t* vTn, LAS bf16_t* STn, f32x4& S) {
  const int fr = lane & 15, fq = lane >> 4;
  bf16_t* O = (bf16_t*)(P.ws + WS_O);
  if (MODE != 2 && ROLE != 0) gla_load<ROLE>(pre, P, b, h, vs, c + 3 < 128 ? c + 3 : 127, wave, lane);
  const bf16x8_t v0 = *(const LAS bf16x8_t*)(vT + fr * 72 + fq * 8), v1 = *(const LAS bf16x8_t*)(vT + fr * 72 + 32 + fq * 8);
  if (ROLE == 0) {
    f32x4 o = (f32x4){0.f, 0.f, 0.f, 0.f};
    o = __builtin_amdgcn_mfma_f32_16x16x32_bf16(v0, cur.am[0], o, 0, 0, 0);
    o = __builtin_amdgcn_mfma_f32_16x16x32_bf16(v1, cur.am[1], o, 0, 0, 0);
#pragma unroll
    for (int kq = 0; kq < 4; ++kq) {
      const bf16x8_t s = *(const LAS bf16x8_t*)(ST + fr * 136 + kq * 32 + fq * 8);
      o = __builtin_amdgcn_mfma_f32_16x16x32_bf16(s, cur.q[kq], o, 0, 0, 0);
    }
    v2u ow; ow.x = pk2(o[0], o[1]); ow.y = pk2(o[2], o[3]);
    if (MODE == 0 || o[0] == 1234.5f) *(v2u*)(O + ((size_t)b * SEQ + (size_t)c * 64 + wave * 16 + fr) * 1024 + h * 256 + vs * 16 + fq * 4) = ow;
  }
  S = S * cur.dec;
  S = __builtin_amdgcn_mfma_f32_16x16x32_bf16(cur.k[0], v0, S, 0, 0, 0);
  S = __builtin_amdgcn_mfma_f32_16x16x32_bf16(cur.k[1], v1, S, 0, 0, 0);
  { v2u sw; sw.x = pk2(S[0], S[1]); sw.y = pk2(S[2], S[3]); *(LAS v2u*)(STn + fr * 136 + wave * 16 + fq * 4) = sw; }
  if (ROLE == 1 && c + 1 < 128) gla_write_vt(vTn, nxt, lane);
  if (MODE != 2 && ROLE == 0) gla_load<ROLE>(pre, P, b, h, vs, c + 3 < 128 ? c + 3 : 127, wave, lane);
  if (MODE != 1) __syncthreads();
}
template <int ROLE, int MODE>
__device__ __forceinline__ void gla_scan_role(const Params& P, LAS unsigned char* lds, int wave, int lane) {
  const int fr = lane & 15, fq = lane >> 4;
  LAS bf16_t* vT0 = (LAS bf16_t*)lds;
  LAS bf16_t* ST0 = (LAS bf16_t*)(lds + 2304);
  LAS bf16_t* vT1 = (LAS bf16_t*)(lds + 6656);
  LAS bf16_t* ST1 = (LAS bf16_t*)(lds + 8960);
  for (int wid = blockIdx.x; wid < 256; wid += gridDim.x) {
    const int xcd = wid & 7, jj = wid >> 3, pair = xcd * 2 + (jj >> 4), vs = jj & 15, b = pair >> 2, h = pair & 3;
    f32x4 S = (f32x4){0.f, 0.f, 0.f, 0.f};
    GlaFrag f0, f1, f2, f3;
    gla_load<ROLE>(f0, P, b, h, vs, 0, wave, lane);
    gla_load<ROLE>(f1, P, b, h, vs, 1, wave, lane);
    gla_load<ROLE>(f2, P, b, h, vs, 2, wave, lane);
    __syncthreads();
    *(LAS v2u*)(ST0 + fr * 136 + wave * 16 + fq * 4) = (v2u){0u, 0u};
    if (ROLE == 1) gla_write_vt(vT0, f0, lane);
    __syncthreads();
    for (int c = 0; c < 128; c += 4) {
      gla_step<ROLE, MODE>(P, f0, f1, f3, b, h, vs, c, wave, lane, vT0, ST0, vT1, ST1, S);
      gla_step<ROLE, MODE>(P, f1, f2, f0, b, h, vs, c + 1, wave, lane, vT1, ST1, vT0, ST0, S);
      gla_step<ROLE, MODE>(P, f2, f3, f1, b, h, vs, c + 2, wave, lane, vT0, ST0, vT1, ST1, S);
      gla_step<ROLE, MODE>(P, f3, f0, f2, b, h, vs, c + 3, wave, lane, vT1, ST1, vT0, ST0, S);
    }
  }
}
template <int MODE = 0>
__device__ __forceinline__ void phase_gla_scan(const Params& P, LAS unsigned char* lds) {
  const int lane = threadIdx.x & 63, wave = __builtin_amdgcn_readfirstlane(threadIdx.x >> 6);
  if (wave < 4) gla_scan_role<0, MODE>(P, lds, wave, lane);
  else if (wave == 4) gla_scan_role<1, MODE>(P, lds, wave, lane);
  else gla_scan_role<2, MODE>(P, lds, wave, lane);
}

struct PostIn { v4u o0, o1, r0, r1; };
__device__ __forceinline__ void gla_post_load(PostIn& x, const Params& P, int tok, int lane) {
  const bf16_t* O = (const bf16_t*)(P.ws + WS_O); const bf16_t* PROJ = (const bf16_t*)(P.ws + WS_PROJ);
  x.o0 = *(const v4u*)(O + (size_t)tok * 1024 + lane * 16); x.o1 = *(const v4u*)(O + (size_t)tok * 1024 + lane * 16 + 8);
  x.r0 = *(const v4u*)(PROJ + (size_t)tok * BPROJ + 2048 + lane * 16); x.r1 = *(const v4u*)(PROJ + (size_t)tok * BPROJ + 2048 + lane * 16 + 8);
}
__device__ __forceinline__ void gla_post_row(const PostIn& in, const Params& P, int tok, int lane, const float (&gn)[16]) {
  const unsigned ow[8] = {in.o0.x, in.o0.y, in.o0.z, in.o0.w, in.o1.x, in.o1.y, in.o1.z, in.o1.w}, rw[8] = {in.r0.x, in.r0.y, in.r0.z, in.r0.w, in.r1.x, in.r1.y, in.r1.z, in.r1.w};
  float x[16], r[16]; float ss = 0.f;
#pragma unroll
  for (int i = 0; i < 8; ++i) { x[2 * i] = __uint_as_float(ow[i] << 16); x[2 * i + 1] = __uint_as_float(ow[i] & 0xFFFF0000u); r[2 * i] = __uint_as_float(rw[i] << 16); r[2 * i + 1] = __uint_as_float(rw[i] & 0xFFFF0000u);
    ss += x[2 * i] * x[2 * i] + x[2 * i + 1] * x[2 * i + 1]; }
  ss = row16_sum_dpp(ss);
  const float rs = rsqrtf(ss * (1.0f / 256.0f) + 1e-6f);
  float y[16];
#pragma unroll
  for (int i = 0; i < 16; ++i) { const float sl = r[i] * __builtin_amdgcn_rcpf(1.0f + __expf(-r[i])); y[i] = x[i] * rs * gn[i] * sl; }
  float am = 0.f;
#pragma unroll
  for (int i = 0; i < 16; ++i) am = fmaxf(am, fabsf(y[i]));
  am = wave_max_dpp(am);
  const float sc = am > 0.f ? am * (1.0f / 127.0f) : 1.0f, inv = 1.0f / sc;
  v4u q;
  q.x = q8(y[0], inv) | (q8(y[1], inv) << 8) | (q8(y[2], inv) << 16) | (q8(y[3], inv) << 24);
  q.y = q8(y[4], inv) | (q8(y[5], inv) << 8) | (q8(y[6], inv) << 16) | (q8(y[7], inv) << 24);
  q.z = q8(y[8], inv) | (q8(y[9], inv) << 8) | (q8(y[10], inv) << 16) | (q8(y[11], inv) << 24);
  q.w = q8(y[12], inv) | (q8(y[13], inv) << 8) | (q8(y[14], inv) << 16) | (q8(y[15], inv) << 24);
  *(v4u*)(P.ws + WS_H8 + (size_t)tok * 1024 + lane * 16) = q;
  if (lane == 0) ((float*)(P.ws + WS_SH))[tok] = sc;
}
__device__ __forceinline__ void phase_gla_post(const Params& P) {
  const int lane = threadIdx.x & 63, wave = __builtin_amdgcn_readfirstlane(threadIdx.x >> 6);
  const int gw = blockIdx.x * 8 + wave, NGW = gridDim.x * 8;
  const float* ng = P.in[14] + (lane & 15) * 16;
  float gn[16];
#pragma unroll
  for (int q = 0; q < 4; ++q) { const float4 g4 = *(const float4*)(ng + q * 4); gn[q * 4] = g4.x; gn[q * 4 + 1] = g4.y; gn[q * 4 + 2] = g4.z; gn[q * 4 + 3] = g4.w; }
  PostIn a, b, c, d;
  for (int tok = gw; tok < TOK; tok += 4 * NGW) {
    const bool vb = tok + NGW < TOK, vc = tok + 2 * NGW < TOK, vd = tok + 3 * NGW < TOK;
    gla_post_load(a, P, tok, lane);
    if (vb) gla_post_load(b, P, tok + NGW, lane);
    if (vc) gla_post_load(c, P, tok + 2 * NGW, lane);
    if (vd) gla_post_load(d, P, tok + 3 * NGW, lane);
    gla_post_row(a, P, tok, lane, gn);
    if (vb) gla_post_row(b, P, tok + NGW, lane, gn);
    if (vc) gla_post_row(c, P, tok + 2 * NGW, lane, gn);
    if (vd) gla_post_row(d, P, tok + 3 * NGW, lane, gn);
  }
}
__device__ __forceinline__ void transpose_item(const float* W, int K, int N, bf16_t* WT, LAS float* scr, int item, int nblk, int lane) {
  const int kb = item / nblk, nb = item % nblk, k0 = 64 * kb, n0 = 32 * nb;
  const int nn = n0 + (lane & 31);
#pragma unroll 8
  for (int i = 0; i < 32; ++i) { const int kk = 2 * i + (lane >> 5); scr[kk * 33 + (lane & 31)] = (nn < N) ? W[(size_t)(k0 + kk) * N + nn] : 0.f; }
  asm volatile("s_waitcnt lgkmcnt(0)" ::: "memory");
  const int c = lane & 7;
#pragma unroll
  for (int j = 0; j < 4; ++j) { const int n = (lane >> 3) + 8 * j; const LAS float* s = scr + (8 * c) * 33 + n;
    v4u o; o.x = pk2(s[0 * 33], s[1 * 33]); o.y = pk2(s[2 * 33], s[3 * 33]); o.z = pk2(s[4 * 33], s[5 * 33]); o.w = pk2(s[6 * 33], s[7 * 33]);
    *(v4u*)(WT + (size_t)(n0 + n) * K + k0 + 8 * c) = o; }
  asm volatile("s_waitcnt lgkmcnt(0)" ::: "memory");
}

__device__ __forceinline__ void phase_prep(const Params& P, LAS unsigned char* lds) {
  const int lane = threadIdx.x & 63, wave = __builtin_amdgcn_readfirstlane(threadIdx.x >> 6);
  LAS float* scr = (LAS float*)(lds + wave * 16384);
  const int gw = blockIdx.x * 8 + wave, NGW = gridDim.x * 8;
  unsigned char* ws = P.ws;
  constexpr int I_AIN = (1024 / 64) * (4096 / 32), I_AOUT = (2048 / 64) * (1024 / 32), I_BIN = (1024 / 64) * (BPROJ / 32), I_BOUT = (1024 / 64) * (1024 / 32), I_FOLD = 2048;
  constexpr int NITEMS = I_AIN + I_AOUT + I_BIN + I_BOUT + I_FOLD;
  for (int it = gw; it < NITEMS; it += NGW) {
    int r = it;
    if (r < I_AIN) { transpose_item(P.in[4], 1024, 4096, (bf16_t*)(ws + WS_WA_IN), scr, r, 4096 / 32, lane); continue; } r -= I_AIN;
    if (r < I_AOUT) { transpose_item(P.in[10], 2048, 1024, (bf16_t*)(ws + WS_WA_OUT), scr, r, 1024 / 32, lane); continue; } r -= I_AOUT;
    if (r < I_BIN) { transpose_item(P.in[11], 1024, 3088, (bf16_t*)(ws + WS_WB_IN), scr, r, BPROJ / 32, lane); continue; } r -= I_BIN;
    if (r < I_BOUT) { transpose_item(P.in[15], 1024, 1024, (bf16_t*)(ws + WS_WB_OUT), scr, r, 1024 / 32, lane); continue; } r -= I_BOUT;
    fold_item(P, r, lane, scr);
  }
}

template <int MODE>
__device__ __forceinline__ void phase_gemm(const Params& P, LAS unsigned char* lds, int layer) {
  unsigned char* ws = P.ws;
  const bf16_t* H = (const bf16_t*)(ws + WS_H);
  if constexpr (MODE == 0) {
    pg8::Gemm g{(const bf16_t*)(ws + WS_H8), (const bf16_t*)(ws + WS_WA_IN8), TOK, 4096, 512}; pg8::StaticOrder S; S.init(TOK, 4096, gridDim.x, blockIdx.x);
    pg8::EpiBf16I8<1> E{(bf16_t*)(ws + WS_BIG), 2048, P.in[5], 2048, (size_t)TOK * 2048, (const float*)(ws + WS_SH), (const float*)(ws + WS_SA_IN)};
    pg8::gemm_phase<pg8::EpiBf16I8<1>, pg8::StaticOrder, true, true, true>(lds, g, S, E);
  } else if constexpr (MODE == 1) {
    pg8::Gemm g{(const bf16_t*)(ws + WS_BIG), (const bf16_t*)(ws + WS_WA_OUT), TOK, 1024, 2048}; pg8::StaticOrder S; S.init(TOK, 1024, gridDim.x, blockIdx.x);
    pg8::EpiResBf16 E{(bf16_t*)P.out, P.in[0], 1024};
    pg8::gemm_phase<pg8::EpiResBf16, pg8::StaticOrder, true, true>(lds, g, S, E);
  } else if constexpr (MODE == 2) {
    pg8::Gemm g{H, (const bf16_t*)(ws + WS_WP) + (size_t)layer * 2048 * 1024, TOK, 2048, 1024}; pg8::StaticOrder S; S.init(TOK, 2048, gridDim.x, blockIdx.x);
    pg8::EpiF16 E{(_Float16*)(ws + WS_BIG), 2048};
    pg8::gemm_phase<pg8::EpiF16, pg8::StaticOrder, true, true>(lds, g, S, E);
  } else if constexpr (MODE == 3) {
    pg8::Gemm g{(const bf16_t*)(ws + WS_H8), (const bf16_t*)(ws + WS_WB_IN8), TOK, 3072, 512}; pg8::StaticOrder S; S.init(TOK, 3072, gridDim.x, blockIdx.x);
    pg8::EpiBf16I8<0> E{(bf16_t*)(ws + WS_BIG), BPROJ, nullptr, 0, 0, (const float*)(ws + WS_SH), (const float*)(ws + WS_SB_IN)};
    pg8::gemm_phase<pg8::EpiBf16I8<0>, pg8::StaticOrder, true, true, true>(lds, g, S, E);
  } else {
    pg8::Gemm g{(const bf16_t*)(ws + WS_H8), (const bf16_t*)(ws + WS_WB_OUT8), TOK, 1024, 512}; pg8::StaticOrder S; S.init(TOK, 1024, gridDim.x, blockIdx.x);
    pg8::EpiResBf16I8 E{(bf16_t*)P.out, (const float*)(ws + WS_SH), (const float*)(ws + WS_SB_OUT), 1024};
    pg8::gemm_phase<pg8::EpiResBf16I8, pg8::StaticOrder, true, true, true>(lds, g, S, E);
  }
}

#define RLX_AGENT __ATOMIC_RELAXED, __HIP_MEMORY_SCOPE_AGENT
#define XB_TMO      128
#define XB_XCNT(j)  (256  + 64 * (j))
#define XB_XSUB(j)  (1280 + 64 * (j))
#define XB_XGEN(j)  (2304 + 64 * (j))
#define XB_TOP      3328
#define XB_TOPGEN   3392
#define XCD_BAR_WORDS 3456
#define XB_SPIN_CAP (1u << 18)

__device__ __forceinline__ unsigned xb_ld(unsigned* p)              { return __hip_atomic_load(p, __ATOMIC_RELAXED, __HIP_MEMORY_SCOPE_AGENT); }
__device__ __forceinline__ unsigned xb_add(unsigned* p, unsigned v) { return __hip_atomic_fetch_add(p, v, __ATOMIC_RELAXED, __HIP_MEMORY_SCOPE_AGENT); }
__device__ __forceinline__ unsigned xb_xcc_id() { return (unsigned)__builtin_amdgcn_s_getreg((3 << 11) | 20) & 0xFu; }
#define XB_SPIN(cond, bar) do { unsigned _sp = 0; while (cond) { __builtin_amdgcn_s_sleep(1); \
    if ((++_sp & 255u) == 0u) { if (xb_ld(&(bar)[XB_TMO])) break; if (_sp > XB_SPIN_CAP) { atomicAdd(&(bar)[XB_TMO], 1u); break; } } } } while (0)

struct XcdBarrier {
    unsigned* bar; unsigned x;
    volatile LAS unsigned* st;
};

__device__ __forceinline__ XcdBarrier xcd_barrier_post(unsigned* bar, volatile LAS unsigned* st) {
    XcdBarrier b; b.bar = bar; b.x = xb_xcc_id(); b.st = st;
    if (threadIdx.x == 0) (void)xb_add(&bar[XB_XCNT(b.x)], 1u);
    return b;
}
__device__ __forceinline__ void xcd_barrier_complete(unsigned* bar, unsigned x, unsigned& nloc, unsigned& nx) {
    const unsigned G = gridDim.x * gridDim.y * gridDim.z;
    unsigned sum, cnt, mine, sp = 0u;
    for (;;) {
        sum = 0u; cnt = 0u; mine = 0u;
#pragma unroll
        for (unsigned j = 0; j < 16; ++j) { const unsigned c = xb_ld(&bar[XB_XCNT(j)]); sum += c; cnt += (c > 0u) ? 1u : 0u; mine = (j == x) ? c : mine; }
        if (sum == G) break;
        __builtin_amdgcn_s_sleep(1);
        if ((++sp & 255u) == 0u) { if (xb_ld(&bar[XB_TMO])) break; if (sp > XB_SPIN_CAP) { atomicAdd(&bar[XB_TMO], 1u); break; } }
    }
    nloc = mine > 0u ? mine : 1u; nx = cnt > 0u ? cnt : 1u;
}

__device__ __forceinline__ void xcd_barrier(const XcdBarrier& b) {
    asm volatile("s_waitcnt vmcnt(0)" ::: "memory");
    __syncthreads();
    if (threadIdx.x == 0) {
        unsigned* bar = b.bar;
        __builtin_amdgcn_s_waitcnt(0);
        unsigned nloc = b.st[0], nx = b.st[1];
        if (nloc == 0u) { xcd_barrier_complete(bar, b.x, nloc, nx); b.st[0] = nloc; b.st[1] = nx; }
        const unsigned old = xb_add(&bar[XB_XSUB(b.x)], 1u);
        const unsigned gen = old / nloc;
        if (old + 1u == (gen + 1u) * nloc) {
            __builtin_amdgcn_fence(__ATOMIC_RELEASE, "agent");
            asm volatile("s_waitcnt vmcnt(0)" ::: "memory");
            const unsigned og = xb_add(&bar[XB_TOP], 1u);
            const unsigned tg = og / nx;
            if (og + 1u == (tg + 1u) * nx) xb_add(&bar[XB_TOPGEN], 1u);
            else XB_SPIN(xb_ld(&bar[XB_TOPGEN]) == tg, bar);
            __builtin_amdgcn_fence(__ATOMIC_ACQUIRE, "agent");
            xb_add(&bar[XB_XGEN(b.x)], 1u);
            asm volatile("s_waitcnt vmcnt(0)" ::: "memory");
        } else {
            XB_SPIN(xb_ld(&bar[XB_XGEN(b.x)]) == gen, bar);
            __builtin_amdgcn_fence(__ATOMIC_ACQUIRE, "agent");
            asm volatile("s_waitcnt vmcnt(0)" ::: "memory");
        }
    }
    __syncthreads();
}


__device__ __forceinline__ void phase_glr(const Params& P) {
  typedef int i32x4_t __attribute__((ext_vector_type(4)));
  const int lane = threadIdx.x & 63, wave = __builtin_amdgcn_readfirstlane(threadIdx.x >> 6), fr = lane & 15, fq = lane >> 4;
  const unsigned char* H8 = P.ws + WS_H8; const unsigned char* WT = P.ws + WS_WB_IN8 + (size_t)3072 * 1024;
  const float* SH = (const float*)(P.ws + WS_SH); const float* SB = (const float*)(P.ws + WS_SB_IN) + 3072;
  float* GLR = (float*)(P.ws + WS_GLR);
  for (int job = blockIdx.x * 8 + wave; job < TOK / 16; job += gridDim.x * 8) {
    const unsigned char* ar = H8 + ((size_t)job * 16 + fr) * 1024 + fq * 16; const unsigned char* br = WT + (size_t)fr * 1024 + fq * 16;
    i32x4_t acc = (i32x4_t){0, 0, 0, 0};
#pragma unroll 8
    for (int ks = 0; ks < 16; ++ks) acc = __builtin_amdgcn_mfma_i32_16x16x64_i8(*(const i32x4_t*)(ar + ks * 64), *(const i32x4_t*)(br + ks * 64), acc, 0, 0, 0);
    const float sb = SB[fr];
#pragma unroll
    for (int r = 0; r < 4; ++r) { const size_t tk = (size_t)job * 16 + 4 * fq + r; GLR[tk * 16 + fr] = (float)acc[r] * (SH[tk] * sb); }
  }
}

template <bool EMIT8, bool WRITE_H = true>
__device__ __forceinline__ void rmsnorm_row(const Params& P, int tok, float4 (&x)[4], const float4 (&gg)[4], int lane) {
  bf16_t* H = (bf16_t*)(P.ws + WS_H);
  float ss = 0.f;
#pragma unroll
  for (int i = 0; i < 4; ++i) ss += x[i].x * x[i].x + x[i].y * x[i].y + x[i].z * x[i].z + x[i].w * x[i].w;
  ss = wave_sum_dpp(ss);
  const float rs = rsqrtf(ss * (1.0f / 1024.0f) + 1e-6f);
  float am = 0.f; unsigned hb[8];
#pragma unroll
  for (int i = 0; i < 4; ++i) {
    x[i].x *= rs * gg[i].x; x[i].y *= rs * gg[i].y; x[i].z *= rs * gg[i].z; x[i].w *= rs * gg[i].w;
    hb[2 * i] = pk2(x[i].x, x[i].y); hb[2 * i + 1] = pk2(x[i].z, x[i].w);
    if (WRITE_H) { v2u o; o.x = hb[2 * i]; o.y = hb[2 * i + 1]; *(v2u*)(H + (size_t)tok * 1024 + i * 256 + lane * 4) = o; }
  }
  if (EMIT8) {
    float hv[16];
#pragma unroll
    for (int i = 0; i < 8; ++i) { hv[2 * i] = __uint_as_float(hb[i] << 16); hv[2 * i + 1] = __uint_as_float(hb[i] & 0xFFFF0000u); am = fmaxf(am, fmaxf(fabsf(hv[2 * i]), fabsf(hv[2 * i + 1]))); }
    am = wave_max_dpp(am);
    const float sh = am > 0.f ? am * (1.0f / 127.0f) : 1.0f, hinv = 1.0f / sh;
    v4u q;
    q.x = q8(hv[0], hinv) | (q8(hv[1], hinv) << 8) | (q8(hv[2], hinv) << 16) | (q8(hv[3], hinv) << 24);
    q.y = q8(hv[4], hinv) | (q8(hv[5], hinv) << 8) | (q8(hv[6], hinv) << 16) | (q8(hv[7], hinv) << 24);
    q.z = q8(hv[8], hinv) | (q8(hv[9], hinv) << 8) | (q8(hv[10], hinv) << 16) | (q8(hv[11], hinv) << 24);
    q.w = q8(hv[12], hinv) | (q8(hv[13], hinv) << 8) | (q8(hv[14], hinv) << 16) | (q8(hv[15], hinv) << 24);
    *(v4u*)(P.ws + WS_H8 + (size_t)tok * 1024 + lane * 16) = q;
    if (lane == 0) ((float*)(P.ws + WS_SH))[tok] = sh;
  }
}
template <bool SRC16>
__device__ __forceinline__ void rmsnorm_ld(float4 (&x)[4], const void* src, int tok, int lane) {
#pragma unroll
  for (int i = 0; i < 4; ++i) {
    if (SRC16) { const v2u w = *(const v2u*)((const bf16_t*)src + (size_t)tok * 1024 + i * 256 + lane * 4);
      x[i].x = __uint_as_float(w.x << 16); x[i].y = __uint_as_float(w.x & 0xFFFF0000u); x[i].z = __uint_as_float(w.y << 16); x[i].w = __uint_as_float(w.y & 0xFFFF0000u); }
    else x[i] = *(const float4*)((const float*)src + (size_t)tok * 1024 + i * 256 + lane * 4);
  }
}
template <bool EMIT8, bool WRITE_H = true, bool SRC16 = true>
__device__ __forceinline__ void phase_rmsnorm(const Params& P, const void* src, const float* g) {
  const int lane = threadIdx.x & 63, wave = __builtin_amdgcn_readfirstlane(threadIdx.x >> 6);
  const int gw = blockIdx.x * 8 + wave, NGW = gridDim.x * 8;
  float4 gg[4];
#pragma unroll
  for (int i = 0; i < 4; ++i) gg[i] = *(const float4*)(g + i * 256 + lane * 4);
  float4 xa[4], xb[4], xc[4], xd[4];
  for (int tok = gw; tok < TOK; tok += 4 * NGW) {
    const bool vb = tok + NGW < TOK, vc = tok + 2 * NGW < TOK, vd = tok + 3 * NGW < TOK;
    rmsnorm_ld<SRC16>(xa, src, tok, lane);
    if (vb) rmsnorm_ld<SRC16>(xb, src, tok + NGW, lane);
    if (vc) rmsnorm_ld<SRC16>(xc, src, tok + 2 * NGW, lane);
    if (vd) rmsnorm_ld<SRC16>(xd, src, tok + 3 * NGW, lane);
    rmsnorm_row<EMIT8, WRITE_H>(P, tok, xa, gg, lane);
    if (vb) rmsnorm_row<EMIT8, WRITE_H>(P, tok + NGW, xb, gg, lane);
    if (vc) rmsnorm_row<EMIT8, WRITE_H>(P, tok + 2 * NGW, xc, gg, lane);
    if (vd) rmsnorm_row<EMIT8, WRITE_H>(P, tok + 3 * NGW, xd, gg, lane);
  }
}

__device__ __forceinline__ void w8_rows(const Params& P, const bf16_t* src0, unsigned char* dst0, float* sc0, int rows, int lane, int gw, int NGW) {
  for (int r = gw; r < rows; r += NGW) {
    const bf16_t* src = src0 + (size_t)r * 1024;
    float hv[16]; float am = 0.f;
#pragma unroll
    for (int i = 0; i < 4; ++i) { const v2u w = *(const v2u*)(src + i * 256 + lane * 4);
      hv[4 * i] = __uint_as_float(w.x << 16); hv[4 * i + 1] = __uint_as_float(w.x & 0xFFFF0000u); hv[4 * i + 2] = __uint_as_float(w.y << 16); hv[4 * i + 3] = __uint_as_float(w.y & 0xFFFF0000u);
      am = fmaxf(am, fmaxf(fmaxf(fabsf(hv[4 * i]), fabsf(hv[4 * i + 1])), fmaxf(fabsf(hv[4 * i + 2]), fabsf(hv[4 * i + 3])))); }
    am = wave_max_dpp(am);
    const float sc = am > 0.f ? am * (1.0f / 127.0f) : 1.0f, inv = 1.0f / sc;
    v4u q;
    q.x = q8(hv[0], inv) | (q8(hv[1], inv) << 8) | (q8(hv[2], inv) << 16) | (q8(hv[3], inv) << 24);
    q.y = q8(hv[4], inv) | (q8(hv[5], inv) << 8) | (q8(hv[6], inv) << 16) | (q8(hv[7], inv) << 24);
    q.z = q8(hv[8], inv) | (q8(hv[9], inv) << 8) | (q8(hv[10], inv) << 16) | (q8(hv[11], inv) << 24);
    q.w = q8(hv[12], inv) | (q8(hv[13], inv) << 8) | (q8(hv[14], inv) << 16) | (q8(hv[15], inv) << 24);
    *(v4u*)(dst0 + (size_t)r * 1024 + lane * 16) = q;
    if (lane == 0) sc0[r] = sc;
  }
}
__device__ __forceinline__ void phase_w8(const Params& P) {
  const int lane = threadIdx.x & 63, wave = __builtin_amdgcn_readfirstlane(threadIdx.x >> 6);
  const int gw = blockIdx.x * 8 + wave, NGW = gridDim.x * 8;
  w8_rows(P, (const bf16_t*)(P.ws + WS_WA_IN), P.ws + WS_WA_IN8, (float*)(P.ws + WS_SA_IN), 4096, lane, gw, NGW);
  w8_rows(P, (const bf16_t*)(P.ws + WS_WB_IN), P.ws + WS_WB_IN8, (float*)(P.ws + WS_SB_IN), BPROJ, lane, gw, NGW);
  for (int r = gw; r < 1024; r += NGW) {
    const bf16_t* src = (const bf16_t*)(P.ws + WS_WB_OUT) + (size_t)r * 1024 + lane * 16;
    const v4u w0 = *(const v4u*)src, w1 = *(const v4u*)(src + 8); const unsigned ww[8] = {w0.x, w0.y, w0.z, w0.w, w1.x, w1.y, w1.z, w1.w};
    float hv[16]; float am = 0.f;
#pragma unroll
    for (int i = 0; i < 8; ++i) { hv[2 * i] = __uint_as_float(ww[i] << 16); hv[2 * i + 1] = __uint_as_float(ww[i] & 0xFFFF0000u); am = fmaxf(am, fmaxf(fabsf(hv[2 * i]), fabsf(hv[2 * i + 1]))); }
    am = wave_max_dpp(am);
    const float sc = am > 0.f ? am * (1.0f / 127.0f) : 1.0f, inv = 1.0f / sc;
    v4u q;
    q.x = q8(hv[0], inv) | (q8(hv[1], inv) << 8) | (q8(hv[2], inv) << 16) | (q8(hv[3], inv) << 24);
    q.y = q8(hv[4], inv) | (q8(hv[5], inv) << 8) | (q8(hv[6], inv) << 16) | (q8(hv[7], inv) << 24);
    q.z = q8(hv[8], inv) | (q8(hv[9], inv) << 8) | (q8(hv[10], inv) << 16) | (q8(hv[11], inv) << 24);
    q.w = q8(hv[12], inv) | (q8(hv[13], inv) << 8) | (q8(hv[14], inv) << 16) | (q8(hv[15], inv) << 24);
    *(v4u*)(P.ws + WS_WB_OUT8 + (size_t)r * 1024 + lane * 16) = q;
    if (lane == 0) ((float*)(P.ws + WS_SB_OUT))[r] = sc;
  }
}

#ifndef PROBE
#define PROBE 0
#endif
__global__ void __launch_bounds__(512, 2) mega_fwd(Params P) {
  extern __shared__ __attribute__((aligned(16))) unsigned char lds_raw[];
  LAS unsigned char* lds = (LAS unsigned char*)lds_raw;
  cg::grid_group grid = cg::this_grid();
  volatile LAS unsigned* bst = (volatile LAS unsigned*)(lds + 131072 + 64);
  if (threadIdx.x == 0) { bst[0] = 0u; bst[1] = 0u; }
  __syncthreads();
  const XcdBarrier bar = xcd_barrier_post((unsigned*)(P.ws + WS_BAR), bst);
#define SEAM() do { xcd_barrier(bar); } while (0)
#if PROBE & 32
  phase_prep(P, lds); phase_tabconv8(P); phase_rmsnorm<true, false, false>(P, P.in[0], P.in[1]);
#endif
  phase_prep(P, lds); phase_tabconv8(P); phase_rmsnorm<true, false, false>(P, P.in[0], P.in[1]);
  grid.sync();
#if PROBE & 8
  phase_gemm<0>(P, lds, 0);
#endif
  phase_w8(P);
  SEAM();
  phase_gemm<0>(P, lds, 0);
  SEAM();
#if PROBE & 262144
  SEAM(); SEAM(); SEAM(); SEAM(); SEAM(); SEAM(); SEAM(); SEAM(); SEAM(); SEAM();
#endif
#if PROBE & 4
  phase_gate_a<true>(P, lds);
#endif
  phase_gate_a<false>(P, lds);
  SEAM();
#if PROBE & 8
  phase_gemm<1>(P, lds, 0);
#endif
  phase_gemm<1>(P, lds, 0);
  SEAM();
#if PROBE & 65536
  phase_rmsnorm<true>(P, P.out, P.in[2]);
#endif
  phase_rmsnorm<true>(P, P.out, P.in[2]);
  SEAM();
#if PROBE & 8
  phase_gemm<2>(P, lds, 0);
#endif
  phase_gemm<2>(P, lds, 0);
  SEAM();
#if PROBE & 16
  phase_topk(P, lds, 0);
#endif
  phase_topk(P, lds, 0);
  SEAM();
  phase_uslice<false>(P, lds, 0);
  SEAM();
  phase_ureduce(P);
  SEAM();
#if PROBE & 1
  phase_vslice<true>(P, lds, 0); SEAM();
#endif
#if PROBE & 256
  phase_uslice<true>(P, lds, 0); SEAM();
#endif
  phase_vslice<false>(P, lds, 0);
  SEAM();
  phase_rmsnorm<true, false>(P, P.out, P.in[1] + 1024);
  SEAM();
#if PROBE & 8
  phase_gemm<3>(P, lds, 0);
#endif
  phase_gemm<3>(P, lds, 0); phase_glr(P);
  SEAM();
#if PROBE & 4098
  phase_gla_prep(P, lds);
#endif
  phase_gla_prep(P, lds);
  SEAM();
#if PROBE & 8194
  phase_gla_scan<3>(P, lds); __syncthreads();
#endif
#if PROBE & 16384
  phase_gla_scan<1>(P, lds); __syncthreads();
#endif
#if PROBE & 32768
  phase_gla_scan<2>(P, lds); __syncthreads();
#endif
  phase_gla_scan(P, lds);
  SEAM();
#if PROBE & 64
  phase_gla_post(P);
#endif
  phase_gla_post(P);
  SEAM();
  phase_gemm<4>(P, lds, 0);
  SEAM();
#if PROBE & 65536
  phase_rmsnorm<true>(P, P.out, P.in[2] + 1024);
#endif
  phase_rmsnorm<true>(P, P.out, P.in[2] + 1024);
  SEAM();
#if PROBE & 131072
  phase_gemm<2>(P, lds, 1);
#endif
  phase_gemm<2>(P, lds, 1);
  SEAM();
#if PROBE & 16
  phase_topk(P, lds, 1);
#endif
  phase_topk(P, lds, 1);
  SEAM();
  phase_uslice<false>(P, lds, 1);
  SEAM();
  phase_ureduce(P);
  SEAM();
#if PROBE & 1
  phase_vslice<true>(P, lds, 1); SEAM();
#endif
  phase_vslice<false>(P, lds, 1);
  SEAM();
  phase_final_norm(P, P.in[3]);
#undef SEAM
}

extern "C" void kernel_launch(void* const* d_in, const int* in_sizes, int n_in, void* d_out, int out_size, void* d_ws, size_t ws_size, hipStream_t stream) {
  static int grid = 0;
  if (grid == 0) {
    int dev = 0, cus = 0, per_cu = 0;
    if (hipGetDevice(&dev) != hipSuccess || hipDeviceGetAttribute(&cus, hipDeviceAttributeMultiprocessorCount, dev) != hipSuccess) { fprintf(stderr, "kernel_launch: device query failed\n"); grid = -1; return; }
    if (hipFuncSetAttribute((const void*)mega_fwd, hipFuncAttributeMaxDynamicSharedMemorySize, LDS_BYTES) != hipSuccess) { fprintf(stderr, "kernel_launch: hipFuncSetAttribute failed\n"); grid = -1; return; }
    if (hipOccupancyMaxActiveBlocksPerMultiprocessor(&per_cu, (const void*)mega_fwd, 512, LDS_BYTES) != hipSuccess || per_cu < 1) { fprintf(stderr, "kernel_launch: occupancy query gave %d\n", per_cu); grid = -1; return; }
    grid = cus * per_cu;
    if (grid > 256) grid = 256;
    fprintf(stderr, "kernel_launch: cus %d per_cu %d grid %d ws %zu\n", cus, per_cu, grid, ws_size);
  }
  if (grid < 0) return;
  (void)hipMemsetAsync((char*)d_ws + WS_BAR, 0, XCD_BAR_WORDS * 4, stream);
  Params P{};
  for (int i = 0; i < 21; ++i) P.in[i] = (const float*)d_in[i];
  P.out = (float*)d_out; P.ws = (unsigned char*)d_ws;
  void* args[] = {&P};
  hipError_t e = hipLaunchCooperativeKernel((const void*)mega_fwd, dim3(grid), dim3(512), args, LDS_BYTES, stream);
  if (e != hipSuccess) fprintf(stderr, "kernel_launch: cooperative launch failed: %s (grid %d)\n", hipGetErrorString(e), grid);
}
```

```cpp
#include <hip/hip_runtime.h>
#include <cstdio>
#include <cstdint>
#include <hip/hip_cooperative_groups.h>
namespace cg = cooperative_groups;
#define PROBE 0
#define VS_VAR 0
namespace pg8 {
#define PG8_LAS __attribute__((address_space(3)))
typedef unsigned short bf16_t;
typedef short bf16x8 __attribute__((ext_vector_type(8)));
typedef float f32x4 __attribute__((ext_vector_type(4)));
typedef unsigned u32x4 __attribute__((ext_vector_type(4)));
constexpr int BM = 256, BK = 64, HALF = 128, HTB = HALF * BK * 2  , STAGE_BYTES = 8 * HTB, NXCD = 8, WGM = 8;

__host__ __device__ __forceinline__ int lds_byte(int r, int c) { const int st = (r >> 4) * 2 + (c >> 5), rr = r & 15, cc = c & 31, ob = rr * 64 + cc * 2; return st * 1024 + (ob ^ (((ob >> 9) & 1) << 5)); }
__host__ __device__ __forceinline__ void stage_rc(int b, int& R, int& C) { const int st = b / 1024, sb = b % 1024, swz = sb ^ (((sb >> 9) & 1) << 5); R = (st >> 1) * 16 + swz / 64; C = (st & 1) * 32 + (swz % 64) / 2; }
__host__ __device__ __forceinline__ int perm32(int rho) { const int n = rho >> 4, i = rho & 15; return 8 * (i >> 2) + 4 * n + (i & 3); }

struct Unit { int pm, pn; };
struct Gemm { const bf16_t* A; const bf16_t* Bt; int M, N, K; };

struct StaticOrder {
    int nM, nN, nwg, G, c;
    __host__ __device__ void init(int M, int N, int G_, int c_) { nM = M / BM; nN = N / BM; nwg = nM * nN; G = G_; c = c_; }
    __host__ __device__ bool next(int i, Unit& u) const {
        const long L = (long)i * G + c; if (L >= nwg) return false;
        int wgid = (int)L; { const int q = nwg / NXCD, r = nwg % NXCD, xcd = wgid % NXCD, off = wgid / NXCD; wgid = (xcd < r ? xcd * (q + 1) : r * (q + 1) + (xcd - r) * q) + off; }
        const int nig = WGM * nN, gid = wgid / nig, fm = gid * WGM, gsz = (nM - fm) < WGM ? (nM - fm) : WGM;
        u.pm = fm + ((wgid % nig) % gsz); u.pn = (wgid % nig) / gsz; return true;
    }
    __device__ __forceinline__ void a_ready(const Unit&) const {}
    __device__ __forceinline__ void done(const Unit&) const {}
};

__device__ __forceinline__ unsigned cvt_pk_bf16(float lo, float hi) { unsigned r; asm volatile("v_cvt_pk_bf16_f32 %0, %1, %2" : "=v"(r) : "v"(lo), "v"(hi)); return r; }
typedef float f32x2 __attribute__((ext_vector_type(2)));
__device__ __forceinline__ f32x2 gelu_pk(f32x2 v) {
    f32x2 z; z.x = __builtin_amdgcn_fmed3f(v.x, -4.0f, 4.0f); z.y = __builtin_amdgcn_fmed3f(v.y, -4.0f, 4.0f);
    const f32x2 t = z * z;
    f32x2 q = t * (-1.580782615917542e-09f) + 1.2171089736057183e-07f; q = q * t + (-4.100861588085536e-06f); q = q * t + 8.06673415354453e-05f; q = q * t + (-0.0010482040233910084f);
    q = q * t + 0.009664873592555523f; q = q * t + (-0.06617537885904312f); q = q * t + 0.3988475203514099f;
    const f32x2 r = z * q + 0.5f;
    return v * r;
}

template <int ACT  > struct EpiBf16 {
    static constexpr bool PERM = true, AFTER_DRAIN = false; static_assert(ACT == 0 || ACT == 1, "EpiBf16: ACT is 0 (none) or 1 (gelu_pk)");
    bf16_t* O; int ldc; const float* bias; int split_cols; size_t split_stride; float scale0;
    __device__ __forceinline__ void operator()(const f32x4 (&acc)[2][2][4][2], const Unit& u, int wr, int wc, int fr, int fq) const {
        const int row0 = u.pm * BM + wr * 64 + fr; int colt = u.pn * BM; bf16_t* base = O;
        float sc = 1.f; if (split_cols) { const int t = colt / split_cols; base += (size_t)t * split_stride; colt -= t * split_cols; if (t == 0) sc = scale0; }
        const int col0 = colt + wc * 32 + 8 * fq, bcol0 = u.pn * BM + wc * 32 + 8 * fq;
        f32x4 bv[2][2];
#pragma unroll
        for (int bj = 0; bj < 2; ++bj)
#pragma unroll
            for (int n = 0; n < 2; ++n) bv[bj][n] = bias ? *(const f32x4*)(bias + bcol0 + bj * HALF + 4 * n) : (f32x4){0.f, 0.f, 0.f, 0.f};
#pragma unroll
        for (int ai = 0; ai < 2; ++ai)
#pragma unroll
            for (int m = 0; m < 4; ++m) { bf16_t* rowp = base + (size_t)(row0 + ai * HALF + m * 16) * ldc + col0;
#pragma unroll
                for (int bj = 0; bj < 2; ++bj) { f32x4 v0 = acc[ai][bj][m][0] + bv[bj][0], v1 = acc[ai][bj][m][1] + bv[bj][1];
                    if (ACT == 1) { f32x2 a = gelu_pk((f32x2){v0[0], v0[1]}), b = gelu_pk((f32x2){v0[2], v0[3]}), c = gelu_pk((f32x2){v1[0], v1[1]}), d = gelu_pk((f32x2){v1[2], v1[3]});
                        v0 = (f32x4){a.x, a.y, b.x, b.y}; v1 = (f32x4){c.x, c.y, d.x, d.y}; }
                    v0 = v0 * sc; v1 = v1 * sc; u32x4 w; w.x = cvt_pk_bf16(v0[0], v0[1]); w.y = cvt_pk_bf16(v0[2], v0[3]); w.z = cvt_pk_bf16(v1[0], v1[1]); w.w = cvt_pk_bf16(v1[2], v1[3]);
                    *(u32x4*)(rowp + bj * HALF) = w; } }
    }
};

struct EpiResF32 {
    static constexpr bool PERM = false, AFTER_DRAIN = false;
    float* C; const float* R; int ldc;
    __device__ __forceinline__ void operator()(const f32x4 (&acc)[2][2][4][2], const Unit& u, int wr, int wc, int fr, int fq) const {
        const int row0 = u.pm * BM + wr * 64 + fr, col0 = u.pn * BM + wc * 32 + 4 * fq;
#pragma unroll
        for (int ai = 0; ai < 2; ++ai)
#pragma unroll
            for (int m = 0; m < 4; ++m) { const size_t off = (size_t)(row0 + ai * HALF + m * 16) * ldc + col0;
#pragma unroll
                for (int bj = 0; bj < 2; ++bj)
#pragma unroll
                    for (int n = 0; n < 2; ++n) { f32x4 v = acc[ai][bj][m][n]; if (R) v = v + *(const f32x4*)(R + off + bj * HALF + n * 16); *(f32x4*)(C + off + bj * HALF + n * 16) = v; } }
    }
};
typedef int i32x4 __attribute__((ext_vector_type(4)));
template <bool INT8> __device__ __forceinline__ f32x4 pg8_mma(bf16x8 a, bf16x8 b, f32x4 c) {
    if constexpr (INT8) return __builtin_bit_cast(f32x4, __builtin_amdgcn_mfma_i32_16x16x64_i8(__builtin_bit_cast(i32x4, a), __builtin_bit_cast(i32x4, b), __builtin_bit_cast(i32x4, c), 0, 0, 0));
    else return __builtin_amdgcn_mfma_f32_16x16x32_bf16(a, b, c, 0, 0, 0);
}
template <int ACT> struct EpiBf16I8 {
    static constexpr bool PERM = true, AFTER_DRAIN = false;
    bf16_t* O; int ldc; const float* bias; int split_cols; size_t split_stride; const float* sa; const float* sb;
    __device__ __forceinline__ void operator()(const f32x4 (&acc)[2][2][4][2], const Unit& u, int wr, int wc, int fr, int fq) const {
        const int row0 = u.pm * BM + wr * 64 + fr; int colt = u.pn * BM; bf16_t* base = O;
        if (split_cols) { const int t = colt / split_cols; base += (size_t)t * split_stride; colt -= t * split_cols; }
        const int col0 = colt + wc * 32 + 8 * fq, bcol0 = u.pn * BM + wc * 32 + 8 * fq;
        f32x4 bv[2][2], cs[2][2];
#pragma unroll
        for (int bj = 0; bj < 2; ++bj)
#pragma unroll
            for (int n = 0; n < 2; ++n) { bv[bj][n] = bias ? *(const f32x4*)(bias + bcol0 + bj * HALF + 4 * n) : (f32x4){0.f, 0.f, 0.f, 0.f}; cs[bj][n] = *(const f32x4*)(sb + bcol0 + bj * HALF + 4 * n); }
#pragma unroll
        for (int ai = 0; ai < 2; ++ai)
#pragma unroll
            for (int m = 0; m < 4; ++m) { const int row = row0 + ai * HALF + m * 16; const float ra = sa[row]; bf16_t* rowp = base + (size_t)row * ldc + col0;
#pragma unroll
                for (int bj = 0; bj < 2; ++bj) { const i32x4 i0 = __builtin_bit_cast(i32x4, acc[ai][bj][m][0]), i1 = __builtin_bit_cast(i32x4, acc[ai][bj][m][1]);
                    f32x4 v0, v1;
#pragma unroll
                    for (int j = 0; j < 4; ++j) { v0[j] = (float)i0[j] * (ra * cs[bj][0][j]) + bv[bj][0][j]; v1[j] = (float)i1[j] * (ra * cs[bj][1][j]) + bv[bj][1][j]; }
                    if (ACT == 1) { f32x2 a = gelu_pk((f32x2){v0[0], v0[1]}), b = gelu_pk((f32x2){v0[2], v0[3]}), c = gelu_pk((f32x2){v1[0], v1[1]}), d = gelu_pk((f32x2){v1[2], v1[3]});
                        v0 = (f32x4){a.x, a.y, b.x, b.y}; v1 = (f32x4){c.x, c.y, d.x, d.y}; }
                    u32x4 w; w.x = cvt_pk_bf16(v0[0], v0[1]); w.y = cvt_pk_bf16(v0[2], v0[3]); w.z = cvt_pk_bf16(v1[0], v1[1]); w.w = cvt_pk_bf16(v1[2], v1[3]);
                    *(u32x4*)(rowp + bj * HALF) = w; } }
    }
};
struct EpiResF32I8 {
    static constexpr bool PERM = false, AFTER_DRAIN = false;
    float* C; const float* R; const float* sa; const float* sb; int ldc;
    __device__ __forceinline__ void operator()(const f32x4 (&acc)[2][2][4][2], const Unit& u, int wr, int wc, int fr, int fq) const {
        const int row0 = u.pm * BM + wr * 64 + fr, col0 = u.pn * BM + wc * 32 + 4 * fq;
        f32x4 cs[2][2];
#pragma unroll
        for (int bj = 0; bj < 2; ++bj)
#pragma unroll
            for (int n = 0; n < 2; ++n) cs[bj][n] = *(const f32x4*)(sb + col0 + bj * HALF + n * 16);
#pragma unroll
        for (int ai = 0; ai < 2; ++ai)
#pragma unroll
            for (int m = 0; m < 4; ++m) { const int row = row0 + ai * HALF + m * 16; const float ra = sa[row]; const size_t off = (size_t)row * ldc + col0;
#pragma unroll
                for (int bj = 0; bj < 2; ++bj)
#pragma unroll
                    for (int n = 0; n < 2; ++n) { const i32x4 iv = __builtin_bit_cast(i32x4, acc[ai][bj][m][n]); f32x4 v = *(const f32x4*)(R + off + bj * HALF + n * 16);
#pragma unroll
                        for (int j = 0; j < 4; ++j) v[j] += (float)iv[j] * (ra * cs[bj][n][j]);
                        *(f32x4*)(C + off + bj * HALF + n * 16) = v; } }
    }
};
struct EpiResBf16 {
    static constexpr bool PERM = true, AFTER_DRAIN = false;
    bf16_t* O; const float* R; int ldc;
    __device__ __forceinline__ void operator()(const f32x4 (&acc)[2][2][4][2], const Unit& u, int wr, int wc, int fr, int fq) const {
        const int row0 = u.pm * BM + wr * 64 + fr, col0 = u.pn * BM + wc * 32 + 8 * fq;
#pragma unroll
        for (int ai = 0; ai < 2; ++ai)
#pragma unroll
            for (int m = 0; m < 4; ++m) { const size_t off = (size_t)(row0 + ai * HALF + m * 16) * ldc + col0;
#pragma unroll
                for (int bj = 0; bj < 2; ++bj) { const f32x4 v0 = acc[ai][bj][m][0] + *(const f32x4*)(R + off + bj * HALF), v1 = acc[ai][bj][m][1] + *(const f32x4*)(R + off + bj * HALF + 4);
                    u32x4 w; w.x = cvt_pk_bf16(v0[0], v0[1]); w.y = cvt_pk_bf16(v0[2], v0[3]); w.z = cvt_pk_bf16(v1[0], v1[1]); w.w = cvt_pk_bf16(v1[2], v1[3]);
                    *(u32x4*)(O + off + bj * HALF) = w; } }
    }
};
struct EpiResBf16I8 {
    static constexpr bool PERM = true, AFTER_DRAIN = false;
    bf16_t* O; const float* sa; const float* sb; int ldc;
    __device__ __forceinline__ void operator()(const f32x4 (&acc)[2][2][4][2], const Unit& u, int wr, int wc, int fr, int fq) const {
        const int row0 = u.pm * BM + wr * 64 + fr, col0 = u.pn * BM + wc * 32 + 8 * fq;
        f32x4 cs[2][2];
#pragma unroll
        for (int bj = 0; bj < 2; ++bj)
#pragma unroll
            for (int n = 0; n < 2; ++n) cs[bj][n] = *(const f32x4*)(sb + col0 + bj * HALF + 4 * n);
#pragma unroll
        for (int ai = 0; ai < 2; ++ai)
#pragma unroll
            for (int m = 0; m < 4; ++m) { const int row = row0 + ai * HALF + m * 16; const float ra = sa[row]; const size_t off = (size_t)row * ldc + col0;
#pragma unroll
                for (int bj = 0; bj < 2; ++bj) { const i32x4 i0 = __builtin_bit_cast(i32x4, acc[ai][bj][m][0]), i1 = __builtin_bit_cast(i32x4, acc[ai][bj][m][1]);
                    const u32x4 r = *(const u32x4*)(O + off + bj * HALF);
                    const float r0[4] = {__uint_as_float(r.x << 16), __uint_as_float(r.x & 0xFFFF0000u), __uint_as_float(r.y << 16), __uint_as_float(r.y & 0xFFFF0000u)};
                    const float r1[4] = {__uint_as_float(r.z << 16), __uint_as_float(r.z & 0xFFFF0000u), __uint_as_float(r.w << 16), __uint_as_float(r.w & 0xFFFF0000u)};
                    f32x4 v0, v1;
#pragma unroll
                    for (int j = 0; j < 4; ++j) { v0[j] = r0[j] + (float)i0[j] * (ra * cs[bj][0][j]); v1[j] = r1[j] + (float)i1[j] * (ra * cs[bj][1][j]); }
                    u32x4 w; w.x = cvt_pk_bf16(v0[0], v0[1]); w.y = cvt_pk_bf16(v0[2], v0[3]); w.z = cvt_pk_bf16(v1[0], v1[1]); w.w = cvt_pk_bf16(v1[2], v1[3]);
                    *(u32x4*)(O + off + bj * HALF) = w; } }
    }
};
struct EpiF16 {
    static constexpr bool PERM = true, AFTER_DRAIN = false;
    _Float16* O; int ldc;
    __device__ __forceinline__ void operator()(const f32x4 (&acc)[2][2][4][2], const Unit& u, int wr, int wc, int fr, int fq) const {
        typedef _Float16 h2 __attribute__((ext_vector_type(2)));
        const int row0 = u.pm * BM + wr * 64 + fr, col0 = u.pn * BM + wc * 32 + 8 * fq;
#pragma unroll
        for (int ai = 0; ai < 2; ++ai)
#pragma unroll
            for (int m = 0; m < 4; ++m) { _Float16* rowp = O + (size_t)(row0 + ai * HALF + m * 16) * ldc + col0;
#pragma unroll
                for (int bj = 0; bj < 2; ++bj) { const f32x4 v0 = acc[ai][bj][m][0], v1 = acc[ai][bj][m][1];
                    u32x4 w;
                    w.x = __builtin_bit_cast(unsigned, (h2){(_Float16)v0[0], (_Float16)v0[1]}); w.y = __builtin_bit_cast(unsigned, (h2){(_Float16)v0[2], (_Float16)v0[3]});
                    w.z = __builtin_bit_cast(unsigned, (h2){(_Float16)v1[0], (_Float16)v1[1]}); w.w = __builtin_bit_cast(unsigned, (h2){(_Float16)v1[2], (_Float16)v1[3]});
                    *(u32x4*)(rowp + bj * HALF) = w; } }
    }
};
template <class Epi, class Sched, bool ALIGN_EPI = false, bool SP2 = false, bool INT8 = false>
__device__ __forceinline__ void gemm_phase(PG8_LAS unsigned char* lds, const Gemm g, const Sched& S, const Epi& E) {
    int tid = threadIdx.x; asm volatile("" : "+v"(tid));
    const int wid = __builtin_amdgcn_readfirstlane(tid >> 6), lane = tid & 63, wr = wid >> 2, wc = wid & 3, fr = lane & 15, fq = lane >> 4;
    const int K = g.K, nt = K / BK;
    unsigned voffA[2], voffB[2];
#pragma unroll
    for (int i = 0; i < 2; ++i) { int R, C; stage_rc(tid * 16 + i * 8192, R, C); const int Rb = Epi::PERM ? ((R & ~31) + perm32(R & 31)) : R;
        voffA[i] = (unsigned)(R * K + C) * 2u; voffB[i] = (unsigned)(Rb * K + C) * 2u; }
    const size_t kstep = (size_t)(BK * 2);
    const size_t hstep = (size_t)HALF * K * 2;
    const size_t tstep = 2 * hstep;
    const unsigned ldsw = (unsigned)wid * 1024u;
    const int aoff = lds_byte(wr * 64 + fr, fq * 8), boff = lds_byte(wc * 32 + fr, fq * 8);
#define PG8_SA(b, h) (((b) * 2 + (h)) * HTB)
#define PG8_SB(b, h) ((4 + (b) * 2 + (h)) * HTB)
#define PG8_STAGE(bufoff, gbase, voff) do { _Pragma("unroll") for (int _i = 0; _i < 2; ++_i) \
        __builtin_amdgcn_global_load_lds((const unsigned*)((const char*)(gbase) + (voff)[_i]), (PG8_LAS unsigned*)(lds + (bufoff) + ldsw + _i * 8192), 16, 0, 0); } while (0)
#define PG8_LDA(dst, b, h) do { _Pragma("unroll") for (int m = 0; m < 4; ++m) _Pragma("unroll") for (int k = 0; k < 2; ++k) dst[m][k] = *(const PG8_LAS bf16x8*)(lds + PG8_SA(b, h) + aoff + m * 2048 + k * 1024); } while (0)
#define PG8_LDB(dst, b, h) do { _Pragma("unroll") for (int n = 0; n < 2; ++n) _Pragma("unroll") for (int k = 0; k < 2; ++k) dst[n][k] = *(const PG8_LAS bf16x8*)(lds + PG8_SB(b, h) + boff + n * 2048 + k * 1024); } while (0)
#define PG8_MMA(ai, bj, At, Bt) do { __builtin_amdgcn_s_setprio(1); _Pragma("unroll") for (int m = 0; m < 4; ++m) _Pragma("unroll") for (int n = 0; n < 2; ++n) _Pragma("unroll") for (int k = 0; k < 2; ++k) \
        acc[ai][bj][m][n] = pg8_mma<INT8>(Bt[n][k], At[m][k], acc[ai][bj][m][n]); __builtin_amdgcn_s_setprio(0); } while (0)
#define PG8_WAIT_V(n) asm volatile("s_waitcnt vmcnt(" #n ")" ::: "memory")
#define PG8_WAIT_L(n) asm volatile("s_waitcnt lgkmcnt(" #n ")" ::: "memory")
#define PG8_BAR __builtin_amdgcn_s_barrier()
#define PG8_SCHED __builtin_amdgcn_sched_barrier(0)
    Unit cur, nxt; int ui = 0;
    if (!S.next(0, cur)) return;
    f32x4 acc[2][2][4][2];
#pragma unroll
    for (int a = 0; a < 2; ++a)
#pragma unroll
        for (int b = 0; b < 2; ++b)
#pragma unroll
            for (int m = 0; m < 4; ++m)
#pragma unroll
                for (int n = 0; n < 2; ++n) acc[a][b][m][n] = (f32x4){0.f, 0.f, 0.f, 0.f};
    bf16x8 At[4][2], B0[2][2], B1[2][2];
    const char* cA = (const char*)g.A + (size_t)cur.pm * tstep; const char* cB = (const char*)g.Bt + (size_t)cur.pn * tstep;
    S.a_ready(cur);
    if constexpr (SP2) {
        PG8_STAGE(PG8_SB(0, 0), cB, voffB); PG8_STAGE(PG8_SB(0, 1), cB + hstep, voffB); PG8_STAGE(PG8_SA(0, 0), cA, voffA); PG8_STAGE(PG8_SA(0, 1), cA + hstep, voffA);
        if (wr == 1) PG8_BAR;
        PG8_WAIT_V(2); PG8_BAR;
        PG8_STAGE(PG8_SB(1, 0), cB + kstep, voffB); PG8_STAGE(PG8_SA(1, 0), cA + kstep, voffA); PG8_STAGE(PG8_SB(1, 1), cB + hstep + kstep, voffB);
        PG8_WAIT_V(6); PG8_BAR;
    } else {
        PG8_STAGE(PG8_SB(0, 0), cB, voffB); PG8_STAGE(PG8_SA(0, 0), cA, voffA); PG8_STAGE(PG8_SB(0, 1), cB + hstep, voffB); PG8_STAGE(PG8_SA(0, 1), cA + hstep, voffA);
        if (wr == 1) PG8_BAR;
        PG8_WAIT_V(4); PG8_BAR;
        PG8_STAGE(PG8_SB(1, 0), cB + kstep, voffB); PG8_STAGE(PG8_SA(1, 0), cA + kstep, voffA); PG8_STAGE(PG8_SB(1, 1), cB + hstep + kstep, voffB);
        PG8_WAIT_V(6); PG8_BAR;
    }
    for (;;) {
        const bool has_next = S.next(ui + 1, nxt);
        const char* nA = has_next ? (const char*)g.A + (size_t)nxt.pm * tstep : cA; const char* nB = has_next ? (const char*)g.Bt + (size_t)nxt.pn * tstep : cB;
        for (int t = 0; t < nt; t += 2) {
            const bool last = (t == nt - 2);
            const char* a1 = cA + (size_t)(t + 1) * kstep;
            const char* a2 = last ? nA : cA + (size_t)(t + 2) * kstep; const char* b2 = last ? nB : cB + (size_t)(t + 2) * kstep;
            const char* a3 = a2 + kstep; const char* b3 = b2 + kstep;
            if (last && has_next) S.a_ready(nxt);
            if constexpr (SP2) {
            PG8_LDB(B0, 0, 0); PG8_LDB(B1, 0, 1); PG8_SCHED; PG8_LDA(At, 0, 0); PG8_STAGE(PG8_SA(1, 1), a1 + hstep, voffA);
            PG8_WAIT_V(8); PG8_WAIT_L(0); PG8_BAR; PG8_MMA(0, 0, At, B0); PG8_MMA(0, 1, At, B1); PG8_BAR; PG8_SCHED;
            PG8_LDA(At, 0, 1); PG8_STAGE(PG8_SB(0, 0), b2, voffB); PG8_STAGE(PG8_SB(0, 1), b2 + hstep, voffB); PG8_STAGE(PG8_SA(0, 0), a2, voffA);
            PG8_WAIT_V(8); PG8_WAIT_L(0); PG8_BAR; PG8_MMA(1, 0, At, B0); PG8_MMA(1, 1, At, B1); PG8_BAR; PG8_SCHED;
            PG8_LDB(B0, 1, 0); PG8_LDB(B1, 1, 1); PG8_SCHED; PG8_LDA(At, 1, 0); PG8_STAGE(PG8_SA(0, 1), a2 + hstep, voffA);
            PG8_WAIT_V(8); PG8_WAIT_L(0); PG8_BAR; PG8_MMA(0, 0, At, B0); PG8_MMA(0, 1, At, B1); PG8_BAR; PG8_SCHED;
            PG8_LDA(At, 1, 1); PG8_STAGE(PG8_SB(1, 0), b3, voffB); PG8_STAGE(PG8_SB(1, 1), b3 + hstep, voffB); PG8_STAGE(PG8_SA(1, 0), a3, voffA);
            PG8_WAIT_V(8); PG8_WAIT_L(0); PG8_BAR; PG8_MMA(1, 0, At, B0); PG8_MMA(1, 1, At, B1); PG8_BAR; PG8_SCHED;
            } else {
            PG8_LDB(B0, 0, 0); PG8_SCHED; PG8_LDA(At, 0, 0); PG8_STAGE(PG8_SA(1, 1), a1 + hstep, voffA);
            PG8_WAIT_L(8); PG8_BAR; PG8_WAIT_L(0); PG8_MMA(0, 0, At, B0); PG8_BAR; PG8_SCHED;
            PG8_LDB(B1, 0, 1); PG8_STAGE(PG8_SB(0, 0), b2, voffB);
            PG8_BAR; PG8_WAIT_L(0); PG8_MMA(0, 1, At, B1); PG8_BAR;
            PG8_LDA(At, 0, 1); PG8_STAGE(PG8_SA(0, 0), a2, voffA);
            PG8_BAR; PG8_WAIT_L(0); PG8_MMA(1, 0, At, B0); PG8_BAR; PG8_SCHED;
            PG8_STAGE(PG8_SB(0, 1), b2 + hstep, voffB);
            PG8_WAIT_V(6); PG8_BAR; PG8_MMA(1, 1, At, B1); PG8_BAR;
            PG8_LDB(B0, 1, 0); PG8_SCHED; PG8_LDA(At, 1, 0); PG8_STAGE(PG8_SA(0, 1), a2 + hstep, voffA);
            PG8_WAIT_L(8); PG8_BAR; PG8_WAIT_L(0); PG8_MMA(0, 0, At, B0); PG8_BAR; PG8_SCHED;
            PG8_LDB(B1, 1, 1); PG8_STAGE(PG8_SB(1, 0), b3, voffB);
            PG8_BAR; PG8_WAIT_L(0); PG8_MMA(0, 1, At, B1); PG8_BAR;
            PG8_LDA(At, 1, 1); PG8_STAGE(PG8_SA(1, 0), a3, voffA);
            PG8_BAR; PG8_WAIT_L(0); PG8_MMA(1, 0, At, B0); PG8_BAR; PG8_SCHED;
            PG8_STAGE(PG8_SB(1, 1), b3 + hstep, voffB);
            PG8_WAIT_V(6); PG8_BAR; PG8_MMA(1, 1, At, B1); PG8_BAR;
            }
        }
        if constexpr (ALIGN_EPI) { if (wr == 0) PG8_BAR; }
        if constexpr (!Epi::AFTER_DRAIN) { E(acc, cur, wr, wc, fr, fq); S.done(cur); }
        if (!has_next) break;
#pragma unroll
        for (int a = 0; a < 2; ++a)
#pragma unroll
            for (int b = 0; b < 2; ++b)
#pragma unroll
                for (int m = 0; m < 4; ++m)
#pragma unroll
                    for (int n = 0; n < 2; ++n) acc[a][b][m][n] = (f32x4){0.f, 0.f, 0.f, 0.f};
        cur = nxt; cA = nA; cB = nB; ++ui;
        if constexpr (ALIGN_EPI) { if (wr == 1) PG8_BAR; }
    }
    PG8_WAIT_V(0);
    if constexpr (!ALIGN_EPI) { if (wr == 0) PG8_BAR; }
    PG8_BAR;
    if constexpr (Epi::AFTER_DRAIN) { E.fused(acc, cur, wr, wc, fr, fq, lds, wid, lane); S.done(cur); }
#undef PG8_SA
#undef PG8_SB
#undef PG8_STAGE
#undef PG8_LDA
#undef PG8_LDB
#undef PG8_MMA
#undef PG8_WAIT_V
#undef PG8_WAIT_L
#undef PG8_BAR
#undef PG8_SCHED
}
}
#define LAS __attribute__((address_space(3)))
typedef unsigned short bf16_t;
typedef unsigned v4u __attribute__((ext_vector_type(4)));
typedef unsigned v2u __attribute__((ext_vector_type(2)));
typedef short bf16x8_t __attribute__((ext_vector_type(8)));
typedef float f32x4 __attribute__((ext_vector_type(4)));

constexpr int TOK = 32768, DM = 1024, SEQ = 8192;
constexpr int BPROJ = 3328;
constexpr size_t MiB = 1ull << 20;
constexpr size_t WS_CTL = 0;
constexpr size_t WS_BAR = 512 * 1024;
constexpr size_t WS_DUMMY = 768 * 1024;
constexpr size_t WS_SCALE = 0;
constexpr size_t WS_WA_IN = 1 * MiB;
constexpr size_t WS_WA_OUT = 9 * MiB;
constexpr size_t WS_WB_IN = 13 * MiB;
constexpr size_t WS_WB_OUT = 20 * MiB;
constexpr size_t WS_WP = 22 * MiB;
constexpr size_t WS_H = 32 * MiB;
constexpr size_t WS_EID = 96 * MiB;
constexpr size_t WS_GATE = 112 * MiB;
constexpr size_t WS_TAB = 128 * MiB;
constexpr size_t WS_BIG = 192 * MiB;
constexpr size_t WS_GLR = WS_BIG + 305 * MiB;
constexpr size_t WS_WA_IN8 = WS_BIG + 309 * MiB;
constexpr size_t WS_WB_IN8 = WS_BIG + 313 * MiB;
constexpr size_t WS_WB_OUT8 = WS_BIG + 317 * MiB;
constexpr size_t WS_SB_OUT = 352 * 1024;
constexpr size_t WS_SA_IN = 288 * 1024;
constexpr size_t WS_SB_IN = 320 * 1024;
constexpr int LDS_BYTES = 147456;

struct Params { const float* in[21]; float* out; unsigned char* ws; };

__device__ __forceinline__ bf16_t f2bf(float f) { return __builtin_bit_cast(bf16_t, (__bf16)f); }
typedef __bf16 bf16n2 __attribute__((ext_vector_type(2)));
__device__ __forceinline__ unsigned pk2(float lo, float hi) { typedef float f32n2 __attribute__((ext_vector_type(2))); const f32n2 v = {lo, hi}; return __builtin_bit_cast(unsigned, __builtin_convertvector(v, bf16n2)); }
__device__ __forceinline__ float bf2f(bf16_t b) { return __uint_as_float(((unsigned)b) << 16); }
__device__ __forceinline__ float gelu_exact(float x) { return 0.5f * x * (1.0f + erff(x * 0.70710678118654752f)); }
__device__ __forceinline__ float wave_sum(float v) {
#pragma unroll
  for (int o = 32; o > 0; o >>= 1) v += __shfl_xor(v, o);
  return v;
}

typedef __bf16 bf16x2_t __attribute__((ext_vector_type(2)));
__device__ __forceinline__ float dot2bf(unsigned a, unsigned b, float c) { return __builtin_amdgcn_fdot2_f32_bf16(__builtin_bit_cast(bf16x2_t, a), __builtin_bit_cast(bf16x2_t, b), c, false); }
__device__ __forceinline__ float wave_sum_dpp(float v) {
  int x;
  x = __builtin_amdgcn_mov_dpp(__float_as_int(v), 0xB1, 0xF, 0xF, true); v += __int_as_float(x);
  x = __builtin_amdgcn_mov_dpp(__float_as_int(v), 0x4E, 0xF, 0xF, true); v += __int_as_float(x);
  x = __builtin_amdgcn_mov_dpp(__float_as_int(v), 0x141, 0xF, 0xF, true); v += __int_as_float(x);
  x = __builtin_amdgcn_mov_dpp(__float_as_int(v), 0x140, 0xF, 0xF, true); v += __int_as_float(x);
  const int vi = __float_as_int(v);
  return (__int_as_float(__builtin_amdgcn_readlane(vi, 0)) + __int_as_float(__builtin_amdgcn_readlane(vi, 16))) +
         (__int_as_float(__builtin_amdgcn_readlane(vi, 32)) + __int_as_float(__builtin_amdgcn_readlane(vi, 48)));
}
__device__ __forceinline__ float gelu_as(float v) {
  const float av = fabsf(v), t = __builtin_amdgcn_rcpf(av * 0.2316418882f + 1.0f);
  float q = t * 0.5307027145f + (-0.7265760135f); q = q * t + 0.7107068705f; q = q * t + (-0.142248368f); q = q * t + 0.127414796f; q = q * t;
  const float e = __builtin_amdgcn_exp2f((v * v) * (-0.72134752044f));
  const float m = v * (q * e);
  return v < 0.f ? m : v - m;
}

__device__ __forceinline__ void fold_item(const Params& P, int it, int lane, LAS float* scr) {
  const int kk0 = (it & 63) * 16, half = (it >> 6) & 1, head = (it >> 7) & 7, layer = it >> 10;
  const float* kx = (half ? P.in[18] : P.in[17]) + (size_t)layer * 16384;
  const float* wq = P.in[16] + (size_t)layer * 1024 * 2048 + head * 256 + half * 128;
#pragma unroll
  for (int i = 0; i < 8; ++i) { const int e = i * 64 + lane, r = e >> 5, c4 = e & 31;
    const float4 v = *(const float4*)(wq + (size_t)(kk0 + r) * 2048 + c4 * 4);
    *(LAS f32x4*)(scr + r * 128 + c4 * 4) = (f32x4){v.x, v.y, v.z, v.w}; }
  asm volatile("s_waitcnt lgkmcnt(0)" ::: "memory");
  float a0[16], a1[16];
#pragma unroll
  for (int i = 0; i < 16; ++i) { a0[i] = 0.f; a1[i] = 0.f; }
#pragma unroll 2
  for (int d4 = 0; d4 < 32; ++d4) {
    const float4 x0 = *(const float4*)(kx + (size_t)lane * 128 + d4 * 4), x1 = *(const float4*)(kx + (size_t)(lane + 64) * 128 + d4 * 4);
#pragma unroll
    for (int kk = 0; kk < 16; ++kk) {
      const f32x4 b = *(const LAS f32x4*)(scr + kk * 128 + d4 * 4);
      a0[kk] += x0.x * b[0] + x0.y * b[1] + x0.z * b[2] + x0.w * b[3];
      a1[kk] += x1.x * b[0] + x1.y * b[1] + x1.z * b[2] + x1.w * b[3];
    }
  }
  asm volatile("s_waitcnt lgkmcnt(0)" ::: "memory");
  bf16_t* wt = (bf16_t*)(P.ws + WS_WP) + (size_t)layer * 2048 * 1024;
  bf16_t* r0 = wt + (size_t)(head * 256 + half * 128 + lane) * 1024 + kk0;
  bf16_t* r1 = r0 + (size_t)64 * 1024;
  v4u o;
  o.x = pk2(a0[0], a0[1]); o.y = pk2(a0[2], a0[3]); o.z = pk2(a0[4], a0[5]); o.w = pk2(a0[6], a0[7]); *(v4u*)r0 = o;
  o.x = pk2(a0[8], a0[9]); o.y = pk2(a0[10], a0[11]); o.z = pk2(a0[12], a0[13]); o.w = pk2(a0[14], a0[15]); *(v4u*)(r0 + 8) = o;
  o.x = pk2(a1[0], a1[1]); o.y = pk2(a1[2], a1[3]); o.z = pk2(a1[4], a1[5]); o.w = pk2(a1[6], a1[7]); *(v4u*)r1 = o;
  o.x = pk2(a1[8], a1[9]); o.y = pk2(a1[10], a1[11]); o.z = pk2(a1[12], a1[13]); o.w = pk2(a1[14], a1[15]); *(v4u*)(r1 + 8) = o;
}

__device__ __forceinline__ float wave_max_dpp(float v) {
  v = fmaxf(v, __int_as_float(__builtin_amdgcn_mov_dpp(__float_as_int(v), 0xB1, 0xF, 0xF, true)));
  v = fmaxf(v, __int_as_float(__builtin_amdgcn_mov_dpp(__float_as_int(v), 0x4E, 0xF, 0xF, true)));
  v = fmaxf(v, __int_as_float(__builtin_amdgcn_mov_dpp(__float_as_int(v), 0x141, 0xF, 0xF, true)));
  v = fmaxf(v, __int_as_float(__builtin_amdgcn_mov_dpp(__float_as_int(v), 0x140, 0xF, 0xF, true)));
  const int vi = __float_as_int(v);
  return fmaxf(fmaxf(__int_as_float(__builtin_amdgcn_readlane(vi, 0)), __int_as_float(__builtin_amdgcn_readlane(vi, 16))),
               fmaxf(__int_as_float(__builtin_amdgcn_readlane(vi, 32)), __int_as_float(__builtin_amdgcn_readlane(vi, 48))));
}
__device__ __forceinline__ int wave_isum_dpp(int v) {
  v += __builtin_amdgcn_mov_dpp(v, 0xB1, 0xF, 0xF, true);
  v += __builtin_amdgcn_mov_dpp(v, 0x4E, 0xF, 0xF, true);
  v += __builtin_amdgcn_mov_dpp(v, 0x141, 0xF, 0xF, true);
  v += __builtin_amdgcn_mov_dpp(v, 0x140, 0xF, 0xF, true);
  return (__builtin_amdgcn_readlane(v, 0) + __builtin_amdgcn_readlane(v, 16)) + (__builtin_amdgcn_readlane(v, 32) + __builtin_amdgcn_readlane(v, 48));
}
__device__ __forceinline__ unsigned q8(float x, float inv) { const int q = (int)rintf(x * inv); return (unsigned)(q < -127 ? -127 : (q > 127 ? 127 : q)) & 0xFFu; }
__device__ __forceinline__ void tabconv8_row(const Params& P, int r, const float4 (&v)[4], int lane) {
  const int row = r & 16383, tab = (r >> 14) & 1, layer = r >> 15;
  float am = 0.f;
#pragma unroll
  for (int i = 0; i < 4; ++i) am = fmaxf(am, fmaxf(fmaxf(fabsf(v[i].x), fabsf(v[i].y)), fmaxf(fabsf(v[i].z), fabsf(v[i].w))));
  am = wave_max_dpp(am);
  const float sc = am > 0.f ? am * (1.0f / 127.0f) : 1.0f, inv = 1.0f / sc;
  const unsigned off = 0u;
  v4u o; unsigned w[4];
#pragma unroll
  for (int i = 0; i < 4; ++i) w[i] = ((q8(v[i].x, inv) | (q8(v[i].y, inv) << 8) | (q8(v[i].z, inv) << 16) | (q8(v[i].w, inv) << 24)) ^ off);
  o.x = w[0]; o.y = w[1]; o.z = w[2]; o.w = w[3];
  *(v4u*)(P.ws + WS_TAB + (size_t)(layer * 2 + tab) * 16 * MiB + ((size_t)(lane >> 3) * 16384 + row) * 128 + (lane & 7) * 16) = o;
  if (lane == 0) ((float*)(P.ws + WS_SCALE))[(layer * 2 + tab) * 16384 + row] = sc;
}
__device__ __forceinline__ void tabconv8_load(const Params& P, int r, float4 (&v)[4], int lane) {
  const int row = r & 16383, tab = (r >> 14) & 1, layer = r >> 15;
  const float* src = P.in[19 + tab] + ((size_t)layer * 16384 + row) * 1024;
#pragma unroll
  for (int i = 0; i < 4; ++i) v[i] = tab ? *(const float4*)(src + lane * 16 + i * 4) : *(const float4*)(src + i * 256 + lane * 4);
}
__device__ __forceinline__ void phase_tabconv8(const Params& P) {
  const int lane = threadIdx.x & 63, wave = __builtin_amdgcn_readfirstlane(threadIdx.x >> 6);
  const int gw = blockIdx.x * 8 + wave, NGW = gridDim.x * 8;
  float4 a[4], b[4], c[4], d[4];
  for (int r = gw; r < 4 * 16384; r += 4 * NGW) {
    tabconv8_load(P, r, a, lane);
    if (r + NGW < 4 * 16384) tabconv8_load(P, r + NGW, b, lane);
    if (r + 2 * NGW < 4 * 16384) tabconv8_load(P, r + 2 * NGW, c, lane);
    if (r + 3 * NGW < 4 * 16384) tabconv8_load(P, r + 3 * NGW, d, lane);
    tabconv8_row(P, r, a, lane);
    if (r + NGW < 4 * 16384) tabconv8_row(P, r + NGW, b, lane);
    if (r + 2 * NGW < 4 * 16384) tabconv8_row(P, r + 2 * NGW, c, lane);
    if (r + 3 * NGW < 4 * 16384) tabconv8_row(P, r + 3 * NGW, d, lane);
  }
}

constexpr size_t WS_GSU = WS_H;
constexpr size_t WS_GSV = WS_GATE;
__device__ __forceinline__ unsigned enc_key(float s) { const unsigned b = __float_as_uint(s); return (b & 0x80000000u) ? ~b : (b | 0x80000000u); }
__device__ __forceinline__ float dec_key(unsigned u) { return __uint_as_float((u & 0x80000000u) ? (u & 0x7FFFFFFFu) : ~u); }
#define TK_CE(a, b) do { const unsigned _hi = (a) > (b) ? (a) : (b), _lo = (a) > (b) ? (b) : (a); (a) = _hi; (b) = _lo; } while (0)
__device__ __forceinline__ void sort16_desc(unsigned (&k)[16]) {
#pragma unroll
  for (int size = 2; size <= 16; size <<= 1)
#pragma unroll
    for (int stride = size >> 1; stride > 0; stride >>= 1)
#pragma unroll
      for (int i = 0; i < 16; ++i) { const int j = i ^ stride; if (j > i) { if ((i & size) == 0) TK_CE(k[i], k[j]); else TK_CE(k[j], k[i]); } }
}
__device__ __forceinline__ void merge16_desc(unsigned (&k)[16]) {
#pragma unroll
  for (int stride = 8; stride > 0; stride >>= 1)
#pragma unroll
    for (int i = 0; i < 16; ++i) { const int j = i ^ stride; if (j > i) TK_CE(k[i], k[j]); }
}
__device__ __forceinline__ void topmerge16(unsigned (&R)[16], const unsigned (&N)[16]) {
#pragma unroll
  for (int i = 0; i < 16; ++i) R[i] = R[i] > N[15 - i] ? R[i] : N[15 - i];
  merge16_desc(R);
}
__device__ __forceinline__ void topk_ld(const _Float16* wbase, int step, int lane, v4u (&g)[4]) {
#pragma unroll
  for (int i = 0; i < 4; ++i) g[i] = *(const v4u*)(wbase + (size_t)(i * 16 + (lane >> 2)) * 256 + step * 32 + (lane & 3) * 8);
}
__device__ __forceinline__ void topk_put(LAS unsigned char* tile, int lane, const v4u (&g)[4]) {
#pragma unroll
  for (int i = 0; i < 4; ++i) *(LAS v4u*)(tile + (i * 16 + (lane >> 2)) * 80 + (lane & 3) * 16) = g[i];
}
__device__ __forceinline__ void topk_group(LAS unsigned char* tile, int lane, int sub, int gcol, unsigned (&N)[16]) {
  typedef _Float16 h2 __attribute__((ext_vector_type(2)));
#pragma unroll
  for (int q = 0; q < 2; ++q) { const v4u v = *(const LAS v4u*)(tile + lane * 80 + sub * 32 + q * 16); const unsigned vv[4] = {v.x, v.y, v.z, v.w};
#pragma unroll
    for (int j = 0; j < 4; ++j) { const h2 hh = __builtin_bit_cast(h2, vv[j]);
      N[q * 8 + 2 * j + 0] = (enc_key((float)hh.x) & ~0x7Fu) | (unsigned)(127 - (gcol + q * 8 + 2 * j + 0));
      N[q * 8 + 2 * j + 1] = (enc_key((float)hh.y) & ~0x7Fu) | (unsigned)(127 - (gcol + q * 8 + 2 * j + 1)); } }
  sort16_desc(N);
}

__device__ __forceinline__ void phase_topk(const Params& P, LAS unsigned char* lds, int layer) {
  const _Float16* S = (const _Float16*)(P.ws + WS_BIG);
  int* EID = (int*)(P.ws + WS_EID); float* GSU = (float*)(P.ws + WS_GSU); float* GSV = (float*)(P.ws + WS_GSV);
  const float* scu = (const float*)(P.ws + WS_SCALE) + layer * 32768; const float* scv = scu + 16384;
  int lane = threadIdx.x & 63; const int wave = __builtin_amdgcn_readfirstlane(threadIdx.x >> 6);
  asm volatile("" : "+v"(lane));
  LAS unsigned char* my = lds + (wave * 64 + lane) * 36;
  LAS unsigned char* tile = lds + 20480 + wave * 10240;
  const int NT = gridDim.x * blockDim.x;
  for (int row = blockIdx.x * blockDim.x + wave * 64 + lane; row < TOK * 8; row += NT) {
    const _Float16* wbase = S + (size_t)(row - lane) * 256;
    unsigned R1[16], R2[16];
    v4u ld[4];
    topk_ld(wbase, 0, lane, ld);
#pragma unroll
    for (int st = 0; st < 8; ++st) {
      LAS unsigned char* tl = tile + (st & 1) * 5120;
      topk_put(tl, lane, ld);
      if (st + 1 < 8) topk_ld(wbase, st + 1, lane, ld);
#pragma unroll
      for (int sub = 0; sub < 2; ++sub) {
        const int gi = st * 2 + sub;
        unsigned N[16];
        topk_group(tl, lane, sub, (gi & 7) * 16, N);
        if (gi == 0) {
#pragma unroll
          for (int i = 0; i < 16; ++i) R1[i] = N[i];
        } else if (gi < 8) topmerge16(R1, N);
        else if (gi == 8) {
#pragma unroll
          for (int i = 0; i < 16; ++i) R2[i] = N[i];
        } else topmerge16(R2, N);
      }
    }
    float v1[16], v2[16];
#pragma unroll
    for (int i = 0; i < 16; ++i) { v1[i] = dec_key(R1[i] & ~0x7Fu); v2[i] = dec_key(R2[i] & ~0x7Fu); my[i] = (unsigned char)(127u - (R1[i] & 0x7Fu)); my[16 + i] = (unsigned char)(127u - (R2[i] & 0x7Fu)); }
    unsigned C[64];
    {
      int n = 0;
#pragma unroll
      for (int a = 0; a < 16; ++a)
#pragma unroll
        for (int b = 0; b < 16; ++b)
          if ((a + 1) * (b + 1) <= 16) { C[n] = (enc_key(v1[a] + v2[b]) & ~0xFFu) | (unsigned)(255 - (a * 16 + b)); ++n; }
#pragma unroll
      for (int i = 50; i < 64; ++i) C[i] = 0u;
    }
    unsigned R[16], N[16];
#pragma unroll
    for (int i = 0; i < 16; ++i) R[i] = C[i];
    sort16_desc(R);
#pragma unroll
    for (int g = 1; g < 4; ++g) {
#pragma unroll
      for (int i = 0; i < 16; ++i) N[i] = C[g * 16 + i];
      sort16_desc(N); topmerge16(R, N);
    }
    float ev[16]; int ei[16]; float sum = 0.f;
    const float mx = dec_key(R[0] & ~0xFFu);
#pragma unroll
    for (int i = 0; i < 16; ++i) {
      const unsigned pos = 255u - (R[i] & 0xFFu);
      ev[i] = __expf(dec_key(R[i] & ~0xFFu) - mx); sum += ev[i];
      ei[i] = (int)my[pos >> 4] * 128 + (int)my[16 + (pos & 15u)];
    }
    const float inv = 1.0f / sum;
#pragma unroll
    for (int q = 0; q < 4; ++q) {
      *(int4*)(EID + (size_t)row * 16 + q * 4) = make_int4(ei[q * 4], ei[q * 4 + 1], ei[q * 4 + 2], ei[q * 4 + 3]);
      *(float4*)(GSU + (size_t)row * 16 + q * 4) = make_float4(scu[ei[q * 4]], scu[ei[q * 4 + 1]], scu[ei[q * 4 + 2]], scu[ei[q * 4 + 3]]);
      *(float4*)(GSV + (size_t)row * 16 + q * 4) = make_float4(ev[q * 4] * inv * scv[ei[q * 4]], ev[q * 4 + 1] * inv * scv[ei[q * 4 + 1]], ev[q * 4 + 2] * inv * scv[ei[q * 4 + 2]], ev[q * 4 + 3] * inv * scv[ei[q * 4 + 3]]);
    }
  }
}

constexpr size_t WS_H8 = WS_BIG + 256 * MiB;
constexpr size_t WS_SH = WS_BIG + 288 * MiB;
constexpr size_t WS_W = WS_BIG + 289 * MiB;
constexpr size_t WS_WQ = WS_W;
constexpr size_t WS_SW = WS_W + 8 * MiB;
constexpr size_t WS_RFIN = WS_BIG;
struct VsHdrLane { const unsigned char* base; int sh, mask; };
__device__ __forceinline__ VsHdrLane vs_hdr_lane(const Params& P, int lane) {
  VsHdrLane h;
  h.base = P.ws + (lane < 32 ? WS_EID + lane * 16 : lane < 40 ? WS_WQ + (lane - 32) * 16 : WS_SW);
  h.sh = lane < 32 ? 9 : lane < 40 ? 7 : 2; h.mask = lane < 40 ? -1 : ~3;
  return h;
}
__device__ __forceinline__ void vs_hdr_issue(const VsHdrLane& h, int tok, LAS unsigned char* slot) {
  const unsigned char* src = h.base + ((unsigned)(tok & h.mask) << h.sh);
  asm volatile("s_mov_b32 m0, %1\n\ts_nop 0\n\tglobal_load_lds_dwordx4 %0, off" :: "v"(src), "s"((unsigned)(size_t)slot) : "m0", "memory");
}
#define VS_BP(v, x) __builtin_amdgcn_ds_bpermute((lane ^ (x)) * 4, (v))
#define VS_PIN_ROWS(q) asm volatile("" : "+v"(q[0]), "+v"(q[1]), "+v"(q[2]), "+v"(q[3]))
#define VS_PIN_ACC(a) asm volatile("" : "+v"(a[0]), "+v"(a[1]), "+v"(a[2]), "+v"(a[3]), "+v"(a[4]), "+v"(a[5]), "+v"(a[6]), "+v"(a[7]), "+v"(a[8]), "+v"(a[9]), "+v"(a[10]), "+v"(a[11]), "+v"(a[12]), "+v"(a[13]), "+v"(a[14]), "+v"(a[15]))
__device__ __forceinline__ void vs_rows4(v4u (&vb)[4], const v4u& e, const unsigned char* VS, int p) {
  unsigned e0 = e.x, e1 = e.y, e2 = e.z, e3 = e.w;
  asm volatile("" : "+v"(e0), "+v"(e1), "+v"(e2), "+v"(e3));
  vb[0] = *(const v4u*)(VS + (e0 * 128u + p * 16)); vb[1] = *(const v4u*)(VS + (e1 * 128u + p * 16));
  vb[2] = *(const v4u*)(VS + (e2 * 128u + p * 16)); vb[3] = *(const v4u*)(VS + (e3 * 128u + p * 16));
}
__device__ __forceinline__ void vs_acc4(int (&acc)[16], const v4u& a, const v4u& b, const v4u& c, const v4u& d, unsigned wq) {
  const unsigned ra[4] = {a.x, a.y, a.z, a.w}, rb[4] = {b.x, b.y, b.z, b.w}, rc[4] = {c.x, c.y, c.z, c.w}, rd[4] = {d.x, d.y, d.z, d.w};
#pragma unroll
  for (int i = 0; i < 4; ++i) {
    const unsigned ablo = __builtin_amdgcn_perm(rb[i], ra[i], 0x05010400u), abhi = __builtin_amdgcn_perm(rb[i], ra[i], 0x07030602u);
    const unsigned cdlo = __builtin_amdgcn_perm(rd[i], rc[i], 0x05010400u), cdhi = __builtin_amdgcn_perm(rd[i], rc[i], 0x07030602u);
    acc[4 * i + 0] = __builtin_amdgcn_sdot4((int)__builtin_amdgcn_perm(cdlo, ablo, 0x05040100u), (int)wq, acc[4 * i + 0], false);
    acc[4 * i + 1] = __builtin_amdgcn_sdot4((int)__builtin_amdgcn_perm(cdlo, ablo, 0x07060302u), (int)wq, acc[4 * i + 1], false);
    acc[4 * i + 2] = __builtin_amdgcn_sdot4((int)__builtin_amdgcn_perm(cdhi, abhi, 0x05040100u), (int)wq, acc[4 * i + 2], false);
    acc[4 * i + 3] = __builtin_amdgcn_sdot4((int)__builtin_amdgcn_perm(cdhi, abhi, 0x07060302u), (int)wq, acc[4 * i + 3], false);
  }
}
#ifndef VS_VAR
#define VS_VAR 0
#endif
__device__ __forceinline__ void vs_xor4(int (&acc)[16], const v4u& a, const v4u& b, const v4u& c, const v4u& d) {
  acc[0] ^= (int)(a.x ^ a.y ^ a.z ^ a.w); acc[1] ^= (int)(b.x ^ b.y ^ b.z ^ b.w); acc[2] ^= (int)(c.x ^ c.y ^ c.z ^ c.w); acc[3] ^= (int)(d.x ^ d.y ^ d.z ^ d.w);
}
template <bool DRY>
__device__ __forceinline__ void vs_step(const Params& P, bf16_t* dst, int tok, int pf_tok, int last, const unsigned char* VS, int x, int lane, const VsHdrLane& hl, LAS unsigned char* scur, LAS unsigned char* snxt, LAS unsigned char* snew,
                                        v4u (&q0)[4], v4u (&q1)[4], v4u (&q2)[4], v4u (&q3)[4]) {
  const int g = lane >> 3, p = lane & 7;
  const int tokc = tok < TOK ? tok : last;
  asm volatile("s_waitcnt vmcnt(17)" ::: "memory");
  const v4u wq = *(const LAS v4u*)(scur + 512 + g * 16);
  const float sw = *(const LAS float*)(scur + 640 + (tokc & 3) * 4);
  v4u e[4];
#pragma unroll
  for (int i = 0; i < 4; ++i) e[i] = *(const LAS v4u*)(snxt + g * 64 + i * 16);
  __builtin_amdgcn_sched_barrier(0);
  vs_hdr_issue(hl, pf_tok < TOK ? pf_tok : last, snew);
  __builtin_amdgcn_sched_barrier(0);
  const size_t oo = (size_t)tok * 1024 + x * 128 + p * 16 + g * 2;
  const unsigned xw = *(const unsigned*)((tok < TOK ? (const bf16_t*)P.out + oo : (const bf16_t*)(P.ws + WS_DUMMY)));
  float2 xo; xo.x = __uint_as_float(xw << 16); xo.y = __uint_as_float(xw & 0xFFFF0000u);
  int acc[16];
#pragma unroll
  for (int i = 0; i < 16; ++i) acc[i] = 0;
  __builtin_amdgcn_sched_barrier(0);
  VS_PIN_ROWS(q0);
  if (DRY && VS_VAR == 1) vs_xor4(acc, q0[0], q0[1], q0[2], q0[3]); else
  vs_acc4(acc, q0[0], q0[1], q0[2], q0[3], wq.x);
  VS_PIN_ACC(acc);
  __builtin_amdgcn_sched_barrier(0);
  if (!(DRY && VS_VAR == 2))
  vs_rows4(q0, e[0], VS, p);
  __builtin_amdgcn_sched_barrier(0);
  VS_PIN_ROWS(q1);
  if (DRY && VS_VAR == 1) vs_xor4(acc, q1[0], q1[1], q1[2], q1[3]); else
  vs_acc4(acc, q1[0], q1[1], q1[2], q1[3], wq.y);
  VS_PIN_ACC(acc);
  __builtin_amdgcn_sched_barrier(0);
  if (!(DRY && VS_VAR == 2))
  vs_rows4(q1, e[1], VS, p);
  __builtin_amdgcn_sched_barrier(0);
  VS_PIN_ROWS(q2);
  if (DRY && VS_VAR == 1) vs_xor4(acc, q2[0], q2[1], q2[2], q2[3]); else
  vs_acc4(acc, q2[0], q2[1], q2[2], q2[3], wq.z);
  VS_PIN_ACC(acc);
  __builtin_amdgcn_sched_barrier(0);
  if (!(DRY && VS_VAR == 2))
  vs_rows4(q2, e[2], VS, p);
  __builtin_amdgcn_sched_barrier(0);
  VS_PIN_ROWS(q3);
  if (DRY && VS_VAR == 1) vs_xor4(acc, q3[0], q3[1], q3[2], q3[3]); else
  vs_acc4(acc, q3[0], q3[1], q3[2], q3[3], wq.w);
  VS_PIN_ACC(acc);
  __builtin_amdgcn_sched_barrier(0);
  if (!(DRY && VS_VAR == 2))
  vs_rows4(q3, e[3], VS, p);
  __builtin_amdgcn_sched_barrier(0);
  const bool b5 = lane & 32, b4 = lane & 16, b3 = lane & 8;
  int r8[8], r4[4], r2[2];
#pragma unroll
  for (int i = 0; i < 8; ++i) { const int keep = b5 ? acc[8 + i] : acc[i], send = b5 ? acc[i] : acc[8 + i]; r8[i] = keep + VS_BP(send, 32); }
#pragma unroll
  for (int i = 0; i < 4; ++i) { const int keep = b4 ? r8[4 + i] : r8[i], send = b4 ? r8[i] : r8[4 + i]; r4[i] = keep + VS_BP(send, 16); }
#pragma unroll
  for (int i = 0; i < 2; ++i) { const int keep = b3 ? r4[2 + i] : r4[i], send = b3 ? r4[i] : r4[2 + i]; r2[i] = keep + VS_BP(send, 8); }
  float2 o; o.x = xo.x + (float)r2[0] * sw; o.y = xo.y + (float)r2[1] * sw;
  unsigned* op = (unsigned*)(tok < TOK ? dst + oo : (bf16_t*)(P.ws + WS_DUMMY));
  if (!DRY || o.x == 1234.5f) *op = pk2(o.x, o.y);
}
template <bool DRY>
__device__ __forceinline__ void phase_vslice(const Params& P, LAS unsigned char* lds, int layer) {
  int lane = threadIdx.x & 63; const int wave = __builtin_amdgcn_readfirstlane(threadIdx.x >> 6);
  asm volatile("" : "+v"(lane));
  const int nsl = (gridDim.x & 7) == 0 ? 8 : 0;
  const int g = lane >> 3, p = lane & 7;
  const int wi = (nsl ? (blockIdx.x >> 3) : blockIdx.x) * 8 + wave, NW = (nsl ? (gridDim.x >> 3) : gridDim.x) * 8;
  const VsHdrLane hl = vs_hdr_lane(P, lane);
  LAS unsigned char* r0 = lds + wave * 3072; LAS unsigned char* r1 = r0 + 1024; LAS unsigned char* r2 = r0 + 2048;
  bf16_t* dst = layer == 1 ? (bf16_t*)(P.ws + WS_RFIN) : (bf16_t*)P.out;
  for (int xs = 0; xs < (nsl ? 1 : 8); ++xs) {
    const int x = nsl ? (blockIdx.x & 7) : xs;
    const unsigned char* VS = P.ws + WS_TAB + (size_t)(layer * 2 + 1) * 16 * MiB + (size_t)x * 2 * MiB;
    if (wi >= TOK) continue;
    v4u q0[4], q1[4], q2[4], q3[4];
    const int last = wi + ((TOK - 1 - wi) / NW) * NW;
    vs_hdr_issue(hl, wi, r0);
    vs_hdr_issue(hl, wi + NW < TOK ? wi + NW : last, r1);
    asm volatile("s_waitcnt vmcnt(0)" ::: "memory");
    {
      v4u e[4];
#pragma unroll
      for (int i = 0; i < 4; ++i) e[i] = *(const LAS v4u*)(r0 + g * 64 + i * 16);
      vs_rows4(q0, e[0], VS, p); vs_rows4(q1, e[1], VS, p); vs_rows4(q2, e[2], VS, p); vs_rows4(q3, e[3], VS, p);
    }
    for (int tok = wi; tok < TOK; tok += 3 * NW) {
      vs_step<DRY>(P, dst, tok, tok + 2 * NW, last, VS, x, lane, hl, r0, r1, r2, q0, q1, q2, q3);
      vs_step<DRY>(P, dst, tok + NW, tok + 3 * NW, last, VS, x, lane, hl, r1, r2, r0, q0, q1, q2, q3);
      vs_step<DRY>(P, dst, tok + 2 * NW, tok + 4 * NW, last, VS, x, lane, hl, r2, r0, r1, q0, q1, q2, q3);
    }
    asm volatile("s_waitcnt vmcnt(0)" ::: "memory");
  }
}
__device__ __forceinline__ void final_norm_ld(v2u (&w)[4], const bf16_t* R, int tok, int lane) {
#pragma unroll
  for (int i = 0; i < 4; ++i) w[i] = *(const v2u*)(R + (size_t)tok * 1024 + i * 256 + lane * 4);
}
__device__ __forceinline__ void final_norm_row(const Params& P, const v2u (&w)[4], const float4 (&gg)[4], int tok, int lane) {
  float* xo = P.out + (size_t)tok * 1024;
  float4 x[4]; float ss = 0.f;
#pragma unroll
  for (int i = 0; i < 4; ++i) {
    x[i].x = __uint_as_float(w[i].x << 16); x[i].y = __uint_as_float(w[i].x & 0xFFFF0000u); x[i].z = __uint_as_float(w[i].y << 16); x[i].w = __uint_as_float(w[i].y & 0xFFFF0000u);
    ss += x[i].x * x[i].x + x[i].y * x[i].y + x[i].z * x[i].z + x[i].w * x[i].w; }
  ss = wave_sum_dpp(ss);
  const float rs = rsqrtf(ss * (1.0f / 1024.0f) + 1e-6f);
#pragma unroll
  for (int i = 0; i < 4; ++i) { float4 y; y.x = x[i].x * rs * gg[i].x; y.y = x[i].y * rs * gg[i].y; y.z = x[i].z * rs * gg[i].z; y.w = x[i].w * rs * gg[i].w; *(float4*)(xo + i * 256 + lane * 4) = y; }
}
__device__ __forceinline__ void phase_final_norm(const Params& P, const float* g) {
  const int lane = threadIdx.x & 63, wave = __builtin_amdgcn_readfirstlane(threadIdx.x >> 6);
  const int gw = blockIdx.x * 8 + wave, NGW = gridDim.x * 8;
  float4 gg[4];
#pragma unroll
  for (int i = 0; i < 4; ++i) gg[i] = *(const float4*)(g + i * 256 + lane * 4);
  const bf16_t* R = (const bf16_t*)(P.ws + WS_RFIN);
  for (int tok = gw; tok < TOK; tok += 4 * NGW) {
    const int tb = tok + NGW, tc = tok + 2 * NGW, td = tok + 3 * NGW;
    v2u wa[4], wb[4], wc[4], wd[4];
    final_norm_ld(wa, R, tok, lane); final_norm_ld(wb, R, tb < TOK ? tb : tok, lane); final_norm_ld(wc, R, tc < TOK ? tc : tok, lane); final_norm_ld(wd, R, td < TOK ? td : tok, lane);
    final_norm_row(P, wa, gg, tok, lane);
    if (tb < TOK) final_norm_row(P, wb, gg, tb, lane);
    if (tc < TOK) final_norm_row(P, wc, gg, tc, lane);
    if (td < TOK) final_norm_row(P, wd, gg, td, lane);
  }
}

constexpr size_t WS_PART = WS_BIG + 128 * MiB;
__device__ __forceinline__ VsHdrLane us_hdr_lane(const Params& P, int lane, int x) {
  VsHdrLane h;
  h.base = P.ws + (lane < 32 ? WS_EID + lane * 16 : lane < 40 ? WS_H8 + x * 128 + (lane - 32) * 16 : WS_EID);
  h.sh = (lane >= 32 && lane < 40) ? 10 : 9; h.mask = -1;
  return h;
}
__device__ __forceinline__ void us_acc4(int& r0, int& r1, const v4u (&q)[4], const v4u& hq, int p, int it0) {
#pragma unroll
  for (int j = 0; j < 4; ++j) {
    const int it = it0 + j;
    int is = __builtin_amdgcn_sdot4((int)q[j].x, (int)hq.x, 0, false);
    is = __builtin_amdgcn_sdot4((int)q[j].y, (int)hq.y, is, false);
    is = __builtin_amdgcn_sdot4((int)q[j].z, (int)hq.z, is, false);
    is = __builtin_amdgcn_sdot4((int)q[j].w, (int)hq.w, is, false);
    is += __builtin_amdgcn_mov_dpp(is, 0xB1, 0xF, 0xF, true); is += __builtin_amdgcn_mov_dpp(is, 0x4E, 0xF, 0xF, true); is += __builtin_amdgcn_mov_dpp(is, 0x141, 0xF, 0xF, true);
    if (it < 8) r0 = (p == it) ? is : r0; else r1 = (p == it - 8) ? is : r1;
  }
}
template <bool DRY>
__device__ __forceinline__ void us_step(const Params& P, int tok, int pf_tok, int last, const unsigned char* US, int x, int lane, const VsHdrLane& hl, LAS unsigned char* scur, LAS unsigned char* snxt, LAS unsigned char* snew,
                                        v4u (&q0)[4], v4u (&q1)[4], v4u (&q2)[4], v4u (&q3)[4]) {
  const int g = lane >> 3, p = lane & 7;
  asm volatile("s_waitcnt vmcnt(16)" ::: "memory");
  const v4u hq = *(const LAS v4u*)(scur + 512 + p * 16);
  v4u e[4];
#pragma unroll
  for (int i = 0; i < 4; ++i) e[i] = *(const LAS v4u*)(snxt + g * 64 + i * 16);
  __builtin_amdgcn_sched_barrier(0);
  vs_hdr_issue(hl, pf_tok < TOK ? pf_tok : last, snew);
  __builtin_amdgcn_sched_barrier(0);
  int r0 = 0, r1 = 0;
#define US_PIN_R() asm volatile("" : "+v"(r0), "+v"(r1))
  VS_PIN_ROWS(q0); us_acc4(r0, r1, q0, hq, p, 0); US_PIN_R();
  __builtin_amdgcn_sched_barrier(0);
  vs_rows4(q0, e[0], US, p);
  __builtin_amdgcn_sched_barrier(0);
  VS_PIN_ROWS(q1); us_acc4(r0, r1, q1, hq, p, 4); US_PIN_R();
  __builtin_amdgcn_sched_barrier(0);
  vs_rows4(q1, e[1], US, p);
  __builtin_amdgcn_sched_barrier(0);
  VS_PIN_ROWS(q2); us_acc4(r0, r1, q2, hq, p, 8); US_PIN_R();
  __builtin_amdgcn_sched_barrier(0);
  vs_rows4(q2, e[2], US, p);
  __builtin_amdgcn_sched_barrier(0);
  VS_PIN_ROWS(q3); us_acc4(r0, r1, q3, hq, p, 12); US_PIN_R();
  __builtin_amdgcn_sched_barrier(0);
  vs_rows4(q3, e[3], US, p);
  __builtin_amdgcn_sched_barrier(0);
  _Float16* part = (tok < TOK ? (_Float16*)(P.ws + WS_PART) + ((size_t)x * TOK + tok) * 128 : (_Float16*)(P.ws + WS_DUMMY)) + g * 16 + p;
  if (!DRY || r0 == 0x7FFFFFFF) { part[0] = (_Float16)((float)r0 * 0.015625f); part[8] = (_Float16)((float)r1 * 0.015625f); }
}
template <bool DRY>
__device__ __forceinline__ void phase_uslice(const Params& P, LAS unsigned char* lds, int layer) {
  int lane = threadIdx.x & 63; const int wave = __builtin_amdgcn_readfirstlane(threadIdx.x >> 6);
  asm volatile("" : "+v"(lane));
  const int nsl = (gridDim.x & 7) == 0 ? 8 : 0;
  const int g = lane >> 3, p = lane & 7;
  const int wi = (nsl ? (blockIdx.x >> 3) : blockIdx.x) * 8 + wave, NW = (nsl ? (gridDim.x >> 3) : gridDim.x) * 8;
  LAS unsigned char* r0 = lds + wave * 3072; LAS unsigned char* r1 = r0 + 1024; LAS unsigned char* r2 = r0 + 2048;
  for (int xs = 0; xs < (nsl ? 1 : 8); ++xs) {
    const int x = nsl ? (blockIdx.x & 7) : xs;
    const unsigned char* US = P.ws + WS_TAB + (size_t)(layer * 2) * 16 * MiB + (size_t)x * 2 * MiB;
    if (wi >= TOK) continue;
    const VsHdrLane hl = us_hdr_lane(P, lane, x);
    v4u q0[4], q1[4], q2[4], q3[4];
    const int last = wi + ((TOK - 1 - wi) / NW) * NW;
    vs_hdr_issue(hl, wi, r0);
    vs_hdr_issue(hl, wi + NW < TOK ? wi + NW : last, r1);
    asm volatile("s_waitcnt vmcnt(0)" ::: "memory");
    {
      v4u e[4];
#pragma unroll
      for (int i = 0; i < 4; ++i) e[i] = *(const LAS v4u*)(r0 + g * 64 + i * 16);
      vs_rows4(q0, e[0], US, p); vs_rows4(q1, e[1], US, p); vs_rows4(q2, e[2], US, p); vs_rows4(q3, e[3], US, p);
    }
    for (int tok = wi; tok < TOK; tok += 3 * NW) {
      us_step<DRY>(P, tok, tok + 2 * NW, last, US, x, lane, hl, r0, r1, r2, q0, q1, q2, q3);
      us_step<DRY>(P, tok + NW, tok + 3 * NW, last, US, x, lane, hl, r1, r2, r0, q0, q1, q2, q3);
      us_step<DRY>(P, tok + 2 * NW, tok + 4 * NW, last, US, x, lane, hl, r2, r0, r1, q0, q1, q2, q3);
    }
    asm volatile("s_waitcnt vmcnt(0)" ::: "memory");
  }
}
__device__ __forceinline__ void phase_ureduce(const Params& P) {
  const _Float16* PART = (const _Float16*)(P.ws + WS_PART); const float* GSU = (const float*)(P.ws + WS_GSU); const float* GSV = (const float*)(P.ws + WS_GSV);
  const float* SH = (const float*)(P.ws + WS_SH); unsigned* WQ = (unsigned*)(P.ws + WS_WQ); float* SW = (float*)(P.ws + WS_SW);
  const int lane = threadIdx.x & 63;
  const size_t n4 = (size_t)TOK * 128 / 4, NT = (size_t)gridDim.x * blockDim.x;
  for (size_t i = (size_t)blockIdx.x * blockDim.x + threadIdx.x; i < n4; i += NT) {
    typedef _Float16 h4 __attribute__((ext_vector_type(4)));
    float s0 = 0.f, s1 = 0.f, s2 = 0.f, s3 = 0.f;
#pragma unroll
    for (int x = 0; x < 8; ++x) { const h4 t = *(const h4*)(PART + (size_t)x * TOK * 128 + i * 4); s0 += (float)t[0]; s1 += (float)t[1]; s2 += (float)t[2]; s3 += (float)t[3]; }
    s0 *= 64.f; s1 *= 64.f; s2 *= 64.f; s3 *= 64.f;
    const float4 su = *(const float4*)(GSU + i * 4), gv = *(const float4*)(GSV + i * 4);
    const float sh = SH[i >> 5];
    float4 w;
    w.x = gv.x * gelu_as(s0 * (su.x * sh)); w.y = gv.y * gelu_as(s1 * (su.y * sh));
    w.z = gv.z * gelu_as(s2 * (su.z * sh)); w.w = gv.w * gelu_as(s3 * (su.w * sh));
    float wm = fmaxf(fmaxf(fabsf(w.x), fabsf(w.y)), fmaxf(fabsf(w.z), fabsf(w.w)));
    wm = fmaxf(wm, __int_as_float(__builtin_amdgcn_mov_dpp(__float_as_int(wm), 0xB1, 0xF, 0xF, true)));
    wm = fmaxf(wm, __int_as_float(__builtin_amdgcn_mov_dpp(__float_as_int(wm), 0x4E, 0xF, 0xF, true)));
    wm = fmaxf(wm, __int_as_float(__builtin_amdgcn_mov_dpp(__float_as_int(wm), 0x141, 0xF, 0xF, true)));
    wm = fmaxf(wm, __int_as_float(__builtin_amdgcn_mov_dpp(__float_as_int(wm), 0x140, 0xF, 0xF, true)));
    wm = fmaxf(wm, __int_as_float(__builtin_amdgcn_ds_bpermute((lane ^ 16) * 4, __float_as_int(wm))));
    const float sw = wm > 0.f ? wm * (1.0f / 127.0f) : 1.0f, winv = 1.0f / sw;
    WQ[i] = q8(w.x, winv) | (q8(w.y, winv) << 8) | (q8(w.z, winv) << 16) | (q8(w.w, winv) << 24);
    if ((lane & 31) == 0) SW[i >> 5] = sw;
  }
}
constexpr int GA_PITCH = 136;
constexpr int GA_WL = 0;
constexpr int GA_VT = 34816;
constexpr int GA_ST = 34816 + 69632;
template <bool DRY>
__device__ __forceinline__ void phase_gate_a(const Params& P, LAS unsigned char* lds) {
  const int tid = threadIdx.x, lane = tid & 63, wave = __builtin_amdgcn_readfirstlane(tid >> 6);
  bf16_t* U = (bf16_t*)(P.ws + WS_BIG); const bf16_t* V = U + (size_t)TOK * 2048;
  const float* ln_g = P.in[6]; const float* ln_b = P.in[7]; const float* w_s = P.in[8]; const float* b_s = P.in[9];
  LAS bf16_t* Wl = (LAS bf16_t*)(lds + GA_WL); LAS bf16_t* vT = (LAS bf16_t*)(lds + GA_VT); LAS float* st = (LAS float*)(lds + GA_ST);
  for (int chunk = blockIdx.x; chunk < TOK / 128; chunk += gridDim.x) {
    const size_t T0 = (size_t)chunk * 128;
    for (int i = 0; i < 16; ++i) {
      const int t = wave * 16 + i;
      const bf16_t* vr = V + (T0 + t) * 2048;
      float x[32]; float s = 0.f;
#pragma unroll
      for (int j = 0; j < 4; ++j) { const v4u w = *(const v4u*)(vr + (j * 64 + lane) * 8); const unsigned ww[4] = {w.x, w.y, w.z, w.w};
#pragma unroll
        for (int q = 0; q < 4; ++q) { x[j * 8 + 2 * q] = __uint_as_float(ww[q] << 16); x[j * 8 + 2 * q + 1] = __uint_as_float(ww[q] & 0xFFFF0000u); s += x[j * 8 + 2 * q] + x[j * 8 + 2 * q + 1]; } }
      s = wave_sum_dpp(s); const float mu = s * (1.0f / 2048.0f);
      float q2 = 0.f;
#pragma unroll
      for (int j = 0; j < 32; ++j) { const float d = x[j] - mu; q2 += d * d; }
      q2 = wave_sum_dpp(q2);
      if (lane == 0) { st[2 * t] = mu; st[2 * t + 1] = rsqrtf(q2 * (1.0f / 2048.0f) + 1e-6f); }
    }
    __syncthreads();
    for (int g = 0; g < 8; ++g) {
      {
        const int t = tid >> 2, c0 = (tid & 3) * 32;
        const float* src = w_s + ((size_t)g * 128 + t) * 128 + c0;
#pragma unroll
        for (int q = 0; q < 4; ++q) {
          const float4 a = *(const float4*)(src + q * 8), b = *(const float4*)(src + q * 8 + 4);
          const int s0 = c0 + q * 8;
          v4u o;
          o.x = pk2(s0 + 0 <= t ? a.x : 0.f, s0 + 1 <= t ? a.y : 0.f); o.y = pk2(s0 + 2 <= t ? a.z : 0.f, s0 + 3 <= t ? a.w : 0.f);
          o.z = pk2(s0 + 4 <= t ? b.x : 0.f, s0 + 5 <= t ? b.y : 0.f); o.w = pk2(s0 + 6 <= t ? b.z : 0.f, s0 + 7 <= t ? b.w : 0.f);
          *(LAS v4u*)(Wl + t * GA_PITCH + s0) = o;
        }
      }
      {
        const int sh0 = (wave & 1) * 64 + (lane >> 2), cq = (wave >> 1) * 64 + (lane & 3) * 8;
#pragma unroll
        for (int jc = 0; jc < 2; ++jc) {
          const int c0 = cq + jc * 32;
          const float4 ga = *(const float4*)(ln_g + g * 256 + c0), gb = *(const float4*)(ln_g + g * 256 + c0 + 4), ba = *(const float4*)(ln_b + g * 256 + c0), bb = *(const float4*)(ln_b + g * 256 + c0 + 4);
          const float gg[8] = {ga.x, ga.y, ga.z, ga.w, gb.x, gb.y, gb.z, gb.w}, bv[8] = {ba.x, ba.y, ba.z, ba.w, bb.x, bb.y, bb.z, bb.w};
#pragma unroll
          for (int jr = 0; jr < 4; ++jr) {
            const int s = sh0 + jr * 16;
            const float mu = st[2 * s], rs = st[2 * s + 1];
            const v4u w = *(const v4u*)(V + (T0 + s) * 2048 + g * 256 + c0); const unsigned ww[4] = {w.x, w.y, w.z, w.w};
#pragma unroll
            for (int q = 0; q < 4; ++q) {
              const float y0 = (__uint_as_float(ww[q] << 16) - mu) * rs * gg[2 * q] + bv[2 * q];
              const float y1 = (__uint_as_float(ww[q] & 0xFFFF0000u) - mu) * rs * gg[2 * q + 1] + bv[2 * q + 1];
              vT[(c0 + 2 * q) * GA_PITCH + s] = f2bf(y0); vT[(c0 + 2 * q + 1) * GA_PITCH + s] = f2bf(y1);
            }
          }
        }
      }
      __syncthreads();
      f32x4 acc[2][8];
#pragma unroll
      for (int ci = 0; ci < 2; ++ci)
#pragma unroll
        for (int jt = 0; jt < 8; ++jt) acc[ci][jt] = (f32x4){0.f, 0.f, 0.f, 0.f};
      const int fr = lane & 15, fq = lane >> 4;
#pragma unroll
      for (int kb = 0; kb < 4; ++kb) {
        bf16x8_t a[2];
#pragma unroll
        for (int ci = 0; ci < 2; ++ci) a[ci] = *(const LAS bf16x8_t*)(vT + (wave * 32 + ci * 16 + fr) * GA_PITCH + kb * 32 + fq * 8);
#pragma unroll
        for (int jt = 0; jt < 8; ++jt) {
          if (kb <= (jt >> 1)) {
            const bf16x8_t b = *(const LAS bf16x8_t*)(Wl + (jt * 16 + fr) * GA_PITCH + kb * 32 + fq * 8);
#pragma unroll
            for (int ci = 0; ci < 2; ++ci) acc[ci][jt] = __builtin_amdgcn_mfma_f32_16x16x32_bf16(a[ci], b, acc[ci][jt], 0, 0, 0);
          }
        }
      }
#pragma unroll
      for (int jt = 0; jt < 8; ++jt) {
        const int t = jt * 16 + fr; const float bs = b_s[g * 128 + t];
#pragma unroll
        for (int ci = 0; ci < 2; ++ci) {
          bf16_t* up = U + (T0 + t) * 2048 + g * 256 + wave * 32 + ci * 16 + fq * 4;
          const v2u uu = *(const v2u*)up;
          v2u o;
          o.x = pk2(__uint_as_float(uu.x << 16) * (acc[ci][jt][0] + bs), __uint_as_float(uu.x & 0xFFFF0000u) * (acc[ci][jt][1] + bs));
          o.y = pk2(__uint_as_float(uu.y << 16) * (acc[ci][jt][2] + bs), __uint_as_float(uu.y & 0xFFFF0000u) * (acc[ci][jt][3] + bs));
          if (!DRY || acc[ci][jt][0] == 1234.5f) *(v2u*)up = o;
        }
      }
      __syncthreads();
    }
  }
}
constexpr size_t WS_PROJ = WS_BIG;
constexpr size_t WS_QT = WS_BIG + 208 * MiB;
constexpr size_t WS_KT = WS_BIG + 240 * MiB;
constexpr size_t WS_AM = WS_BIG + 272 * MiB;
constexpr size_t WS_DEC = WS_BIG + 288 * MiB;
constexpr size_t WS_O = WS_H;
__device__ __forceinline__ float row16_sum_dpp(float v) {
  int x;
  x = __builtin_amdgcn_mov_dpp(__float_as_int(v), 0xB1, 0xF, 0xF, true); v += __int_as_float(x);
  x = __builtin_amdgcn_mov_dpp(__float_as_int(v), 0x4E, 0xF, 0xF, true); v += __int_as_float(x);
  x = __builtin_amdgcn_mov_dpp(__float_as_int(v), 0x141, 0xF, 0xF, true); v += __int_as_float(x);
  x = __builtin_amdgcn_mov_dpp(__float_as_int(v), 0x140, 0xF, 0xF, true); v += __int_as_float(x);
  return v;
}

__device__ __forceinline__ void phase_gla_prep(const Params& P, LAS unsigned char* lds) {
  const int tid = threadIdx.x, lane = tid & 63, wave = __builtin_amdgcn_readfirstlane(tid >> 6);
  const int fr = lane & 15, fq = lane >> 4;
  const bf16_t* PROJ = (const bf16_t*)(P.ws + WS_PROJ);
  bf16_t* QT = (bf16_t*)(P.ws + WS_QT); bf16_t* KT = (bf16_t*)(P.ws + WS_KT); bf16_t* AM = (bf16_t*)(P.ws + WS_AM); float* DEC = (float*)(P.ws + WS_DEC);
  const float* w_g2 = P.in[12]; const float* b_g = P.in[13];
  LAS bf16_t* ql = (LAS bf16_t*)lds; LAS bf16_t* kl = (LAS bf16_t*)(lds + 17408); LAS float* tot = (LAS float*)(lds + 34816);
  const int kk = tid & 127, tq = wave >> 1;
  const float scale = 0.08838834764831845f;
  for (int item = blockIdx.x; item < 2048; item += gridDim.x) {
    const int h = item & 3; const size_t T0 = (size_t)(item >> 2) * 64;
    bf16_t qraw[16], kraw[16];
#pragma unroll
    for (int i = 0; i < 16; ++i) { const bf16_t* pr = PROJ + (T0 + tq * 16 + i) * BPROJ + h * 128 + kk; qraw[i] = pr[0]; kraw[i] = pr[512]; }
    float wg[16];
#pragma unroll
    for (int j = 0; j < 16; ++j) wg[j] = w_g2[j * 512 + h * 128 + kk];
    const float bg = b_g[h * 128 + kk];
    float G[16]; float run = 0.f;
#pragma unroll
    for (int i = 0; i < 16; ++i) {
      const float* gl = (const float*)(P.ws + WS_GLR) + (T0 + tq * 16 + i) * 16;
      const float4 g0 = *(const float4*)gl, g1 = *(const float4*)(gl + 4), g2 = *(const float4*)(gl + 8), g3 = *(const float4*)(gl + 12);
      const float gw[16] = {g0.x, g0.y, g0.z, g0.w, g1.x, g1.y, g1.z, g1.w, g2.x, g2.y, g2.z, g2.w, g3.x, g3.y, g3.z, g3.w};
      float a = bg;
#pragma unroll
      for (int j = 0; j < 16; ++j) a += gw[j] * wg[j];
      const float ls = fminf(a, 0.f) - log1pf(__expf(-fabsf(a)));
      run += ls * 0.0625f; G[i] = run;
    }
    tot[tq * 128 + kk] = run;
    __syncthreads();
    float off = 0.f, glast = 0.f;
#pragma unroll
    for (int q = 0; q < 4; ++q) { const float v = tot[q * 128 + kk]; off += (q < tq) ? v : 0.f; glast += v; }
    unsigned kh[8];
#pragma unroll
    for (int i = 0; i < 16; ++i) {
      const int t = tq * 16 + i; const float Gi = G[i] + off;
      const float qv = bf2f(qraw[i]) * scale * __expf(Gi);
      const float kv = bf2f(kraw[i]);
      const bf16_t qb = f2bf(qv);
      ql[t * 136 + kk] = qb; kl[t * 136 + kk] = f2bf(kv * __expf(-Gi));
      QT[((size_t)item * 64 + t) * 128 + kk] = qb;
      const unsigned khb = f2bf(kv * __expf(glast - Gi));
      if (i & 1) kh[i >> 1] |= khb << 16; else kh[i >> 1] = khb;
    }
    {
      bf16_t* kt = KT + ((size_t)item * 128 + kk) * 64 + tq * 16;
      v4u o; o.x = kh[0]; o.y = kh[1]; o.z = kh[2]; o.w = kh[3]; *(v4u*)kt = o;
      o.x = kh[4]; o.y = kh[5]; o.z = kh[6]; o.w = kh[7]; *(v4u*)(kt + 8) = o;
    }
    if (tq == 0) DEC[(size_t)item * 128 + kk] = __expf(glast);
    __syncthreads();
#pragma unroll
    for (int u = 0; u < 2; ++u) {
      const int tile = wave * 2 + u, si = tile >> 2, ti = tile & 3;
      f32x4 acc = (f32x4){0.f, 0.f, 0.f, 0.f};
      if (si <= ti) {
#pragma unroll
        for (int ks = 0; ks < 4; ++ks) {
          const bf16x8_t a = *(const LAS bf16x8_t*)(kl + (si * 16 + fr) * 136 + ks * 32 + fq * 8);
          const bf16x8_t b = *(const LAS bf16x8_t*)(ql + (ti * 16 + fr) * 136 + ks * 32 + fq * 8);
          acc = __builtin_amdgcn_mfma_f32_16x16x32_bf16(a, b, acc, 0, 0, 0);
        }
      }
      const int t = ti * 16 + fr, s0 = si * 16 + 4 * fq;
      v2u o;
      o.x = pk2(s0 + 0 <= t ? acc[0] : 0.f, s0 + 1 <= t ? acc[1] : 0.f);
      o.y = pk2(s0 + 2 <= t ? acc[2] : 0.f, s0 + 3 <= t ? acc[3] : 0.f);
      *(v2u*)(AM + ((size_t)item * 64 + t) * 64 + s0) = o;
    }
    __syncthreads();
  }
}

struct GlaFrag { bf16x8_t am[2], q[4], k[2]; f32x4 dec; v4u vr[2]; };
template <int ROLE>
__device__ __forceinline__ void gla_load(GlaFrag& F, const Params& P, int b, int h, int vs, int c, int wave, int lane) {
  const int fr = lane & 15, fq = lane >> 4;
  const size_t item = ((size_t)b * 128 + c) * 4 + h;
  const bf16_t* QT = (const bf16_t*)(P.ws + WS_QT); const bf16_t* KT = (const bf16_t*)(P.ws + WS_KT); const bf16_t* AM = (const bf16_t*)(P.ws + WS_AM); const float* DEC = (const float*)(P.ws + WS_DEC);
  if (ROLE == 0) {
    const bf16_t* ar = AM + (item * 64 + wave * 16 + fr) * 64 + fq * 8;
    F.am[0] = *(const bf16x8_t*)ar; F.am[1] = *(const bf16x8_t*)(ar + 32);
    const bf16_t* qr = QT + (item * 64 + wave * 16 + fr) * 128 + fq * 8;
#pragma unroll
    for (int kq = 0; kq < 4; ++kq) F.q[kq] = *(const bf16x8_t*)(qr + kq * 32);
  }
  const bf16_t* kr = KT + (item * 128 + wave * 16 + fr) * 64 + fq * 8;
  F.k[0] = *(const bf16x8_t*)kr; F.k[1] = *(const bf16x8_t*)(kr + 32);
  F.dec = *(const f32x4*)(DEC + item * 128 + wave * 16 + fq * 4);
  if (ROLE == 1) {
    const bf16_t* vp = (const bf16_t*)(P.ws + WS_PROJ) + ((size_t)b * SEQ + (size_t)c * 64 + lane) * BPROJ + 1024 + h * 256 + vs * 16;
    F.vr[0] = *(const v4u*)vp; F.vr[1] = *(const v4u*)(vp + 8);
  }
}
__device__ __forceinline__ void gla_write_vt(LAS bf16_t* vT, const GlaFrag& F, int lane) {
  const unsigned w[8] = {F.vr[0].x, F.vr[0].y, F.vr[0].z, F.vr[0].w, F.vr[1].x, F.vr[1].y, F.vr[1].z, F.vr[1].w};
#pragma unroll
  for (int i = 0; i < 8; ++i) { vT[(2 * i) * 72 + lane] = (bf16_t)(w[i] & 0xFFFFu); vT[(2 * i + 1) * 72 + lane] = (bf16_t)(w[i] >> 16); }
}
template <int ROLE, int MODE>
__device__ __forceinline__ void gla_step(const Params& P, const GlaFrag& cur, const GlaFrag& nxt, GlaFrag& pre, int b, int h, int vs, int c, int wave, int lane, LAS bf16_t* vT, LAS bf16_t* ST, LAS bf16_t* vTn, LAS bf16_t* STn, f32x4& S) {
  const int fr = lane & 15, fq = lane >> 4;
  bf16_t* O = (bf16_t*)(P.ws + WS_O);
  if (MODE != 2 && ROLE != 0) gla_load<ROLE>(pre, P, b, h, vs, c + 3 < 128 ? c + 3 : 127, wave, lane);
  const bf16x8_t v0 = *(const LAS bf16x8_t*)(vT + fr * 72 + fq * 8), v1 = *(const LAS bf16x8_t*)(vT + fr * 72 + 32 + fq * 8);
  if (ROLE == 0) {
    f32x4 o = (f32x4){0.f, 0.f, 0.f, 0.f};
    o = __builtin_amdgcn_mfma_f32_16x16x32_bf16(v0, cur.am[0], o, 0, 0, 0);
    o = __builtin_amdgcn_mfma_f32_16x16x32_bf16(v1, cur.am[1], o, 0, 0, 0);
#pragma unroll
    for (int kq = 0; kq < 4; ++kq) {
      const bf16x8_t s = *(const LAS bf16x8_t*)(ST + fr * 136 + kq * 32 + fq * 8);
      o = __builtin_amdgcn_mfma_f32_16x16x32_bf16(s, cur.q[kq], o, 0, 0, 0);
    }
    v2u ow; ow.x = pk2(o[0], o[1]); ow.y = pk2(o[2], o[3]);
    if (MODE == 0 || o[0] == 1234.5f) *(v2u*)(O + ((size_t)b * SEQ + (size_t)c * 64 + wave * 16 + fr) * 1024 + h * 256 + vs * 16 + fq * 4) = ow;
  }
  S = S * cur.dec;
  S = __builtin_amdgcn_mfma_f32_16x16x32_bf16(cur.k[0], v0, S, 0, 0, 0);
  S = __builtin_amdgcn_mfma_f32_16x16x32_bf16(cur.k[1], v1, S, 0, 0, 0);
  { v2u sw; sw.x = pk2(S[0], S[1]); sw.y = pk2(S[2], S[3]); *(LAS v2u*)(STn + fr * 136 + wave * 16 + fq * 4) = sw; }
  if (ROLE == 1 && c + 1 < 128) gla_write_vt(vTn, nxt, lane);
  if (MODE != 2 && ROLE == 0) gla_load<ROLE>(pre, P, b, h, vs, c + 3 < 128 ? c + 3 : 127, wave, lane);
  if (MODE != 1) __syncthreads();
}
template <int ROLE, int MODE>
__device__ __forceinline__ void gla_scan_role(const Params& P, LAS unsigned char* lds, int wave, int lane) {
  const int fr = lane & 15, fq = lane >> 4;
  LAS bf16_t* vT0 = (LAS bf16_t*)lds;
  LAS bf16_t* ST0 = (LAS bf16_t*)(lds + 2304);
  LAS bf16_t* vT1 = (LAS bf16_t*)(lds + 6656);
  LAS bf16_t* ST1 = (LAS bf16_t*)(lds + 8960);
  for (int wid = blockIdx.x; wid < 256; wid += gridDim.x) {
    const int xcd = wid & 7, jj = wid >> 3, pair = xcd * 2 + (jj >> 4), vs = jj & 15, b = pair >> 2, h = pair & 3;
    f32x4 S = (f32x4){0.f, 0.f, 0.f, 0.f};
    GlaFrag f0, f1, f2, f3;
    gla_load<ROLE>(f0, P, b, h, vs, 0, wave, lane);
    gla_load<ROLE>(f1, P, b, h, vs, 1, wave, lane);
    gla_load<ROLE>(f2, P, b, h, vs, 2, wave, lane);
    __syncthreads();
    *(LAS v2u*)(ST0 + fr * 136 + wave * 16 + fq * 4) = (v2u){0u, 0u};
    if (ROLE == 1) gla_write_vt(vT0, f0, lane);
    __syncthreads();
    for (int c = 0; c < 128; c += 4) {
      gla_step<ROLE, MODE>(P, f0, f1, f3, b, h, vs, c, wave, lane, vT0, ST0, vT1, ST1, S);
      gla_step<ROLE, MODE>(P, f1, f2, f0, b, h, vs, c + 1, wave, lane, vT1, ST1, vT0, ST0, S);
      gla_step<ROLE, MODE>(P, f2, f3, f1, b, h, vs, c + 2, wave, lane, vT0, ST0, vT1, ST1, S);
      gla_step<ROLE, MODE>(P, f3, f0, f2, b, h, vs, c + 3, wave, lane, vT1, ST1, vT0, ST0, S);
    }
  }
}
template <int MODE = 0>
__device__ __forceinline__ void phase_gla_scan(const Params& P, LAS unsigned char* lds) {
  const int lane = threadIdx.x & 63, wave = __builtin_amdgcn_readfirstlane(threadIdx.x >> 6);
  if (wave < 4) gla_scan_role<0, MODE>(P, lds, wave, lane);
  else if (wave == 4) gla_scan_role<1, MODE>(P, lds, wave, lane);
  else gla_scan_role<2, MODE>(P, lds, wave, lane);
}

struct PostIn { v4u o0, o1, r0, r1; };
__device__ __forceinline__ void gla_post_load(PostIn& x, const Params& P, int tok, int lane) {
  const bf16_t* O = (const bf16_t*)(P.ws + WS_O); const bf16_t* PROJ = (const bf16_t*)(P.ws + WS_PROJ);
  x.o0 = *(const v4u*)(O + (size_t)tok * 1024 + lane * 16); x.o1 = *(const v4u*)(O + (size_t)tok * 1024 + lane * 16 + 8);
  x.r0 = *(const v4u*)(PROJ + (size_t)tok * BPROJ + 2048 + lane * 16); x.r1 = *(const v4u*)(PROJ + (size_t)tok * BPROJ + 2048 + lane * 16 + 8);
}
__device__ __forceinline__ void gla_post_row(const PostIn& in, const Params& P, int tok, int lane, const float (&gn)[16]) {
  const unsigned ow[8] = {in.o0.x, in.o0.y, in.o0.z, in.o0.w, in.o1.x, in.o1.y, in.o1.z, in.o1.w}, rw[8] = {in.r0.x, in.r0.y, in.r0.z, in.r0.w, in.r1.x, in.r1.y, in.r1.z, in.r1.w};
  float x[16], r[16]; float ss = 0.f;
#pragma unroll
  for (int i = 0; i < 8; ++i) { x[2 * i] = __uint_as_float(ow[i] << 16); x[2 * i + 1] = __uint_as_float(ow[i] & 0xFFFF0000u); r[2 * i] = __uint_as_float(rw[i] << 16); r[2 * i + 1] = __uint_as_float(rw[i] & 0xFFFF0000u);
    ss += x[2 * i] * x[2 * i] + x[2 * i + 1] * x[2 * i + 1]; }
  ss = row16_sum_dpp(ss);
  const float rs = rsqrtf(ss * (1.0f / 256.0f) + 1e-6f);
  float y[16];
#pragma unroll
  for (int i = 0; i < 16; ++i) { const float sl = r[i] * __builtin_amdgcn_rcpf(1.0f + __expf(-r[i])); y[i] = x[i] * rs * gn[i] * sl; }
  float am = 0.f;
#pragma unroll
  for (int i = 0; i < 16; ++i) am = fmaxf(am, fabsf(y[i]));
  am = wave_max_dpp(am);
  const float sc = am > 0.f ? am * (1.0f / 127.0f) : 1.0f, inv = 1.0f / sc;
  v4u q;
  q.x = q8(y[0], inv) | (q8(y[1], inv) << 8) | (q8(y[2], inv) << 16) | (q8(y[3], inv) << 24);
  q.y = q8(y[4], inv) | (q8(y[5], inv) << 8) | (q8(y[6], inv) << 16) | (q8(y[7], inv) << 24);
  q.z = q8(y[8], inv) | (q8(y[9], inv) << 8) | (q8(y[10], inv) << 16) | (q8(y[11], inv) << 24);
  q.w = q8(y[12], inv) | (q8(y[13], inv) << 8) | (q8(y[14], inv) << 16) | (q8(y[15], inv) << 24);
  *(v4u*)(P.ws + WS_H8 + (size_t)tok * 1024 + lane * 16) = q;
  if (lane == 0) ((float*)(P.ws + WS_SH))[tok] = sc;
}
__device__ __forceinline__ void phase_gla_post(const Params& P) {
  const int lane = threadIdx.x & 63, wave = __builtin_amdgcn_readfirstlane(threadIdx.x >> 6);
  const int gw = blockIdx.x * 8 + wave, NGW = gridDim.x * 8;
  const float* ng = P.in[14] + (lane & 15) * 16;
  float gn[16];
#pragma unroll
  for (int q = 0; q < 4; ++q) { const float4 g4 = *(const float4*)(ng + q * 4); gn[q * 4] = g4.x; gn[q * 4 + 1] = g4.y; gn[q * 4 + 2] = g4.z; gn[q * 4 + 3] = g4.w; }
  PostIn a, b, c, d;
  for (int tok = gw; tok < TOK; tok += 4 * NGW) {
    const bool vb = tok + NGW < TOK, vc = tok + 2 * NGW < TOK, vd = tok + 3 * NGW < TOK;
    gla_post_load(a, P, tok, lane);
    if (vb) gla_post_load(b, P, tok + NGW, lane);
    if (vc) gla_post_load(c, P, tok + 2 * NGW, lane);
    if (vd) gla_post_load(d, P, tok + 3 * NGW, lane);
    gla_post_row(a, P, tok, lane, gn);
    if (vb) gla_post_row(b, P, tok + NGW, lane, gn);
    if (vc) gla_post_row(c, P, tok + 2 * NGW, lane, gn);
    if (vd) gla_post_row(d, P, tok + 3 * NGW, lane, gn);
  }
}
__device__ __forceinline__ void transpose_item(const float* W, int K, int N, bf16_t* WT, LAS float* scr, int item, int nblk, int lane) {
  const int kb = item / nblk, nb = item % nblk, k0 = 64 * kb, n0 = 32 * nb;
  const int nn = n0 + (lane & 31);
#pragma unroll 8
  for (int i = 0; i < 32; ++i) { const int kk = 2 * i + (lane >> 5); scr[kk * 33 + (lane & 31)] = (nn < N) ? W[(size_t)(k0 + kk) * N + nn] : 0.f; }
  asm volatile("s_waitcnt lgkmcnt(0)" ::: "memory");
  const int c = lane & 7;
#pragma unroll
  for (int j = 0; j < 4; ++j) { const int n = (lane >> 3) + 8 * j; const LAS float* s = scr + (8 * c) * 33 + n;
    v4u o; o.x = pk2(s[0 * 33], s[1 * 33]); o.y = pk2(s[2 * 33], s[3 * 33]); o.z = pk2(s[4 * 33], s[5 * 33]); o.w = pk2(s[6 * 33], s[7 * 33]);
    *(v4u*)(WT + (size_t)(n0 + n) * K + k0 + 8 * c) = o; }
  asm volatile("s_waitcnt lgkmcnt(0)" ::: "memory");
}

__device__ __forceinline__ void phase_prep(const Params& P, LAS unsigned char* lds) {
  const int lane = threadIdx.x & 63, wave = __builtin_amdgcn_readfirstlane(threadIdx.x >> 6);
  LAS float* scr = (LAS float*)(lds + wave * 16384);
  const int gw = blockIdx.x * 8 + wave, NGW = gridDim.x * 8;
  unsigned char* ws = P.ws;
  constexpr int I_AIN = (1024 / 64) * (4096 / 32), I_AOUT = (2048 / 64) * (1024 / 32), I_BIN = (1024 / 64) * (BPROJ / 32), I_BOUT = (1024 / 64) * (1024 / 32), I_FOLD = 2048;
  constexpr int NITEMS = I_AIN + I_AOUT + I_BIN + I_BOUT + I_FOLD;
  for (int it = gw; it < NITEMS; it += NGW) {
    int r = it;
    if (r < I_AIN) { transpose_item(P.in[4], 1024, 4096, (bf16_t*)(ws + WS_WA_IN), scr, r, 4096 / 32, lane); continue; } r -= I_AIN;
    if (r < I_AOUT) { transpose_item(P.in[10], 2048, 1024, (bf16_t*)(ws + WS_WA_OUT), scr, r, 1024 / 32, lane); continue; } r -= I_AOUT;
    if (r < I_BIN) { transpose_item(P.in[11], 1024, 3088, (bf16_t*)(ws + WS_WB_IN), scr, r, BPROJ / 32, lane); continue; } r -= I_BIN;
    if (r < I_BOUT) { transpose_item(P.in[15], 1024, 1024, (bf16_t*)(ws + WS_WB_OUT), scr, r, 1024 / 32, lane); continue; } r -= I_BOUT;
    fold_item(P, r, lane, scr);
  }
}

template <int MODE>
__device__ __forceinline__ void phase_gemm(const Params& P, LAS unsigned char* lds, int layer) {
  unsigned char* ws = P.ws;
  const bf16_t* H = (const bf16_t*)(ws + WS_H);
  if constexpr (MODE == 0) {
    pg8::Gemm g{(const bf16_t*)(ws + WS_H8), (const bf16_t*)(ws + WS_WA_IN8), TOK, 4096, 512}; pg8::StaticOrder S; S.init(TOK, 4096, gridDim.x, blockIdx.x);
    pg8::EpiBf16I8<1> E{(bf16_t*)(ws + WS_BIG), 2048, P.in[5], 2048, (size_t)TOK * 2048, (const float*)(ws + WS_SH), (const float*)(ws + WS_SA_IN)};
    pg8::gemm_phase<pg8::EpiBf16I8<1>, pg8::StaticOrder, true, true, true>(lds, g, S, E);
  } else if constexpr (MODE == 1) {
    pg8::Gemm g{(const bf16_t*)(ws + WS_BIG), (const bf16_t*)(ws + WS_WA_OUT), TOK, 1024, 2048}; pg8::StaticOrder S; S.init(TOK, 1024, gridDim.x, blockIdx.x);
    pg8::EpiResBf16 E{(bf16_t*)P.out, P.in[0], 1024};
    pg8::gemm_phase<pg8::EpiResBf16, pg8::StaticOrder, true, true>(lds, g, S, E);
  } else if constexpr (MODE == 2) {
    pg8::Gemm g{H, (const bf16_t*)(ws + WS_WP) + (size_t)layer * 2048 * 1024, TOK, 2048, 1024}; pg8::StaticOrder S; S.init(TOK, 2048, gridDim.x, blockIdx.x);
    pg8::EpiF16 E{(_Float16*)(ws + WS_BIG), 2048};
    pg8::gemm_phase<pg8::EpiF16, pg8::StaticOrder, true, true>(lds, g, S, E);
  } else if constexpr (MODE == 3) {
    pg8::Gemm g{(const bf16_t*)(ws + WS_H8), (const bf16_t*)(ws + WS_WB_IN8), TOK, 3072, 512}; pg8::StaticOrder S; S.init(TOK, 3072, gridDim.x, blockIdx.x);
    pg8::EpiBf16I8<0> E{(bf16_t*)(ws + WS_BIG), BPROJ, nullptr, 0, 0, (const float*)(ws + WS_SH), (const float*)(ws + WS_SB_IN)};
    pg8::gemm_phase<pg8::EpiBf16I8<0>, pg8::StaticOrder, true, true, true>(lds, g, S, E);
  } else {
    pg8::Gemm g{(const bf16_t*)(ws + WS_H8), (const bf16_t*)(ws + WS_WB_OUT8), TOK, 1024, 512}; pg8::StaticOrder S; S.init(TOK, 1024, gridDim.x, blockIdx.x);
    pg8::EpiResBf16I8 E{(bf16_t*)P.out, (const float*)(ws + WS_SH), (const float*)(ws + WS_SB_OUT), 1024};
    pg8::gemm_phase<pg8::EpiResBf16I8, pg8::StaticOrder, true, true, true>(lds, g, S, E);
  }
}

#define RLX_AGENT __ATOMIC_RELAXED, __HIP_MEMORY_SCOPE_AGENT
#define XB_TMO      128
#define XB_XCNT(j)  (256  + 64 * (j))
#define XB_XSUB(j)  (1280 + 64 * (j))
#define XB_XGEN(j)  (2304 + 64 * (j))
#define XB_TOP      3328
#define XB_TOPGEN   3392
#define XCD_BAR_WORDS 3456
#define XB_SPIN_CAP (1u << 18)

__device__ __forceinline__ unsigned xb_ld(unsigned* p)              { return __hip_atomic_load(p, __ATOMIC_RELAXED, __HIP_MEMORY_SCOPE_AGENT); }
__device__ __forceinline__ unsigned xb_add(unsigned* p, unsigned v) { return __hip_atomic_fetch_add(p, v, __ATOMIC_RELAXED, __HIP_MEMORY_SCOPE_AGENT); }
__device__ __forceinline__ unsigned xb_xcc_id() { return (unsigned)__builtin_amdgcn_s_getreg((3 << 11) | 20) & 0xFu; }
#define XB_SPIN(cond, bar) do { unsigned _sp = 0; while (cond) { __builtin_amdgcn_s_sleep(1); \
    if ((++_sp & 255u) == 0u) { if (xb_ld(&(bar)[XB_TMO])) break; if (_sp > XB_SPIN_CAP) { atomicAdd(&(bar)[XB_TMO], 1u); break; } } } } while (0)

struct XcdBarrier {
    unsigned* bar; unsigned x;
    volatile LAS unsigned* st;
};

__device__ __forceinline__ XcdBarrier xcd_barrier_post(unsigned* bar, volatile LAS unsigned* st) {
    XcdBarrier b; b.bar = bar; b.x = xb_xcc_id(); b.st = st;
    if (threadIdx.x == 0) (void)xb_add(&bar[XB_XCNT(b.x)], 1u);
    return b;
}
__device__ __forceinline__ void xcd_barrier_complete(unsigned* bar, unsigned x, unsigned& nloc, unsigned& nx) {
    const unsigned G = gridDim.x * gridDim.y * gridDim.z;
    unsigned sum, cnt, mine, sp = 0u;
    for (;;) {
        sum = 0u; cnt = 0u; mine = 0u;
#pragma unroll
        for (unsigned j = 0; j < 16; ++j) { const unsigned c = xb_ld(&bar[XB_XCNT(j)]); sum += c; cnt += (c > 0u) ? 1u : 0u; mine = (j == x) ? c : mine; }
        if (sum == G) break;
        __builtin_amdgcn_s_sleep(1);
        if ((++sp & 255u) == 0u) { if (xb_ld(&bar[XB_TMO])) break; if (sp > XB_SPIN_CAP) { atomicAdd(&bar[XB_TMO], 1u); break; } }
    }
    nloc = mine > 0u ? mine : 1u; nx = cnt > 0u ? cnt : 1u;
}

__device__ __forceinline__ void xcd_barrier(const XcdBarrier& b) {
    asm volatile("s_waitcnt vmcnt(0)" ::: "memory");
    __syncthreads();
    if (threadIdx.x == 0) {
        unsigned* bar = b.bar;
        __builtin_amdgcn_s_waitcnt(0);
        unsigned nloc = b.st[0], nx = b.st[1];
        if (nloc == 0u) { xcd_barrier_complete(bar, b.x, nloc, nx); b.st[0] = nloc; b.st[1] = nx; }
        const unsigned old = xb_add(&bar[XB_XSUB(b.x)], 1u);
        const unsigned gen = old / nloc;
        if (old + 1u == (gen + 1u) * nloc) {
            __builtin_amdgcn_fence(__ATOMIC_RELEASE, "agent");
            asm volatile("s_waitcnt vmcnt(0)" ::: "memory");
            const unsigned og = xb_add(&bar[XB_TOP], 1u);
            const unsigned tg = og / nx;
            if (og + 1u == (tg + 1u) * nx) xb_add(&bar[XB_TOPGEN], 1u);
            else XB_SPIN(xb_ld(&bar[XB_TOPGEN]) == tg, bar);
            __builtin_amdgcn_fence(__ATOMIC_ACQUIRE, "agent");
            xb_add(&bar[XB_XGEN(b.x)], 1u);
            asm volatile("s_waitcnt vmcnt(0)" ::: "memory");
        } else {
            XB_SPIN(xb_ld(&bar[XB_XGEN(b.x)]) == gen, bar);
            __builtin_amdgcn_fence(__ATOMIC_ACQUIRE, "agent");
            asm volatile("s_waitcnt vmcnt(0)" ::: "memory");
        }
    }
    __syncthreads();
}


__device__ __forceinline__ void phase_glr(const Params& P) {
  typedef int i32x4_t __attribute__((ext_vector_type(4)));
  const int lane = threadIdx.x & 63, wave = __builtin_amdgcn_readfirstlane(threadIdx.x >> 6), fr = lane & 15, fq = lane >> 4;
  const unsigned char* H8 = P.ws + WS_H8; const unsigned char* WT = P.ws + WS_WB_IN8 + (size_t)3072 * 1024;
  const float* SH = (const float*)(P.ws + WS_SH); const float* SB = (const float*)(P.ws + WS_SB_IN) + 3072;
  float* GLR = (float*)(P.ws + WS_GLR);
  for (int job = blockIdx.x * 8 + wave; job < TOK / 16; job += gridDim.x * 8) {
    const unsigned char* ar = H8 + ((size_t)job * 16 + fr) * 1024 + fq * 16; const unsigned char* br = WT + (size_t)fr * 1024 + fq * 16;
    i32x4_t acc = (i32x4_t){0, 0, 0, 0};
#pragma unroll 8
    for (int ks = 0; ks < 16; ++ks) acc = __builtin_amdgcn_mfma_i32_16x16x64_i8(*(const i32x4_t*)(ar + ks * 64), *(const i32x4_t*)(br + ks * 64), acc, 0, 0, 0);
    const float sb = SB[fr];
#pragma unroll
    for (int r = 0; r < 4; ++r) { const size_t tk = (size_t)job * 16 + 4 * fq + r; GLR[tk * 16 + fr] = (float)acc[r] * (SH[tk] * sb); }
  }
}

template <bool EMIT8, bool WRITE_H = true>
__device__ __forceinline__ void rmsnorm_row(const Params& P, int tok, float4 (&x)[4], const float4 (&gg)[4], int lane) {
  bf16_t* H = (bf16_t*)(P.ws + WS_H);
  float ss = 0.f;
#pragma unroll
  for (int i = 0; i < 4; ++i) ss += x[i].x * x[i].x + x[i].y * x[i].y + x[i].z * x[i].z + x[i].w * x[i].w;
  ss = wave_sum_dpp(ss);
  const float rs = rsqrtf(ss * (1.0f / 1024.0f) + 1e-6f);
  float am = 0.f; unsigned hb[8];
#pragma unroll
  for (int i = 0; i < 4; ++i) {
    x[i].x *= rs * gg[i].x; x[i].y *= rs * gg[i].y; x[i].z *= rs * gg[i].z; x[i].w *= rs * gg[i].w;
    hb[2 * i] = pk2(x[i].x, x[i].y); hb[2 * i + 1] = pk2(x[i].z, x[i].w);
    if (WRITE_H) { v2u o; o.x = hb[2 * i]; o.y = hb[2 * i + 1]; *(v2u*)(H + (size_t)tok * 1024 + i * 256 + lane * 4) = o; }
  }
  if (EMIT8) {
    float hv[16];
#pragma unroll
    for (int i = 0; i < 8; ++i) { hv[2 * i] = __uint_as_float(hb[i] << 16); hv[2 * i + 1] = __uint_as_float(hb[i] & 0xFFFF0000u); am = fmaxf(am, fmaxf(fabsf(hv[2 * i]), fabsf(hv[2 * i + 1]))); }
    am = wave_max_dpp(am);
    const float sh = am > 0.f ? am * (1.0f / 127.0f) : 1.0f, hinv = 1.0f / sh;
    v4u q;
    q.x = q8(hv[0], hinv) | (q8(hv[1], hinv) << 8) | (q8(hv[2], hinv) << 16) | (q8(hv[3], hinv) << 24);
    q.y = q8(hv[4], hinv) | (q8(hv[5], hinv) << 8) | (q8(hv[6], hinv) << 16) | (q8(hv[7], hinv) << 24);
    q.z = q8(hv[8], hinv) | (q8(hv[9], hinv) << 8) | (q8(hv[10], hinv) << 16) | (q8(hv[11], hinv) << 24);
    q.w = q8(hv[12], hinv) | (q8(hv[13], hinv) << 8) | (q8(hv[14], hinv) << 16) | (q8(hv[15], hinv) << 24);
    *(v4u*)(P.ws + WS_H8 + (size_t)tok * 1024 + lane * 16) = q;
    if (lane == 0) ((float*)(P.ws + WS_SH))[tok] = sh;
  }
}
template <bool SRC16>
__device__ __forceinline__ void rmsnorm_ld(float4 (&x)[4], const void* src, int tok, int lane) {
#pragma unroll
  for (int i = 0; i < 4; ++i) {
    if (SRC16) { const v2u w = *(const v2u*)((const bf16_t*)src + (size_t)tok * 1024 + i * 256 + lane * 4);
      x[i].x = __uint_as_float(w.x << 16); x[i].y = __uint_as_float(w.x & 0xFFFF0000u); x[i].z = __uint_as_float(w.y << 16); x[i].w = __uint_as_float(w.y & 0xFFFF0000u); }
    else x[i] = *(const float4*)((const float*)src + (size_t)tok * 1024 + i * 256 + lane * 4);
  }
}
template <bool EMIT8, bool WRITE_H = true, bool SRC16 = true>
__device__ __forceinline__ void phase_rmsnorm(const Params& P, const void* src, const float* g) {
  const int lane = threadIdx.x & 63, wave = __builtin_amdgcn_readfirstlane(threadIdx.x >> 6);
  const int gw = blockIdx.x * 8 + wave, NGW = gridDim.x * 8;
  float4 gg[4];
#pragma unroll
  for (int i = 0; i < 4; ++i) gg[i] = *(const float4*)(g + i * 256 + lane * 4);
  float4 xa[4], xb[4], xc[4], xd[4];
  for (int tok = gw; tok < TOK; tok += 4 * NGW) {
    const bool vb = tok + NGW < TOK, vc = tok + 2 * NGW < TOK, vd = tok + 3 * NGW < TOK;
    rmsnorm_ld<SRC16>(xa, src, tok, lane);
    if (vb) rmsnorm_ld<SRC16>(xb, src, tok + NGW, lane);
    if (vc) rmsnorm_ld<SRC16>(xc, src, tok + 2 * NGW, lane);
    if (vd) rmsnorm_ld<SRC16>(xd, src, tok + 3 * NGW, lane);
    rmsnorm_row<EMIT8, WRITE_H>(P, tok, xa, gg, lane);
    if (vb) rmsnorm_row<EMIT8, WRITE_H>(P, tok + NGW, xb, gg, lane);
    if (vc) rmsnorm_row<EMIT8, WRITE_H>(P, tok + 2 * NGW, xc, gg, lane);
    if (vd) rmsnorm_row<EMIT8, WRITE_H>(P, tok + 3 * NGW, xd, gg, lane);
  }
}

__device__ __forceinline__ void w8_rows(const Params& P, const bf16_t* src0, unsigned char* dst0, float* sc0, int rows, int lane, int gw, int NGW) {
  for (int r = gw; r < rows; r += NGW) {
    const bf16_t* src = src0 + (size_t)r * 1024;
    float hv[16]; float am = 0.f;
#pragma unroll
    for (int i = 0; i < 4; ++i) { const v2u w = *(const v2u*)(src + i * 256 + lane * 4);
      hv[4 * i] = __uint_as_float(w.x << 16); hv[4 * i + 1] = __uint_as_float(w.x & 0xFFFF0000u); hv[4 * i + 2] = __uint_as_float(w.y << 16); hv[4 * i + 3] = __uint_as_float(w.y & 0xFFFF0000u);
      am = fmaxf(am, fmaxf(fmaxf(fabsf(hv[4 * i]), fabsf(hv[4 * i + 1])), fmaxf(fabsf(hv[4 * i + 2]), fabsf(hv[4 * i + 3])))); }
    am = wave_max_dpp(am);
    const float sc = am > 0.f ? am * (1.0f / 127.0f) : 1.0f, inv = 1.0f / sc;
    v4u q;
    q.x = q8(hv[0], inv) | (q8(hv[1], inv) << 8) | (q8(hv[2], inv) << 16) | (q8(hv[3], inv) << 24);
    q.y = q8(hv[4], inv) | (q8(hv[5], inv) << 8) | (q8(hv[6], inv) << 16) | (q8(hv[7], inv) << 24);
    q.z = q8(hv[8], inv) | (q8(hv[9], inv) << 8) | (q8(hv[10], inv) << 16) | (q8(hv[11], inv) << 24);
    q.w = q8(hv[12], inv) | (q8(hv[13], inv) << 8) | (q8(hv[14], inv) << 16) | (q8(hv[15], inv) << 24);
    *(v4u*)(dst0 + (size_t)r * 1024 + lane * 16) = q;
    if (lane == 0) sc0[r] = sc;
  }
}
__device__ __forceinline__ void phase_w8(const Params& P) {
  const int lane = threadIdx.x & 63, wave = __builtin_amdgcn_readfirstlane(threadIdx.x >> 6);
  const int gw = blockIdx.x * 8 + wave, NGW = gridDim.x * 8;
  w8_rows(P, (const bf16_t*)(P.ws + WS_WA_IN), P.ws + WS_WA_IN8, (float*)(P.ws + WS_SA_IN), 4096, lane, gw, NGW);
  w8_rows(P, (const bf16_t*)(P.ws + WS_WB_IN), P.ws + WS_WB_IN8, (float*)(P.ws + WS_SB_IN), BPROJ, lane, gw, NGW);
  for (int r = gw; r < 1024; r += NGW) {
    const bf16_t* src = (const bf16_t*)(P.ws + WS_WB_OUT) + (size_t)r * 1024 + lane * 16;
    const v4u w0 = *(const v4u*)src, w1 = *(const v4u*)(src + 8); const unsigned ww[8] = {w0.x, w0.y, w0.z, w0.w, w1.x, w1.y, w1.z, w1.w};
    float hv[16]; float am = 0.f;
#pragma unroll
    for (int i = 0; i < 8; ++i) { hv[2 * i] = __uint_as_float(ww[i] << 16); hv[2 * i + 1] = __uint_as_float(ww[i] & 0xFFFF0000u); am = fmaxf(am, fmaxf(fabsf(hv[2 * i]), fabsf(hv[2 * i + 1]))); }
    am = wave_max_dpp(am);
    const float sc = am > 0.f ? am * (1.0f / 127.0f) : 1.0f, inv = 1.0f / sc;
    v4u q;
    q.x = q8(hv[0], inv) | (q8(hv[1], inv) << 8) | (q8(hv[2], inv) << 16) | (q8(hv[3], inv) << 24);
    q.y = q8(hv[4], inv) | (q8(hv[5], inv) << 8) | (q8(hv[6], inv) << 16) | (q8(hv[7], inv) << 24);
    q.z = q8(hv[8], inv) | (q8(hv[9], inv) << 8) | (q8(hv[10], inv) << 16) | (q8(hv[11], inv) << 24);
    q.w = q8(hv[12], inv) | (q8(hv[13], inv) << 8) | (q8(hv[14], inv) << 16) | (q8(hv[15], inv) << 24);
    *(v4u*)(P.ws + WS_WB_OUT8 + (size_t)r * 1024 + lane * 16) = q;
    if (lane == 0) ((float*)(P.ws + WS_SB_OUT))[r] = sc;
  }
}

#ifndef PROBE
#define PROBE 0
#endif
__global__ void __launch_bounds__(512, 2) mega_fwd(Params P) {
  extern __shared__ __attribute__((aligned(16))) unsigned char lds_raw[];
  LAS unsigned char* lds = (LAS unsigned char*)lds_raw;
  cg::grid_group grid = cg::this_grid();
  volatile LAS unsigned* bst = (volatile LAS unsigned*)(lds + 131072 + 64);
  if (threadIdx.x == 0) { bst[0] = 0u; bst[1] = 0u; }
  __syncthreads();
  const XcdBarrier bar = xcd_barrier_post((unsigned*)(P.ws + WS_BAR), bst);
#define SEAM() do { xcd_barrier(bar); } while (0)
#if PROBE & 32
  phase_prep(P, lds); phase_tabconv8(P); phase_rmsnorm<true, false, false>(P, P.in[0], P.in[1]);
#endif
  phase_prep(P, lds); phase_tabconv8(P); phase_rmsnorm<true, false, false>(P, P.in[0], P.in[1]);
  grid.sync();
#if PROBE & 8
  phase_gemm<0>(P, lds, 0);
#endif
  phase_w8(P);
  SEAM();
  phase_gemm<0>(P, lds, 0);
  SEAM();
#if PROBE & 262144
  SEAM(); SEAM(); SEAM(); SEAM(); SEAM(); SEAM(); SEAM(); SEAM(); SEAM(); SEAM();
#endif
#if PROBE & 4
  phase_gate_a<true>(P, lds);
#endif
  phase_gate_a<false>(P, lds);
  SEAM();
#if PROBE & 8
  phase_gemm<1>(P, lds, 0);
#endif
  phase_gemm<1>(P, lds, 0);
  SEAM();
#if PROBE & 65536
  phase_rmsnorm<true>(P, P.out, P.in[2]);
#endif
  phase_rmsnorm<true>(P, P.out, P.in[2]);
  SEAM();
#if PROBE & 8
  phase_gemm<2>(P, lds, 0);
#endif
  phase_gemm<2>(P, lds, 0);
  SEAM();
#if PROBE & 16
  phase_topk(P, lds, 0);
#endif
  phase_topk(P, lds, 0);
  SEAM();
  phase_uslice<false>(P, lds, 0);
  SEAM();
  phase_ureduce(P);
  SEAM();
#if PROBE & 1
  phase_vslice<true>(P, lds, 0); SEAM();
#endif
#if PROBE & 256
  phase_uslice<true>(P, lds, 0); SEAM();
#endif
  phase_vslice<false>(P, lds, 0);
  SEAM();
  phase_rmsnorm<true, false>(P, P.out, P.in[1] + 1024);
  SEAM();
#if PROBE & 8
  phase_gemm<3>(P, lds, 0);
#endif
  phase_gemm<3>(P, lds, 0); phase_glr(P);
  SEAM();
#if PROBE & 4098
  phase_gla_prep(P, lds);
#endif
  phase_gla_prep(P, lds);
  SEAM();
#if PROBE & 8194
  phase_gla_scan<3>(P, lds); __syncthreads();
#endif
#if PROBE & 16384
  phase_gla_scan<1>(P, lds); __syncthreads();
#endif
#if PROBE & 32768
  phase_gla_scan<2>(P, lds); __syncthreads();
#endif
  phase_gla_scan(P, lds);
  SEAM();
#if PROBE & 64
  phase_gla_post(P);
#endif
  phase_gla_post(P);
  SEAM();
  phase_gemm<4>(P, lds, 0);
  SEAM();
#if PROBE & 65536
  phase_rmsnorm<true>(P, P.out, P.in[2] + 1024);
#endif
  phase_rmsnorm<true>(P, P.out, P.in[2] + 1024);
  SEAM();
#if PROBE & 131072
  phase_gemm<2>(P, lds, 1);
#endif
  phase_gemm<2>(P, lds, 1);
  SEAM();
#if PROBE & 16
  phase_topk(P, lds, 1);
#endif
  phase_topk(P, lds, 1);
  SEAM();
  phase_uslice<false>(P, lds, 1);
  SEAM();
  phase_ureduce(P);
  SEAM();
#if PROBE & 1
  phase_vslice<true>(P, lds, 1); SEAM();
#endif
  phase_vslice<false>(P, lds, 1);
  SEAM();
  phase_final_norm(P, P.in[3]);
#undef SEAM
}

extern "C" void kernel_launch(void* const* d_in, const int* in_sizes, int n_in, void* d_out, int out_size, void* d_ws, size_t ws_size, hipStream_t stream) {
  static int grid = 0;
  if (grid == 0) {
    int dev = 0, cus = 0, per_cu = 0;
    if (hipGetDevice(&dev) != hipSuccess || hipDeviceGetAttribute(&cus, hipDeviceAttributeMultiprocessorCount, dev) != hipSuccess) { fprintf(stderr, "kernel_launch: device query failed\n"); grid = -1; return; }
    if (hipFuncSetAttribute((const void*)mega_fwd, hipFuncAttributeMaxDynamicSharedMemorySize, LDS_BYTES) != hipSuccess) { fprintf(stderr, "kernel_launch: hipFuncSetAttribute failed\n"); grid = -1; return; }
    if (hipOccupancyMaxActiveBlocksPerMultiprocessor(&per_cu, (const void*)mega_fwd, 512, LDS_BYTES) != hipSuccess || per_cu < 1) { fprintf(stderr, "kernel_launch: occupancy query gave %d\n", per_cu); grid = -1; return; }
    grid = cus * per_cu;
    if (grid > 256) grid = 256;
    fprintf(stderr, "kernel_launch: cus %d per_cu %d grid %d ws %zu\n", cus, per_cu, grid, ws_size);
  }
  if (grid < 0) return;
  (void)hipMemsetAsync((char*)d_ws + WS_BAR, 0, XCD_BAR_WORDS * 4, stream);
  Params P{};
  for (int i = 0; i < 21; ++i) P.in[i] = (const float*)d_in[i];
  P.out = (float*)d_out; P.ws = (unsigned char*)d_ws;
  void* args[] = {&P};
  hipError_t e = hipLaunchCooperativeKernel((const void*)mega_fwd, dim3(grid), dim3(512), args, LDS_BYTES, stream);
  if (e != hipSuccess) fprintf(stderr, "kernel_launch: cooperative launch failed: %s (grid %d)\n", hipGetErrorString(e), grid);
}
```
